# Optimizing an MI355X kernel written in HIP

```python
import jax
import jax.numpy as jnp
from jax import lax
import numpy as np

D_MODEL = 1024
BATCH = 2
SEQ = 8192
DEPTH = 2
DEC_BATCH = 8
DEC_SEQ = 8192
PAST_LEN = 128

GRID_W = 64
HEAD_DIM = 64
NA_HEADS = 6
NA_WIN_H = 8
NA_WIN_W = 16
NA_DIM = NA_HEADS * HEAD_DIM
SC_DIM = 256
SC_WIDTH = 3
SWA_HEADS = 6
SWA_KV_HEADS = 2
SWA_GROUP = SWA_HEADS // SWA_KV_HEADS
SWA_WINDOW = 128
SWA_BLOCK = 128
SWA_DIM = SWA_HEADS * HEAD_DIM
SWA_KV_DIM = SWA_KV_HEADS * HEAD_DIM
T5_BUCKETS = 32
T5_MAX_DIST = 128
MIX_DIM = NA_DIM + SC_DIM + SWA_DIM
IN_SPLITS = (NA_DIM, NA_DIM, NA_DIM, SC_DIM, SC_DIM, SC_DIM, SWA_DIM, SWA_KV_DIM, SWA_KV_DIM)
IN_DIM = 3 * NA_DIM + 3 * SC_DIM + SWA_DIM + 2 * SWA_KV_DIM
MEM_LEN = 256
XA_HEADS = 4
XA_HEAD_DIM = 128
XA_DIM = XA_HEADS * XA_HEAD_DIM
PEER_HEADS = 8
PEER_NKEYS = 128
PEER_EXPERTS = PEER_NKEYS * PEER_NKEYS
PEER_TOPK = 16
PEER_KEY_DIM = 256
PEER_HALF = PEER_KEY_DIM // 2
PEER_CHUNK = 128
RMS_EPS = 1e-6
NEG_INF = -1e30

kernel_name = "hybrid_na2d_shortconv_swa_peer_encoder"


def rmsnorm(x, g):
    xf = x.astype(jnp.float32)
    y = xf * lax.rsqrt(jnp.mean(xf * xf, axis=-1, keepdims=True) + RMS_EPS)
    return (y * g.astype(jnp.float32)).astype(x.dtype)


def t5_bucket(rel):
    nb = T5_BUCKETS // 2
    max_exact = nb // 2
    ret = (rel > 0).astype(np.int32) * nb
    n = np.abs(rel)
    large = max_exact + (np.log(np.maximum(n, 1) / max_exact) / np.log(T5_MAX_DIST / max_exact) * (nb - max_exact)).astype(np.int32)
    large = np.minimum(large, nb - 1)
    return (ret + np.where(n < max_exact, n, large)).astype(np.int32)


def neighborhood_attention(q, k, v, rpb):
    b, s = q.shape[0], q.shape[1]
    rows = s // GRID_W
    kh = min(NA_WIN_H, rows)
    grid = lambda t: t.reshape(b, rows, GRID_W, NA_HEADS, HEAD_DIM)
    qg, kg, vg = grid(q), grid(k), grid(v)
    col = np.arange(GRID_W)
    col_start = np.clip(col - NA_WIN_W // 2, 0, GRID_W - NA_WIN_W)
    col_idx = col_start[:, None] + np.arange(NA_WIN_W)[None, :]
    dc_idx = col_idx - col[:, None] + (NA_WIN_W - 1)
    scale = HEAD_DIM ** -0.5

    def row_block(r):
        r0 = jnp.clip(r - kh // 2, 0, rows - kh)
        rows_idx = r0 + jnp.arange(kh)
        k_r = jnp.take(kg, rows_idx, axis=1)[:, :, col_idx]
        v_r = jnp.take(vg, rows_idx, axis=1)[:, :, col_idx]
        q_r = lax.dynamic_index_in_dim(qg, r, axis=1, keepdims=False)
        logits = jnp.einsum("bchd,bicjhd->bhcij", q_r, k_r).astype(jnp.float32) * scale
        dr_idx = rows_idx - r + (NA_WIN_H - 1)
        bias = rpb[dr_idx[None, :, None], dc_idx[:, None, :]]
        logits = logits + jnp.transpose(bias, (3, 0, 1, 2)).astype(jnp.float32)
        p = jax.nn.softmax(logits.reshape(b, NA_HEADS, GRID_W, kh * NA_WIN_W), axis=-1).reshape(logits.shape)
        return jnp.einsum("bhcij,bicjhd->bchd", p.astype(v.dtype), v_r)

    out = lax.map(row_block, jnp.arange(rows))
    return jnp.transpose(out, (1, 0, 2, 3, 4)).reshape(b, s, NA_DIM)


def short_conv_mixer(gate_b, gate_c, hx, w):
    u = gate_c * hx
    half = SC_WIDTH // 2
    s = u.shape[1]
    up = jnp.pad(u, ((0, 0), (half, half), (0, 0)))
    y = up[:, 0:s] * w[0]
    for tap in range(1, SC_WIDTH):
        y = y + up[:, tap:tap + s] * w[tap]
    return gate_b * y


def window_gqa(q, k, v, bias_off, sink):
    b, s = q.shape[0], q.shape[1]
    blk = SWA_BLOCK
    nb = s // blk
    qb = q.reshape(b, nb, blk, SWA_KV_HEADS, SWA_GROUP, HEAD_DIM)
    pad = ((0, 0), (blk, blk), (0, 0), (0, 0))
    kp = jnp.pad(k, pad).reshape(b, nb + 2, blk, SWA_KV_HEADS, HEAD_DIM)
    vp = jnp.pad(v, pad).reshape(b, nb + 2, blk, SWA_KV_HEADS, HEAD_DIM)
    kband = jnp.concatenate([kp[:, :-2], kp[:, 1:-1], kp[:, 2:]], axis=2)
    vband = jnp.concatenate([vp[:, :-2], vp[:, 1:-1], vp[:, 2:]], axis=2)
    logits = jnp.einsum("bnqhgd,bnjhd->bnhgqj", qb, kband).astype(jnp.float32) * (HEAD_DIM ** -0.5)
    a = np.arange(blk)[:, None]
    j = np.arange(3 * blk)[None, :]
    off = j - blk - a
    in_win = np.abs(off) <= SWA_WINDOW
    key_pos = (np.arange(nb)[:, None] - 1) * blk + np.arange(3 * blk)[None, :]
    valid = (key_pos >= 0) & (key_pos < s)
    mask = in_win[None, :, :] & valid[:, None, :]
    bias = bias_off[np.clip(off + SWA_WINDOW, 0, 2 * SWA_WINDOW)]
    bias = jnp.transpose(bias.reshape(blk, 3 * blk, SWA_KV_HEADS, SWA_GROUP), (2, 3, 0, 1)).astype(jnp.float32)
    logits = jnp.where(mask[None, :, None, None], logits + bias[None, None], NEG_INF)
    sk = sink.astype(jnp.float32).reshape(1, 1, SWA_KV_HEADS, SWA_GROUP, 1, 1)
    m = jnp.maximum(jnp.max(logits, axis=-1, keepdims=True), sk)
    p = jnp.exp(logits - m)
    p = p / (jnp.sum(p, axis=-1, keepdims=True) + jnp.exp(sk - m))
    out = jnp.einsum("bnhgqj,bnjhd->bnqhgd", p.astype(v.dtype), vband)
    return out.reshape(b, s, SWA_DIM)


def mem_cross_attention(xn, memn, wq, wk, wv, wo):
    b, s = xn.shape[0], xn.shape[1]
    m = memn.shape[1]
    q = (xn @ wq).reshape(b, s, XA_HEADS, XA_HEAD_DIM)
    k = (memn @ wk).reshape(b, m, XA_HEADS, XA_HEAD_DIM)
    v = (memn @ wv).reshape(b, m, XA_HEADS, XA_HEAD_DIM)
    logits = jnp.einsum("bshd,bmhd->bhsm", q, k).astype(jnp.float32) * (XA_HEAD_DIM ** -0.5)
    p = jax.nn.softmax(logits, axis=-1)
    o = jnp.einsum("bhsm,bmhd->bshd", p.astype(v.dtype), v).reshape(b, s, XA_DIM)
    return o @ wo


def peer_ffn(xn, wq, subkeys, u, v):
    b, s, d = xn.shape
    xt = xn.reshape(-1, PEER_CHUNK, d)

    def chunk(xc):
        q = (xc @ wq).reshape(PEER_CHUNK, PEER_HEADS, 2, PEER_HALF)
        scores = jnp.einsum("thpe,hpne->thpn", q, subkeys)
        top_s, top_i = lax.top_k(scores, PEER_TOPK)
        cand = top_s[:, :, 0, :, None] + top_s[:, :, 1, None, :]
        cand_idx = top_i[:, :, 0, :, None] * PEER_NKEYS + top_i[:, :, 1, None, :]
        cand = cand.reshape(PEER_CHUNK, PEER_HEADS, PEER_TOPK * PEER_TOPK)
        cand_idx = cand_idx.reshape(PEER_CHUNK, PEER_HEADS, PEER_TOPK * PEER_TOPK)
        best_s, best_pos = lax.top_k(cand, PEER_TOPK)
        expert = jnp.take_along_axis(cand_idx, best_pos, axis=-1)
        gate = jax.nn.softmax(best_s.astype(jnp.float32), axis=-1)
        act = jax.nn.gelu(jnp.einsum("thkd,td->thk", u[expert], xc).astype(jnp.float32), approximate=False)
        w = (gate * act).astype(xc.dtype)
        return jnp.einsum("thk,thkd->td", w, v[expert])

    return lax.map(chunk, xt).reshape(b, s, d)


def encoder_trunk(x, mem, norm_mix_g, w_in, na_rpb, conv_w, swa_sink, t5_bias, w_out,
                  norm_xa_g, norm_mem_g, w_xq, w_xk, w_xv, w_xo,
                  norm_ffn_g, peer_wq, peer_subkeys, peer_u, peer_v, final_g):
    b, s = x.shape[0], x.shape[1]
    offsets = np.arange(-SWA_WINDOW, SWA_WINDOW + 1)
    bias_off = t5_bias[t5_bucket(offsets)]
    split_at = [int(i) for i in np.cumsum(IN_SPLITS)[:-1]]
    for l in range(DEPTH):
        h = rmsnorm(x, norm_mix_g[l])
        z = h @ w_in[l]
        na_q, na_k, na_v, sc_b, sc_c, sc_h, sw_q, sw_k, sw_v = jnp.split(z, split_at, axis=-1)
        y_na = neighborhood_attention(na_q.reshape(b, s, NA_HEADS, HEAD_DIM),
                                      na_k.reshape(b, s, NA_HEADS, HEAD_DIM),
                                      na_v.reshape(b, s, NA_HEADS, HEAD_DIM), na_rpb[l])
        y_sc = short_conv_mixer(sc_b, sc_c, sc_h, conv_w[l])
        y_sw = window_gqa(sw_q.reshape(b, s, SWA_HEADS, HEAD_DIM),
                          sw_k.reshape(b, s, SWA_KV_HEADS, HEAD_DIM),
                          sw_v.reshape(b, s, SWA_KV_HEADS, HEAD_DIM), bias_off, swa_sink[l])
        x = x + jnp.concatenate([y_na, y_sc, y_sw], axis=-1) @ w_out[l]
        x = x + mem_cross_attention(rmsnorm(x, norm_xa_g[l]), rmsnorm(mem, norm_mem_g[l]),
                                    w_xq[l], w_xk[l], w_xv[l], w_xo[l])
        x = x + peer_ffn(rmsnorm(x, norm_ffn_g[l]), peer_wq[l], peer_subkeys[l], peer_u[l], peer_v[l])
    return rmsnorm(x, final_g)


def setup_inputs(seed: int = 0) -> dict:
    key = jax.random.key(seed)
    ks = jax.random.split(key, 24)
    f32 = jnp.float32
    nrm = lambda k, shape, scale: jax.random.normal(k, shape, f32) * scale
    gain = lambda k, shape: 1.0 + 0.02 * jax.random.normal(k, shape, f32)
    return {
        "x_prompt": nrm(ks[0], (BATCH, SEQ, D_MODEL), 1.0),
        "x_sample": nrm(ks[1], (DEC_BATCH, DEC_SEQ, D_MODEL), 1.0),
        "mem_prompt": nrm(ks[2], (BATCH, MEM_LEN, D_MODEL), 1.0),
        "mem_sample": nrm(ks[3], (DEC_BATCH, MEM_LEN, D_MODEL), 1.0),
        "norm_mix_g": gain(ks[4], (DEPTH, D_MODEL)),
        "w_in": nrm(ks[5], (DEPTH, D_MODEL, IN_DIM), D_MODEL ** -0.5),
        "na_rpb": nrm(ks[6], (DEPTH, 2 * NA_WIN_H - 1, 2 * NA_WIN_W - 1, NA_HEADS), 0.1),
        "conv_w": nrm(ks[7], (DEPTH, SC_WIDTH, SC_DIM), SC_WIDTH ** -0.5),
        "swa_sink": nrm(ks[8], (DEPTH, SWA_HEADS), 0.5),
        "t5_bias": nrm(ks[9], (T5_BUCKETS, SWA_HEADS), 0.1),
        "w_out": nrm(ks[10], (DEPTH, MIX_DIM, D_MODEL), MIX_DIM ** -0.5),
        "norm_xa_g": gain(ks[11], (DEPTH, D_MODEL)),
        "norm_mem_g": gain(ks[12], (DEPTH, D_MODEL)),
        "w_xq": nrm(ks[13], (DEPTH, D_MODEL, XA_DIM), D_MODEL ** -0.5),
        "w_xk": nrm(ks[14], (DEPTH, D_MODEL, XA_DIM), D_MODEL ** -0.5),
        "w_xv": nrm(ks[15], (DEPTH, D_MODEL, XA_DIM), D_MODEL ** -0.5),
        "w_xo": nrm(ks[16], (DEPTH, XA_DIM, D_MODEL), XA_DIM ** -0.5),
        "norm_ffn_g": gain(ks[17], (DEPTH, D_MODEL)),
        "peer_wq": nrm(ks[18], (DEPTH, D_MODEL, PEER_HEADS * PEER_KEY_DIM), D_MODEL ** -0.5),
        "peer_subkeys": nrm(ks[19], (DEPTH, PEER_HEADS, 2, PEER_NKEYS, PEER_HALF), PEER_HALF ** -0.5),
        "peer_u": nrm(ks[20], (DEPTH, PEER_EXPERTS, D_MODEL), D_MODEL ** -0.5),
        "peer_v": nrm(ks[21], (DEPTH, PEER_EXPERTS, D_MODEL), D_MODEL ** -0.5),
        "final_g": gain(ks[22], (D_MODEL,)),
    }


def reference(x_prompt, x_sample, mem_prompt, mem_sample, norm_mix_g, w_in, na_rpb, conv_w,
              swa_sink, t5_bias, w_out, norm_xa_g, norm_mem_g, w_xq, w_xk, w_xv, w_xo,
              norm_ffn_g, peer_wq, peer_subkeys, peer_u, peer_v, final_g):
    y_prompt = encoder_trunk(x_prompt, mem_prompt, norm_mix_g, w_in, na_rpb, conv_w, swa_sink, t5_bias, w_out,
                             norm_xa_g, norm_mem_g, w_xq, w_xk, w_xv, w_xo,
                             norm_ffn_g, peer_wq, peer_subkeys, peer_u, peer_v, final_g)
    y_sample = encoder_trunk(x_sample, mem_sample, norm_mix_g, w_in, na_rpb, conv_w, swa_sink, t5_bias, w_out,
                             norm_xa_g, norm_mem_g, w_xq, w_xk, w_xv, w_xo,
                             norm_ffn_g, peer_wq, peer_subkeys, peer_u, peer_v, final_g)
    return (y_prompt, y_sample)
```

```cpp
#include <hip/hip_runtime.h>
#include <hip/hip_cooperative_groups.h>
#include <cstdio>
#include <cstdint>
namespace cg = cooperative_groups;

#ifndef ONE_LAUNCH
#define ONE_LAUNCH 0
#endif

#define DI __device__ __forceinline__
typedef unsigned short bf16_t;
typedef short bf16x8 __attribute__((ext_vector_type(8)));
typedef short s16x4 __attribute__((ext_vector_type(4)));
typedef float f32x16 __attribute__((ext_vector_type(16)));
typedef float f32x4 __attribute__((ext_vector_type(4)));
typedef float f32x2 __attribute__((ext_vector_type(2)));
typedef unsigned u32x4 __attribute__((ext_vector_type(4)));
typedef unsigned u32x2 __attribute__((ext_vector_type(2)));
typedef __bf16 bf2_t __attribute__((ext_vector_type(2)));

constexpr int T = 81920, DM = 1024, SEQ = 8192;
constexpr int IN_DIM = 2560;
constexpr float LOG2E = 1.4426950408889634f;
constexpr float RMS_EPS = 1e-6f;
constexpr int NPHASE = 17;

constexpr int Z_NAQ = 0, Z_NAK = 384, Z_NAV = 768, Z_SCB = 1152, Z_SCC = 1408, Z_SCH = 1664, Z_SWQ = 1920, Z_SWK = 2304, Z_SWV = 2432;

__device__ const unsigned char T5TAB[257] = {
15,15,15,15,15,15,15,15,15,15,15,15,15,15,15,15,15,15,15,15,15,15,15,15,15,15,15,15,15,15,15,15,15,15,15,15,15,15,14,14,14,14,14,14,14,14,14,14,14,14,14,14,14,14,14,14,14,14,14,14,14,14,14,14,14,13,13,13,13,13,13,13,13,13,13,13,13,13,13,13,13,13,13,12,12,12,12,12,12,12,12,12,12,12,12,12,12,11,11,11,11,11,11,11,11,11,10,10,10,10,10,10,10,9,9,9,9,8,8,8,8,7,6,5,4,3,2,1,0,17,18,19,20,21,22,23,24,24,24,24,25,25,25,25,26,26,26,26,26,26,26,27,27,27,27,27,27,27,27,27,28,28,28,28,28,28,28,28,28,28,28,28,28,28,29,29,29,29,29,29,29,29,29,29,29,29,29,29,29,29,29,29,30,30,30,30,30,30,30,30,30,30,30,30,30,30,30,30,30,30,30,30,30,30,30,30,30,30,30,31,31,31,31,31,31,31,31,31,31,31,31,31,31,31,31,31,31,31,31,31,31,31,31,31,31,31,31,31,31,31,31,31,31,31,31,31,31};
__device__ const unsigned char PAIRTAB[64] = {
0x00,0x01,0x02,0x03,0x04,0x05,0x06,0x07,0x08,0x09,0x0a,0x0b,0x0c,0x0d,0x0e,0x0f,
0x10,0x11,0x12,0x13,0x14,0x15,0x16,0x17,
0x20,0x21,0x22,0x23,0x24,
0x30,0x31,0x32,0x33,
0x40,0x41,0x42,
0x50,0x51,0x60,0x61,0x70,0x71,
0x80,0x90,0xa0,0xb0,0xc0,0xd0,0xe0,0xf0,
0,0,0,0,0,0,0,0,0,0,0,0,0,0};

struct Params {
  const float* x_prompt; const float* x_sample; const float* mem_prompt; const float* mem_sample;
  const float* norm_mix_g; const float* w_in; const float* na_rpb; const float* conv_w; const float* swa_sink; const float* t5_bias;
  const float* w_out; const float* norm_xa_g; const float* norm_mem_g; const float* w_xq; const float* w_xk; const float* w_xv; const float* w_xo;
  const float* norm_ffn_g; const float* peer_wq; const float* peer_subkeys; const float* peer_u; const float* peer_v; const float* final_g;
  float* x;
  bf16_t* z; bf16_t* ymix; bf16_t* q; bf16_t* o; float* topS;
  bf16_t* w_inT; bf16_t* w_outT; bf16_t* w_xqT; bf16_t* w_xkvT; bf16_t* w_xoT; bf16_t* w_pqT; bf16_t* subk; bf16_t* pu; bf16_t* pv; bf16_t* memkv;
};

DI unsigned pk2(float a, float b) { f32x2 v = {a, b}; return __builtin_bit_cast(unsigned, __builtin_convertvector(v, bf2_t)); }
DI bf16_t bf1(float a) { return (bf16_t)(pk2(a, 0.f) & 0xffffu); }
DI float bf_lo(unsigned u) { return __uint_as_float(u << 16); }
DI float bf_hi(unsigned u) { return __uint_as_float(u & 0xffff0000u); }
#define MFMA32(a, b, c) __builtin_amdgcn_mfma_f32_32x32x16_bf16((a), (b), (c), 0, 0, 0)
DI int crow(int i, int h) { return (i & 3) + 8 * (i >> 2) + 4 * h; }
DI float wave_sum(float v) { v += __shfl_xor(v, 32); v += __shfl_xor(v, 16); v += __shfl_xor(v, 8); v += __shfl_xor(v, 4); v += __shfl_xor(v, 2); v += __shfl_xor(v, 1); return v; }
DI float rdlane_f(float v, int l) { return __int_as_float(__builtin_amdgcn_readlane(__float_as_int(v), l)); }

constexpr int LDT = 72;
constexpr int GEMM_BUF = 128 * LDT;
constexpr int SMEM_RSTD = 4 * GEMM_BUF * 2;
constexpr int SMEM_BYTES = SMEM_RSTD + 512;

template <bool AF32>
DI void gemm_tile(const void* __restrict__ Ap, int lda, const bf16_t* __restrict__ Bp, int K, unsigned char* smem, f32x16 (&acc)[2][2]) {
  bf16_t* As = (bf16_t*)smem; bf16_t* Bs = As + 2 * GEMM_BUF; float* rs = (float*)(smem + SMEM_RSTD);
  const int t = threadIdx.x, lane = t & 63, wid = t >> 6, wm = wid >> 1, wn = wid & 1, r = lane & 31, h = lane >> 5;
#pragma unroll
  for (int a = 0; a < 2; ++a)
#pragma unroll
    for (int b = 0; b < 2; ++b)
#pragma unroll
      for (int i = 0; i < 16; ++i) acc[a][b][i] = 0.f;
  f32x4 af[8]; u32x4 ab[4]; u32x4 bb[4]; float ss[8];
#pragma unroll
  for (int i = 0; i < 8; ++i) ss[i] = 0.f;
  const int nk = K >> 6;
  const float* Af = (const float*)Ap + (size_t)(t >> 4) * lda + (t & 15) * 4;
  const bf16_t* Ab = (const bf16_t*)Ap + (size_t)(t >> 3) * lda + (t & 7) * 8;
  const bf16_t* Bb = Bp + (size_t)(t >> 3) * K + (t & 7) * 8;
#define GEMM_LDG(kt) { \
    if constexpr (AF32) { _Pragma("unroll") for (int i = 0; i < 8; ++i) af[i] = *(const f32x4*)(Af + (size_t)(16 * i) * lda + (kt) * 64); } \
    else { _Pragma("unroll") for (int i = 0; i < 4; ++i) ab[i] = *(const u32x4*)(Ab + (size_t)(32 * i) * lda + (kt) * 64); } \
    _Pragma("unroll") for (int i = 0; i < 4; ++i) bb[i] = *(const u32x4*)(Bb + (size_t)(32 * i) * K + (kt) * 64); }
#define GEMM_STS(buf) { \
    bf16_t* a_ = As + (buf) * GEMM_BUF; bf16_t* b_ = Bs + (buf) * GEMM_BUF; \
    if constexpr (AF32) { _Pragma("unroll") for (int i = 0; i < 8; ++i) { f32x4 v = af[i]; ss[i] += v.x * v.x + v.y * v.y + v.z * v.z + v.w * v.w; \
        u32x2 pk = {pk2(v.x, v.y), pk2(v.z, v.w)}; *(u32x2*)(a_ + ((t >> 4) + 16 * i) * LDT + (t & 15) * 4) = pk; } } \
    else { _Pragma("unroll") for (int i = 0; i < 4; ++i) *(u32x4*)(a_ + ((t >> 3) + 32 * i) * LDT + (t & 7) * 8) = ab[i]; } \
    _Pragma("unroll") for (int i = 0; i < 4; ++i) *(u32x4*)(b_ + ((t >> 3) + 32 * i) * LDT + (t & 7) * 8) = bb[i]; }
  GEMM_LDG(0);
  GEMM_STS(0);
  __syncthreads();
  for (int kt = 0; kt < nk; ++kt) {
    const int cur = kt & 1;
    if (kt + 1 < nk) GEMM_LDG(kt + 1);
    {
      const bf16_t* a = As + cur * GEMM_BUF + (64 * wm + r) * LDT + 8 * h;
      const bf16_t* b = Bs + cur * GEMM_BUF + (64 * wn + r) * LDT + 8 * h;
#pragma unroll
      for (int ks = 0; ks < 4; ++ks) {
        const bf16x8 a0 = *(const bf16x8*)(a + 16 * ks), a1 = *(const bf16x8*)(a + 32 * LDT + 16 * ks);
        const bf16x8 b0 = *(const bf16x8*)(b + 16 * ks), b1 = *(const bf16x8*)(b + 32 * LDT + 16 * ks);
        acc[0][0] = MFMA32(a0, b0, acc[0][0]); acc[0][1] = MFMA32(a0, b1, acc[0][1]);
        acc[1][0] = MFMA32(a1, b0, acc[1][0]); acc[1][1] = MFMA32(a1, b1, acc[1][1]);
      }
    }
    if (kt + 1 < nk) GEMM_STS(cur ^ 1);
    __syncthreads();
  }
#undef GEMM_LDG
#undef GEMM_STS
  if constexpr (AF32) {
#pragma unroll
    for (int i = 0; i < 8; ++i) {
      float s = ss[i];
      s += __shfl_xor(s, 1); s += __shfl_xor(s, 2); s += __shfl_xor(s, 4); s += __shfl_xor(s, 8);
      if ((t & 15) == 0) rs[(t >> 4) + 16 * i] = rsqrtf(s * (1.0f / 1024.0f) + RMS_EPS);
    }
    __syncthreads();
  }
}

DI void epi_bf16_scaled(const f32x16 (&acc)[2][2], const unsigned char* smem, bf16_t* C, int ldc) {
  const float* rs = (const float*)(smem + SMEM_RSTD);
  const int t = threadIdx.x, lane = t & 63, wid = t >> 6, wm = wid >> 1, wn = wid & 1, r = lane & 31, h = lane >> 5;
#pragma unroll
  for (int mi = 0; mi < 2; ++mi)
#pragma unroll
    for (int i = 0; i < 16; ++i) {
      const int row = 64 * wm + 32 * mi + crow(i, h);
      const float sc = rs[row];
#pragma unroll
      for (int ni = 0; ni < 2; ++ni) C[(size_t)row * ldc + 64 * wn + 32 * ni + r] = bf1(acc[mi][ni][i] * sc);
    }
}
DI void epi_resid(const f32x16 (&acc)[2][2], float* X) {
  const int t = threadIdx.x, lane = t & 63, wid = t >> 6, wm = wid >> 1, wn = wid & 1, r = lane & 31, h = lane >> 5;
#pragma unroll
  for (int mi = 0; mi < 2; ++mi)
#pragma unroll
    for (int i = 0; i < 16; ++i) {
      const int row = 64 * wm + 32 * mi + crow(i, h);
#pragma unroll
      for (int ni = 0; ni < 2; ++ni) { float* px = X + (size_t)row * DM + 64 * wn + 32 * ni + r; *px = *px + acc[mi][ni][i]; }
    }
}

template <int D, class F>
DI void attn_tile(const bf16_t* Ks, const bf16_t* Vt, const bf16x8 (&qf)[D / 16], f32x16 (&o)[D / 32], float& m, float& l, F fn, int r, int h) {
  f32x16 s;
#pragma unroll
  for (int i = 0; i < 16; ++i) s[i] = 0.f;
#pragma unroll
  for (int ks = 0; ks < D / 16; ++ks) { const bf16x8 a = *(const bf16x8*)(Ks + r * (D + 8) + 16 * ks + 8 * h); s = MFMA32(a, qf[ks], s); }
  float mx = -INFINITY;
#pragma unroll
  for (int i = 0; i < 16; ++i) { s[i] = fn(s[i], i); mx = fmaxf(mx, s[i]); }
  mx = fmaxf(mx, __shfl_xor(mx, 32));
  const float mn = fmaxf(m, mx);
  const float alpha = __builtin_amdgcn_exp2f(m - mn);
  m = mn;
  float sum = 0.f;
#pragma unroll
  for (int i = 0; i < 16; ++i) { s[i] = __builtin_amdgcn_exp2f(s[i] - mn); sum += s[i]; }
  l = l * alpha + sum;
#pragma unroll
  for (int dt = 0; dt < D / 32; ++dt)
#pragma unroll
    for (int i = 0; i < 16; ++i) o[dt][i] *= alpha;
  bf16x8 pf[2];
#pragma unroll
  for (int s2 = 0; s2 < 2; ++s2) {
    u32x4 pk = {pk2(s[8 * s2], s[8 * s2 + 1]), pk2(s[8 * s2 + 2], s[8 * s2 + 3]), pk2(s[8 * s2 + 4], s[8 * s2 + 5]), pk2(s[8 * s2 + 6], s[8 * s2 + 7])};
    pf[s2] = __builtin_bit_cast(bf16x8, pk);
  }
#pragma unroll
  for (int dt = 0; dt < D / 32; ++dt)
#pragma unroll
    for (int s2 = 0; s2 < 2; ++s2) {
      const bf16_t* vp = Vt + (32 * dt + r) * 40 + 16 * s2 + 4 * h;
      const s16x4 lo = *(const s16x4*)vp, hi = *(const s16x4*)(vp + 8);
      const bf16x8 a = __builtin_shufflevector(lo, hi, 0, 1, 2, 3, 4, 5, 6, 7);
      o[dt] = MFMA32(a, pf[s2], o[dt]);
    }
}
DI void vt_store(bf16_t* Vt, u32x4 v, int c8, int kk) {
#pragma unroll
  for (int e = 0; e < 8; ++e) Vt[(8 * c8 + e) * 40 + kk] = (bf16_t)((v[e >> 1] >> (16 * (e & 1))) & 0xffffu);
}
template <int ND>
DI void attn_out(const f32x16 (&o)[ND], float l, bf16_t* yp, int h) {
  const float lt = l + __shfl_xor(l, 32);
  const float inv = 1.0f / lt;
#pragma unroll
  for (int dt = 0; dt < ND; ++dt)
#pragma unroll
    for (int g = 0; g < 4; ++g) {
      u32x2 v = {pk2(o[dt][4 * g] * inv, o[dt][4 * g + 1] * inv), pk2(o[dt][4 * g + 2] * inv, o[dt][4 * g + 3] * inv)};
      *(u32x2*)(yp + 32 * dt + 8 * g + 4 * h) = v;
    }
}

constexpr int AT64_BUF = 32 * 72 + 64 * 40;
DI void swa_item(const Params& p, int l, int item, unsigned char* smem) {
  const int t = threadIdx.x, lane = t & 63, w = t >> 6, r = lane & 31, h = lane >> 5;
  const int head = item % 6, n = (item / 6) & 63, b = item / 384, hkv = head / 3;
  bf16_t* st = (bf16_t*)smem;
  float* bt = (float*)(smem + 2 * AT64_BUF * 2);
  __syncthreads();
  for (int i = t; i < 257; i += 256) bt[i] = p.t5_bias[T5TAB[i] * 6 + head] * LOG2E;
  const size_t tok0 = (size_t)b * SEQ;
  const int q0 = n * 128 + 32 * w;
  bf16x8 qf[4];
  { const bf16_t* qp = p.z + (tok0 + q0 + r) * IN_DIM + Z_SWQ + head * 64 + 8 * h;
#pragma unroll
    for (int ks = 0; ks < 4; ++ks) qf[ks] = *(const bf16x8*)(qp + 16 * ks); }
  f32x16 o[2];
#pragma unroll
  for (int dt = 0; dt < 2; ++dt)
#pragma unroll
    for (int i = 0; i < 16; ++i) o[dt][i] = 0.f;
  float m = p.swa_sink[l * 6 + head] * LOG2E, lsum = (h == 0) ? 1.f : 0.f;
  const int kt_lo = (n == 0) ? 4 : 0, kt_hi = (n == 63) ? 8 : 12;
  const int kk = t >> 3, c8 = t & 7;
  const bf16_t* kbase = p.z + (tok0 + (size_t)(n * 128 + kk)) * IN_DIM + Z_SWK + hkv * 64 + 8 * c8;
  u32x4 kr, vr;
  { const bf16_t* kp = kbase + (ptrdiff_t)(32 * kt_lo - 128) * IN_DIM; kr = *(const u32x4*)kp; vr = *(const u32x4*)(kp + 128); }
  *(u32x4*)(st + kk * 72 + 8 * c8) = kr; vt_store(st + 32 * 72, vr, c8, kk);
  __syncthreads();
  const float sc2 = 0.125f * LOG2E;
  for (int kt = kt_lo; kt < kt_hi; ++kt) {
    const int cur = (kt - kt_lo) & 1;
    if (kt + 1 < kt_hi) { const bf16_t* kp = kbase + (ptrdiff_t)(32 * (kt + 1) - 128) * IN_DIM; kr = *(const u32x4*)kp; vr = *(const u32x4*)(kp + 128); }
    if (kt >= w && kt <= w + 8) {
      const int kb = 32 * kt - 128 - 32 * w - r + 4 * h;
      attn_tile<64>(st + cur * AT64_BUF, st + cur * AT64_BUF + 32 * 72, qf, o, m, lsum,
        [&](float sv, int i) { const int oi = kb + (i & 3) + 8 * (i >> 2) + 128; const bool ok = (unsigned)oi <= 256u; const float bias = bt[ok ? oi : 0]; return ok ? sv * sc2 + bias : -INFINITY; }, r, h);
    }
    if (kt + 1 < kt_hi) { bf16_t* sb = st + (cur ^ 1) * AT64_BUF; *(u32x4*)(sb + kk * 72 + 8 * c8) = kr; vt_store(sb + 32 * 72, vr, c8, kk); }
    __syncthreads();
  }
  attn_out<2>(o, lsum, p.ymix + (tok0 + q0 + r) * DM + 640 + head * 64, h);
}

DI void na_item(const Params& p, int l, int item, unsigned char* smem) {
  const int t = threadIdx.x, lane = t & 63, w = t >> 6, r = lane & 31, h = lane >> 5;
  const int hp = item % 3, rr = (item / 3) & 127, b = item / 384;
  const int hh = w >> 1, qh = w & 1, head = 2 * hp + hh;
  bf16_t* st = (bf16_t*)smem;
  constexpr int NBUF = 2 * AT64_BUF;
  float* bt = (float*)(smem + 2 * NBUF * 2);
  __syncthreads();
  for (int i = t; i < 930; i += 256) { const int e = i % 465, hsel = i / 465; bt[i] = p.na_rpb[((size_t)l * 465 + e) * 6 + 2 * hp + hsel] * LOG2E; }
  const size_t tok0 = (size_t)b * SEQ;
  const int r0 = min(max(rr - 4, 0), 120);
  const int c = 32 * qh + r;
  bf16x8 qf[4];
  { const bf16_t* qp = p.z + (tok0 + rr * 64 + c) * IN_DIM + Z_NAQ + head * 64 + 8 * h;
#pragma unroll
    for (int ks = 0; ks < 4; ++ks) qf[ks] = *(const bf16x8*)(qp + 16 * ks); }
  f32x16 o[2];
#pragma unroll
  for (int dt = 0; dt < 2; ++dt)
#pragma unroll
    for (int i = 0; i < 16; ++i) o[dt][i] = 0.f;
  float m = -1e30f, lsum = 0.f;
  const int kk = t >> 3, c8 = t & 7;
  const bf16_t* kbase = p.z + (tok0 + (size_t)((r0 + (kk >> 4)) * 64 + (kk & 15))) * IN_DIM + Z_NAK + (2 * hp) * 64 + 8 * c8;
  u32x4 k0r, k1r, v0r, v1r;
#define NA_LDG(kt) { const bf16_t* kp = kbase + (size_t)(((kt) >> 2) * 128 + ((kt) & 3) * 16) * IN_DIM; \
    k0r = *(const u32x4*)kp; k1r = *(const u32x4*)(kp + 64); v0r = *(const u32x4*)(kp + 384); v1r = *(const u32x4*)(kp + 448); }
#define NA_STS(buf) { bf16_t* sb = st + (buf) * NBUF; *(u32x4*)(sb + kk * 72 + 8 * c8) = k0r; *(u32x4*)(sb + AT64_BUF + kk * 72 + 8 * c8) = k1r; \
    vt_store(sb + 32 * 72, v0r, c8, kk); vt_store(sb + AT64_BUF + 32 * 72, v1r, c8, kk); }
  NA_LDG(0);
  NA_STS(0);
  __syncthreads();
  const float sc2 = 0.125f * LOG2E;
  const int c0 = min(max(c - 8, 0), 48);
  const float* bth = bt + hh * 465;
  for (int kt = 0; kt < 16; ++kt) {
    const int cur = kt & 1;
    if (kt + 1 < 16) NA_LDG(kt + 1);
    const int rp = kt >> 2, cb = kt & 3;
    if (cb >= qh && cb <= qh + 2) {
      const bf16_t* sb = st + cur * NBUF + hh * AT64_BUF;
      const int drb = r0 + 2 * rp - rr + 7;
      const int kcb = 16 * cb;
      attn_tile<64>(sb, sb + 32 * 72, qf, o, m, lsum,
        [&](float sv, int i) { const int kq = (i & 3) + 8 * (i >> 2) + 4 * h; const int kcol = kcb + (kq & 15); const int dr = drb + (kq >> 4);
          const bool ok = (kcol >= c0) && (kcol < c0 + 16); const int bi = dr * 31 + (kcol - c + 15); const float bias = bth[ok ? bi : 0];
          return ok ? sv * sc2 + bias : -INFINITY; }, r, h);
    }
    if (kt + 1 < 16) NA_STS(cur ^ 1);
    __syncthreads();
  }
#undef NA_LDG
#undef NA_STS
  attn_out<2>(o, lsum, p.ymix + (tok0 + rr * 64 + c) * DM + head * 64, h);
}

DI void conv_item(const Params& p, int l, int item) {
  const int t = threadIdx.x;
  const size_t tok = (size_t)item * 8 + (t >> 5);
  const int c8 = t & 31, pos = (int)(tok & (SEQ - 1));
  const bf16_t* zr = p.z + tok * IN_DIM + 8 * c8;
  const u32x4 bv = *(const u32x4*)(zr + Z_SCB);
  const u32x4 cc = *(const u32x4*)(zr + Z_SCC), hc = *(const u32x4*)(zr + Z_SCH);
  u32x4 cm = {0, 0, 0, 0}, hm = {0, 0, 0, 0}, cp = {0, 0, 0, 0}, hpv = {0, 0, 0, 0};
  if (pos > 0) { cm = *(const u32x4*)(zr - IN_DIM + Z_SCC); hm = *(const u32x4*)(zr - IN_DIM + Z_SCH); }
  if (pos < SEQ - 1) { cp = *(const u32x4*)(zr + IN_DIM + Z_SCC); hpv = *(const u32x4*)(zr + IN_DIM + Z_SCH); }
  const float* cw = p.conv_w + (size_t)l * 3 * 256 + 8 * c8;
  float y[8];
#pragma unroll
  for (int e = 0; e < 8; ++e) {
    const int wd = e >> 1;
    const float fb = (e & 1) ? bf_hi(bv[wd]) : bf_lo(bv[wd]);
    const float um = ((e & 1) ? bf_hi(cm[wd]) : bf_lo(cm[wd])) * ((e & 1) ? bf_hi(hm[wd]) : bf_lo(hm[wd]));
    const float uc = ((e & 1) ? bf_hi(cc[wd]) : bf_lo(cc[wd])) * ((e & 1) ? bf_hi(hc[wd]) : bf_lo(hc[wd]));
    const float up = ((e & 1) ? bf_hi(cp[wd]) : bf_lo(cp[wd])) * ((e & 1) ? bf_hi(hpv[wd]) : bf_lo(hpv[wd]));
    y[e] = fb * (um * cw[e] + uc * cw[256 + e] + up * cw[512 + e]);
  }
  u32x4 ov = {pk2(y[0], y[1]), pk2(y[2], y[3]), pk2(y[4], y[5]), pk2(y[6], y[7])};
  *(u32x4*)(p.ymix + tok * DM + 384 + 8 * c8) = ov;
}

constexpr int AT128_BUF = 32 * 136 + 128 * 40;
DI void xattn_item(const Params& p, int l, int item, unsigned char* smem) {
  const int t = threadIdx.x, lane = t & 63, w = t >> 6, r = lane & 31, h = lane >> 5;
  const int qt = item & 63, head = (item >> 6) & 3, b = item >> 8;
  bf16_t* st = (bf16_t*)smem;
  const size_t tok = (size_t)b * SEQ + qt * 128 + 32 * w + r;
  bf16x8 qf[8];
  { const bf16_t* qp = p.q + tok * 512 + head * 128 + 8 * h;
#pragma unroll
    for (int ks = 0; ks < 8; ++ks) qf[ks] = *(const bf16x8*)(qp + 16 * ks); }
  f32x16 o[4];
#pragma unroll
  for (int dt = 0; dt < 4; ++dt)
#pragma unroll
    for (int i = 0; i < 16; ++i) o[dt][i] = 0.f;
  float m = -1e30f, lsum = 0.f;
  const int kk = t >> 4, c8 = t & 15;
  const bf16_t* kbase = p.memkv + ((size_t)l * 2560 + (size_t)b * 256 + kk) * 1024 + head * 128 + 8 * c8;
  u32x4 k0r, k1r, v0r, v1r;
#define XA_LDG(kt) { const bf16_t* kp = kbase + (size_t)(32 * (kt)) * 1024; \
    k0r = *(const u32x4*)kp; k1r = *(const u32x4*)(kp + 16 * 1024); v0r = *(const u32x4*)(kp + 512); v1r = *(const u32x4*)(kp + 16 * 1024 + 512); }
#define XA_STS(buf) { bf16_t* sb = st + (buf) * AT128_BUF; *(u32x4*)(sb + kk * 136 + 8 * c8) = k0r; *(u32x4*)(sb + (kk + 16) * 136 + 8 * c8) = k1r; \
    vt_store(sb + 32 * 136, v0r, c8, kk); vt_store(sb + 32 * 136, v1r, c8, kk + 16); }
  __syncthreads();
  XA_LDG(0);
  XA_STS(0);
  __syncthreads();
  const float sc2 = 0.08838834764831845f * LOG2E;
  for (int kt = 0; kt < 8; ++kt) {
    const int cur = kt & 1;
    if (kt + 1 < 8) XA_LDG(kt + 1);
    { const bf16_t* sb = st + cur * AT128_BUF;
      attn_tile<128>(sb, sb + 32 * 136, qf, o, m, lsum, [&](float sv, int) { return sv * sc2; }, r, h); }
    if (kt + 1 < 8) XA_STS(cur ^ 1);
    __syncthreads();
  }
#undef XA_LDG
#undef XA_STS
  attn_out<4>(o, lsum, p.o + tok * 512 + head * 128, h);
}

DI void transpose_job(const float* __restrict__ src, int K, int N, const float* __restrict__ g, bf16_t* __restrict__ dst, unsigned char* smem) {
  float* tl = (float*)smem;
  const int tn = N / 64, ntile = (K / 64) * tn, t = threadIdx.x;
  for (int tile = blockIdx.x; tile < ntile; tile += gridDim.x) {
    const int k0 = (tile / tn) * 64, n0 = (tile % tn) * 64;
    __syncthreads();
#pragma unroll 4
    for (int i = 0; i < 16; ++i) { const int kk = (t >> 6) + 4 * i; float v = src[(size_t)(k0 + kk) * N + n0 + (t & 63)]; if (g) v *= g[k0 + kk]; tl[kk * 65 + (t & 63)] = v; }
    __syncthreads();
#pragma unroll 4
    for (int i = 0; i < 16; ++i) { const int nn = (t >> 6) + 4 * i; dst[(size_t)(n0 + nn) * K + k0 + (t & 63)] = bf1(tl[(t & 63) * 65 + nn]); }
  }
}
DI void convert_job(const float* __restrict__ src, bf16_t* __restrict__ dst, size_t n4) {
  for (size_t i = (size_t)blockIdx.x * 256 + threadIdx.x; i < n4; i += (size_t)gridDim.x * 256) {
    const f32x4 v = ((const f32x4*)src)[i];
    u32x2 o = {pk2(v.x, v.y), pk2(v.z, v.w)};
    ((u32x2*)dst)[i] = o;
  }
}

DI void phase_prologue(const Params& p, unsigned char* smem) {
  { const size_t n4p = (size_t)16384 * 256, n4 = (size_t)T * 256;
    for (size_t i = (size_t)blockIdx.x * 256 + threadIdx.x; i < n4; i += (size_t)gridDim.x * 256)
      ((f32x4*)p.x)[i] = (i < n4p) ? ((const f32x4*)p.x_prompt)[i] : ((const f32x4*)p.x_sample)[i - n4p]; }
  for (int l = 0; l < 2; ++l) {
    transpose_job(p.w_in + (size_t)l * 1024 * 2560, 1024, 2560, p.norm_mix_g + l * 1024, p.w_inT + (size_t)l * 2560 * 1024, smem);
    transpose_job(p.w_out + (size_t)l * 1024 * 1024, 1024, 1024, nullptr, p.w_outT + (size_t)l * 1024 * 1024, smem);
    transpose_job(p.w_xq + (size_t)l * 1024 * 512, 1024, 512, p.norm_xa_g + l * 1024, p.w_xqT + (size_t)l * 512 * 1024, smem);
    transpose_job(p.w_xk + (size_t)l * 1024 * 512, 1024, 512, p.norm_mem_g + l * 1024, p.w_xkvT + (size_t)l * 1024 * 1024, smem);
    transpose_job(p.w_xv + (size_t)l * 1024 * 512, 1024, 512, p.norm_mem_g + l * 1024, p.w_xkvT + (size_t)l * 1024 * 1024 + (size_t)512 * 1024, smem);
    transpose_job(p.w_xo + (size_t)l * 512 * 1024, 512, 1024, nullptr, p.w_xoT + (size_t)l * 1024 * 512, smem);
    transpose_job(p.peer_wq + (size_t)l * 1024 * 2048, 1024, 2048, p.norm_ffn_g + l * 1024, p.w_pqT + (size_t)l * 2048 * 1024, smem);
  }
  convert_job(p.peer_subkeys, p.subk, (size_t)2 * 8 * 2 * 128 * 128 / 4);
  convert_job(p.peer_u, p.pu, (size_t)2 * 16384 * 1024 / 4);
  convert_job(p.peer_v, p.pv, (size_t)2 * 16384 * 1024 / 4);
}

#define TILE_WALK(NT, MT8) const int nx_ = gridDim.x >> 3, xcd_ = blockIdx.x & 7; \
  for (int j_ = blockIdx.x >> 3; j_ < (MT8) * (NT); j_ += nx_) { const int mt = (j_ / (NT)) * 8 + xcd_, nt = j_ % (NT);

DI void phase_in_gemm(const Params& p, int l, unsigned char* smem) {
  f32x16 acc[2][2];
  { TILE_WALK(20, 80)
    gemm_tile<true>(p.x + (size_t)mt * 128 * DM, DM, p.w_inT + ((size_t)l * 2560 + nt * 128) * 1024, 1024, smem, acc);
    epi_bf16_scaled(acc, smem, p.z + (size_t)mt * 128 * IN_DIM + nt * 128, IN_DIM);
  } }
  if (l == 0) {
    for (int j = blockIdx.x; j < 20 * 8 * 2; j += gridDim.x) {
      const int ll = j / 160, mt = (j % 160) >> 3, nt = j & 7, b = mt >> 1;
      const float* A = (b < 2 ? p.mem_prompt + (size_t)b * 256 * DM : p.mem_sample + (size_t)(b - 2) * 256 * DM) + (size_t)(mt & 1) * 128 * DM;
      gemm_tile<true>(A, DM, p.w_xkvT + ((size_t)ll * 1024 + nt * 128) * 1024, 1024, smem, acc);
      epi_bf16_scaled(acc, smem, p.memkv + ((size_t)ll * 2560 + mt * 128) * 1024 + nt * 128, 1024);
    }
  }
}
DI void phase_out_gemm(const Params& p, int l, unsigned char* smem) {
  f32x16 acc[2][2];
  TILE_WALK(8, 80)
    gemm_tile<false>(p.ymix + (size_t)mt * 128 * DM, DM, p.w_outT + ((size_t)l * 1024 + nt * 128) * 1024, 1024, smem, acc);
    epi_resid(acc, p.x + (size_t)mt * 128 * DM + nt * 128);
  }
}
DI void phase_xq_gemm(const Params& p, int l, unsigned char* smem) {
  f32x16 acc[2][2];
  TILE_WALK(4, 80)
    gemm_tile<true>(p.x + (size_t)mt * 128 * DM, DM, p.w_xqT + ((size_t)l * 512 + nt * 128) * 1024, 1024, smem, acc);
    epi_bf16_scaled(acc, smem, p.q + (size_t)mt * 128 * 512 + nt * 128, 512);
  }
}
DI void phase_xo_gemm(const Params& p, int l, unsigned char* smem) {
  f32x16 acc[2][2];
  TILE_WALK(8, 80)
    gemm_tile<false>(p.o + (size_t)mt * 128 * 512, 512, p.w_xoT + ((size_t)l * 1024 + nt * 128) * 512, 512, smem, acc);
    epi_resid(acc, p.x + (size_t)mt * 128 * DM + nt * 128);
  }
}
DI void phase_peer_q(const Params& p, int l, unsigned char* smem) {
  f32x16 acc[2][2];
  const int t = threadIdx.x, lane = t & 63, wid = t >> 6, wm = wid >> 1, wn = wid & 1, r = lane & 31, h = lane >> 5;
  const float* rs = (const float*)(smem + SMEM_RSTD);
  bf16_t* Qs = (bf16_t*)smem; bf16_t* SKs = Qs + 128 * 136;
  TILE_WALK(16, 80)
    gemm_tile<true>(p.x + (size_t)mt * 128 * DM, DM, p.w_pqT + ((size_t)l * 2048 + nt * 128) * 1024, 1024, smem, acc);
#pragma unroll
    for (int mi = 0; mi < 2; ++mi)
#pragma unroll
      for (int i = 0; i < 16; ++i) {
        const int row = 64 * wm + 32 * mi + crow(i, h);
        const float sc = rs[row];
#pragma unroll
        for (int ni = 0; ni < 2; ++ni) Qs[row * 136 + 64 * wn + 32 * ni + r] = bf1(acc[mi][ni][i] * sc);
      }
    { const bf16_t* sk = p.subk + ((size_t)(l * 16 + nt) * 128) * 128;
#pragma unroll
      for (int i = 0; i < 8; ++i) { const int row = (t >> 4) + 16 * i, c8 = t & 15; *(u32x4*)(SKs + row * 136 + 8 * c8) = *(const u32x4*)(sk + row * 128 + 8 * c8); } }
    __syncthreads();
    f32x16 sc[4];
#pragma unroll
    for (int n4 = 0; n4 < 4; ++n4)
#pragma unroll
      for (int i = 0; i < 16; ++i) sc[n4][i] = 0.f;
#pragma unroll
    for (int ks = 0; ks < 8; ++ks) {
      const bf16x8 bq = *(const bf16x8*)(Qs + (32 * wid + r) * 136 + 16 * ks + 8 * h);
#pragma unroll
      for (int n4 = 0; n4 < 4; ++n4) { const bf16x8 a = *(const bf16x8*)(SKs + (32 * n4 + r) * 136 + 16 * ks + 8 * h); sc[n4] = MFMA32(a, bq, sc[n4]); }
    }
    __syncthreads();
#pragma unroll
    for (int n4 = 0; n4 < 4; ++n4)
#pragma unroll
      for (int i = 0; i < 16; ++i) sc[n4][i] = __uint_as_float((__float_as_uint(sc[n4][i]) & ~127u) | (unsigned)(32 * n4 + crow(i, h)));
    float res[16];
#pragma unroll
    for (int rd = 0; rd < 16; ++rd) {
      float mx = -INFINITY;
#pragma unroll
      for (int n4 = 0; n4 < 4; ++n4)
#pragma unroll
        for (int i = 0; i < 16; ++i) mx = fmaxf(mx, sc[n4][i]);
      const float M = fmaxf(mx, __shfl_xor(mx, 32));
      res[rd] = M;
#pragma unroll
      for (int n4 = 0; n4 < 4; ++n4)
#pragma unroll
        for (int i = 0; i < 16; ++i) sc[n4][i] = (sc[n4][i] == M) ? -INFINITY : sc[n4][i];
    }
    if (h == 0) {
      float* dst = p.topS + (((size_t)mt * 128 + 32 * wid + r) * 16 + nt) * 16;
#pragma unroll
      for (int g = 0; g < 4; ++g) { f32x4 v = {res[4 * g], res[4 * g + 1], res[4 * g + 2], res[4 * g + 3]}; *(f32x4*)(dst + 4 * g) = v; }
    }
  }
}

DI void phase_peer_experts(const Params& p, int l, bool last) {
  const int lane = threadIdx.x & 63, wid = threadIdx.x >> 6;
  const bf16_t* pu = p.pu + (size_t)l * 16384 * 1024;
  const bf16_t* pv = p.pv + (size_t)l * 16384 * 1024;
  const float* gf = p.norm_ffn_g + l * 1024;
  f32x4 gv[4];
  gv[0] = *(const f32x4*)(gf + 8 * lane); gv[1] = *(const f32x4*)(gf + 8 * lane + 4); gv[2] = *(const f32x4*)(gf + 512 + 8 * lane); gv[3] = *(const f32x4*)(gf + 512 + 8 * lane + 4);
  const int pr = PAIRTAB[lane], ci = pr >> 4, cj = pr & 15;
  for (int tok = blockIdx.x * 4 + wid; tok < T; tok += gridDim.x * 4) {
    float* xr = p.x + (size_t)tok * DM;
    f32x4 xa[4];
    xa[0] = *(const f32x4*)(xr + 8 * lane); xa[1] = *(const f32x4*)(xr + 8 * lane + 4); xa[2] = *(const f32x4*)(xr + 512 + 8 * lane); xa[3] = *(const f32x4*)(xr + 512 + 8 * lane + 4);
    float ss = 0.f;
#pragma unroll
    for (int k = 0; k < 4; ++k) ss += xa[k].x * xa[k].x + xa[k].y * xa[k].y + xa[k].z * xa[k].z + xa[k].w * xa[k].w;
    ss = wave_sum(ss);
    const float rstd = rsqrtf(ss * (1.0f / 1024.0f) + RMS_EPS);
    float xn[16], out[16];
#pragma unroll
    for (int k = 0; k < 4; ++k) { xn[4 * k] = xa[k].x * rstd * gv[k].x; xn[4 * k + 1] = xa[k].y * rstd * gv[k].y; xn[4 * k + 2] = xa[k].z * rstd * gv[k].z; xn[4 * k + 3] = xa[k].w * rstd * gv[k].w; }
#pragma unroll
    for (int k = 0; k < 16; ++k) out[k] = 0.f;
    const float* ts = p.topS + (size_t)tok * 256;
    for (int hd = 0; hd < 8; ++hd) {
      const float sa = ts[hd * 32 + ci], sb = ts[hd * 32 + 16 + cj];
      const float val = (lane < 50) ? sa + sb : -INFINITY;
      const int idx = (int)((__float_as_uint(sa) & 127u) * 128u + (__float_as_uint(sb) & 127u));
      int rank = 0;
#pragma unroll
      for (int c = 0; c < 50; ++c) { const float vc = rdlane_f(val, c); rank += ((vc > val) || (vc == val && c < lane)) ? 1 : 0; }
      const bool selected = (rank < 16) && (lane < 50);
      unsigned long long sel = __ballot(selected);
      const float vmax = rdlane_f(val, 0);
      const float e = selected ? __expf(val - vmax) : 0.f;
      const float esum = wave_sum(e);
      const float gate = e / esum;
      int src[16];
#pragma unroll
      for (int rd = 0; rd < 16; ++rd) { src[rd] = __ffsll((long long)sel) - 1; sel &= sel - 1; }
      float dots[16];
#pragma unroll
      for (int half = 0; half < 2; ++half) {
        u32x4 u0[8], u1[8];
#pragma unroll
        for (int k = 0; k < 8; ++k) {
          const int ex = __builtin_amdgcn_readlane(idx, src[half * 8 + k]);
          const bf16_t* row = pu + (size_t)ex * 1024 + 8 * lane;
          u0[k] = *(const u32x4*)row; u1[k] = *(const u32x4*)(row + 512);
        }
#pragma unroll
        for (int k = 0; k < 8; ++k) {
          float d = 0.f;
#pragma unroll
          for (int e2 = 0; e2 < 4; ++e2) { d += bf_lo(u0[k][e2]) * xn[2 * e2] + bf_hi(u0[k][e2]) * xn[2 * e2 + 1]; d += bf_lo(u1[k][e2]) * xn[8 + 2 * e2] + bf_hi(u1[k][e2]) * xn[8 + 2 * e2 + 1]; }
          dots[half * 8 + k] = wave_sum(d);
        }
      }
      float myd = dots[0];
#pragma unroll
      for (int rd = 1; rd < 16; ++rd) myd = ((lane & 15) == rd) ? dots[rd] : myd;
      const float act = 0.5f * myd * (1.0f + erff(myd * 0.70710678118654752f));
      float wv[16];
#pragma unroll
      for (int rd = 0; rd < 16; ++rd) wv[rd] = rdlane_f(gate, src[rd]) * rdlane_f(act, rd);
#pragma unroll
      for (int half = 0; half < 2; ++half) {
        u32x4 u0[8], u1[8];
#pragma unroll
        for (int k = 0; k < 8; ++k) {
          const int ex = __builtin_amdgcn_readlane(idx, src[half * 8 + k]);
          const bf16_t* row = pv + (size_t)ex * 1024 + 8 * lane;
          u0[k] = *(const u32x4*)row; u1[k] = *(const u32x4*)(row + 512);
        }
#pragma unroll
        for (int k = 0; k < 8; ++k) {
          const float wk = wv[half * 8 + k];
#pragma unroll
          for (int e2 = 0; e2 < 4; ++e2) {
            out[2 * e2] += wk * bf_lo(u0[k][e2]); out[2 * e2 + 1] += wk * bf_hi(u0[k][e2]);
            out[8 + 2 * e2] += wk * bf_lo(u1[k][e2]); out[8 + 2 * e2 + 1] += wk * bf_hi(u1[k][e2]);
          }
        }
      }
    }
    f32x4 xo[4];
#pragma unroll
    for (int k = 0; k < 4; ++k) { xo[k].x = xa[k].x + out[4 * k]; xo[k].y = xa[k].y + out[4 * k + 1]; xo[k].z = xa[k].z + out[4 * k + 2]; xo[k].w = xa[k].w + out[4 * k + 3]; }
    if (last) {
      float s2 = 0.f;
#pragma unroll
      for (int k = 0; k < 4; ++k) s2 += xo[k].x * xo[k].x + xo[k].y * xo[k].y + xo[k].z * xo[k].z + xo[k].w * xo[k].w;
      s2 = wave_sum(s2);
      const float r2 = rsqrtf(s2 * (1.0f / 1024.0f) + RMS_EPS);
      const float* fg = p.final_g;
      const f32x4 f0 = *(const f32x4*)(fg + 8 * lane), f1 = *(const f32x4*)(fg + 8 * lane + 4), f2 = *(const f32x4*)(fg + 512 + 8 * lane), f3 = *(const f32x4*)(fg + 512 + 8 * lane + 4);
      xo[0] = xo[0] * r2 * f0; xo[1] = xo[1] * r2 * f1; xo[2] = xo[2] * r2 * f2; xo[3] = xo[3] * r2 * f3;
    }
    *(f32x4*)(xr + 8 * lane) = xo[0]; *(f32x4*)(xr + 8 * lane + 4) = xo[1]; *(f32x4*)(xr + 512 + 8 * lane) = xo[2]; *(f32x4*)(xr + 512 + 8 * lane + 4) = xo[3];
  }
}

DI void run_phase(const Params& p, int ph, unsigned char* smem) {
  if (ph == 0) { phase_prologue(p, smem); return; }
  const int l = (ph - 1) >> 3, s = (ph - 1) & 7;
  switch (s) {
    case 0: phase_in_gemm(p, l, smem); break;
    case 1:
      for (int it = blockIdx.x; it < 3840; it += gridDim.x) na_item(p, l, it, smem);
      for (int it = blockIdx.x; it < 3840; it += gridDim.x) swa_item(p, l, it, smem);
      for (int it = blockIdx.x; it < 10240; it += gridDim.x) conv_item(p, l, it);
      break;
    case 2: phase_out_gemm(p, l, smem); break;
    case 3: phase_xq_gemm(p, l, smem); break;
    case 4: for (int it = blockIdx.x; it < 2560; it += gridDim.x) xattn_item(p, l, it, smem); break;
    case 5: phase_xo_gemm(p, l, smem); break;
    case 6: phase_peer_q(p, l, smem); break;
    case 7: phase_peer_experts(p, l, l == 1); break;
  }
}
#if ONE_LAUNCH
__global__ void __launch_bounds__(256, 2) fwd(Params p) {
  __shared__ __attribute__((aligned(16))) unsigned char smem[SMEM_BYTES];
  cg::grid_group grid = cg::this_grid();
  for (int ph = 0; ph < NPHASE; ++ph) {
    if (ph > 0) grid.sync();
    run_phase(p, ph, smem);
  }
}
#else
#define DK(name, body) __global__ void __launch_bounds__(256, 2) name(Params p, int l) { __shared__ __attribute__((aligned(16))) unsigned char smem[SMEM_BYTES]; body; }
DK(k_prologue, phase_prologue(p, smem))
DK(k_in_gemm, phase_in_gemm(p, l, smem))
DK(k_na, for (int it = blockIdx.x; it < 3840; it += gridDim.x) na_item(p, l, it, smem))
DK(k_swa, for (int it = blockIdx.x; it < 3840; it += gridDim.x) swa_item(p, l, it, smem))
DK(k_conv, for (int it = blockIdx.x; it < 10240; it += gridDim.x) conv_item(p, l, it))
DK(k_out_gemm, phase_out_gemm(p, l, smem))
DK(k_xq_gemm, phase_xq_gemm(p, l, smem))
DK(k_xattn, for (int it = blockIdx.x; it < 2560; it += gridDim.x) xattn_item(p, l, it, smem))
DK(k_xo_gemm, phase_xo_gemm(p, l, smem))
DK(k_peer_q, phase_peer_q(p, l, smem))
DK(k_peer_e, phase_peer_experts(p, l, l == 1))
#endif

extern "C" void kernel_launch(void* const* d_in, const int* in_sizes, int n_in, void* d_out, int out_size, void* d_ws, size_t ws_size, hipStream_t stream) {
  static int grid_blocks = 0;
  if (!grid_blocks) {
    int dev = 0, cus = 0, per_cu = 2;
    (void)hipGetDevice(&dev);
    (void)hipDeviceGetAttribute(&cus, hipDeviceAttributeMultiprocessorCount, dev);
#if ONE_LAUNCH
    (void)hipOccupancyMaxActiveBlocksPerMultiprocessor(&per_cu, fwd, 256, 0);
#endif
    if (per_cu > 2) per_cu = 2;
    if (per_cu < 1) per_cu = 1;
    grid_blocks = cus * per_cu;
    grid_blocks -= grid_blocks % 8;
  }
  Params p{};
  const float* const* in = (const float* const*)d_in;
  p.x_prompt = in[0]; p.x_sample = in[1]; p.mem_prompt = in[2]; p.mem_sample = in[3];
  p.norm_mix_g = in[4]; p.w_in = in[5]; p.na_rpb = in[6]; p.conv_w = in[7]; p.swa_sink = in[8]; p.t5_bias = in[9];
  p.w_out = in[10]; p.norm_xa_g = in[11]; p.norm_mem_g = in[12]; p.w_xq = in[13]; p.w_xk = in[14]; p.w_xv = in[15]; p.w_xo = in[16];
  p.norm_ffn_g = in[17]; p.peer_wq = in[18]; p.peer_subkeys = in[19]; p.peer_u = in[20]; p.peer_v = in[21]; p.final_g = in[22];
  p.x = (float*)d_out;
  unsigned char* ws = (unsigned char*)d_ws;
  size_t off = 0;
  auto take = [&](size_t bytes) { unsigned char* r = ws + off; off += (bytes + 255) & ~(size_t)255; return r; };
  p.z = (bf16_t*)take((size_t)T * IN_DIM * 2);
  p.q = p.z;
  p.o = p.z + (size_t)T * 512;
  p.topS = (float*)(p.z + (size_t)T * 1024);
  p.ymix = (bf16_t*)take((size_t)T * DM * 2);
  p.w_inT = (bf16_t*)take((size_t)2 * 2560 * 1024 * 2);
  p.w_outT = (bf16_t*)take((size_t)2 * 1024 * 1024 * 2);
  p.w_xqT = (bf16_t*)take((size_t)2 * 512 * 1024 * 2);
  p.w_xkvT = (bf16_t*)take((size_t)2 * 1024 * 1024 * 2);
  p.w_xoT = (bf16_t*)take((size_t)2 * 1024 * 512 * 2);
  p.w_pqT = (bf16_t*)take((size_t)2 * 2048 * 1024 * 2);
  p.subk = (bf16_t*)take((size_t)2 * 8 * 2 * 128 * 128 * 2);
  p.pu = (bf16_t*)take((size_t)2 * 16384 * 1024 * 2);
  p.pv = (bf16_t*)take((size_t)2 * 16384 * 1024 * 2);
  p.memkv = (bf16_t*)take((size_t)2 * 2560 * 1024 * 2);
  if (off > ws_size) { fprintf(stderr, "workspace too small: need %zu have %zu\n", off, ws_size); return; }
#if ONE_LAUNCH
  void* args[] = {&p};
  hipError_t e = hipLaunchCooperativeKernel((void*)fwd, dim3(grid_blocks), dim3(256), args, 0, stream);
  if (e != hipSuccess) fprintf(stderr, "cooperative launch failed: %s (grid %d)\n", hipGetErrorString(e), grid_blocks);
#else
  const dim3 g(grid_blocks), b(256);
  k_prologue<<<g, b, 0, stream>>>(p, 0);
  for (int l = 0; l < 2; ++l) {
    k_in_gemm<<<g, b, 0, stream>>>(p, l);
    k_na<<<g, b, 0, stream>>>(p, l);
    k_swa<<<g, b, 0, stream>>>(p, l);
    k_conv<<<g, b, 0, stream>>>(p, l);
    k_out_gemm<<<g, b, 0, stream>>>(p, l);
    k_xq_gemm<<<g, b, 0, stream>>>(p, l);
    k_xattn<<<g, b, 0, stream>>>(p, l);
    k_xo_gemm<<<g, b, 0, stream>>>(p, l);
    k_peer_q<<<g, b, 0, stream>>>(p, l);
    k_peer_e<<<g, b, 0, stream>>>(p, l);
  }
#endif
}
```

```cpp
#include <hip/hip_runtime.h>
#include <hip/hip_cooperative_groups.h>
#include <cstdio>
#include <cstdint>
namespace cg = cooperative_groups;

#ifndef ONE_LAUNCH
#define ONE_LAUNCH 1
#endif

#define DI __device__ __forceinline__
typedef unsigned short bf16_t;
typedef short bf16x8 __attribute__((ext_vector_type(8)));
typedef short s16x4 __attribute__((ext_vector_type(4)));
typedef float f32x16 __attribute__((ext_vector_type(16)));
typedef float f32x4 __attribute__((ext_vector_type(4)));
typedef float f32x2 __attribute__((ext_vector_type(2)));
typedef unsigned u32x4 __attribute__((ext_vector_type(4)));
typedef unsigned u32x2 __attribute__((ext_vector_type(2)));
typedef __bf16 bf2_t __attribute__((ext_vector_type(2)));

constexpr int T = 81920, DM = 1024, SEQ = 8192;
constexpr int IN_DIM = 2560;
constexpr float LOG2E = 1.4426950408889634f;
constexpr float RMS_EPS = 1e-6f;
constexpr int NPHASE = 17;

constexpr int Z_NAQ = 0, Z_NAK = 384, Z_NAV = 768, Z_SCB = 1152, Z_SCC = 1408, Z_SCH = 1664, Z_SWQ = 1920, Z_SWK = 2304, Z_SWV = 2432;

__device__ const unsigned char T5TAB[257] = {
15,15,15,15,15,15,15,15,15,15,15,15,15,15,15,15,15,15,15,15,15,15,15,15,15,15,15,15,15,15,15,15,15,15,15,15,15,15,14,14,14,14,14,14,14,14,14,14,14,14,14,14,14,14,14,14,14,14,14,14,14,14,14,14,14,13,13,13,13,13,13,13,13,13,13,13,13,13,13,13,13,13,13,12,12,12,12,12,12,12,12,12,12,12,12,12,12,11,11,11,11,11,11,11,11,11,10,10,10,10,10,10,10,9,9,9,9,8,8,8,8,7,6,5,4,3,2,1,0,17,18,19,20,21,22,23,24,24,24,24,25,25,25,25,26,26,26,26,26,26,26,27,27,27,27,27,27,27,27,27,28,28,28,28,28,28,28,28,28,28,28,28,28,28,29,29,29,29,29,29,29,29,29,29,29,29,29,29,29,29,29,29,30,30,30,30,30,30,30,30,30,30,30,30,30,30,30,30,30,30,30,30,30,30,30,30,30,30,30,31,31,31,31,31,31,31,31,31,31,31,31,31,31,31,31,31,31,31,31,31,31,31,31,31,31,31,31,31,31,31,31,31,31,31,31,31,31};
__device__ const unsigned char PAIRTAB[64] = {
0x00,0x01,0x02,0x03,0x04,0x05,0x06,0x07,0x08,0x09,0x0a,0x0b,0x0c,0x0d,0x0e,0x0f,
0x10,0x11,0x12,0x13,0x14,0x15,0x16,0x17,
0x20,0x21,0x22,0x23,0x24,
0x30,0x31,0x32,0x33,
0x40,0x41,0x42,
0x50,0x51,0x60,0x61,0x70,0x71,
0x80,0x90,0xa0,0xb0,0xc0,0xd0,0xe0,0xf0,
0,0,0,0,0,0,0,0,0,0,0,0,0,0};

struct Params {
  const float* x_prompt; const float* x_sample; const float* mem_prompt; const float* mem_sample;
  const float* norm_mix_g; const float* w_in; const float* na_rpb; const float* conv_w; const float* swa_sink; const float* t5_bias;
  const float* w_out; const float* norm_xa_g; const float* norm_mem_g; const float* w_xq; const float* w_xk; const float* w_xv; const float* w_xo;
  const float* norm_ffn_g; const float* peer_wq; const float* peer_subkeys; const float* peer_u; const float* peer_v; const float* final_g;
  float* x;
  unsigned char* ws;
};
constexpr size_t OFF_Z = 0;
constexpr size_t OFF_Q = 0;
constexpr size_t OFF_O = (size_t)T * 512 * 2;
constexpr size_t OFF_TOPS = (size_t)T * 1024 * 2;
constexpr size_t OFF_YMIX = OFF_Z + (size_t)T * IN_DIM * 2;
constexpr size_t OFF_WIN = OFF_YMIX + (size_t)T * DM * 2;
constexpr size_t OFF_WOUT = OFF_WIN + (size_t)2 * 2560 * 1024 * 2;
constexpr size_t OFF_WXQ = OFF_WOUT + (size_t)2 * 1024 * 1024 * 2;
constexpr size_t OFF_WXKV = OFF_WXQ + (size_t)2 * 512 * 1024 * 2;
constexpr size_t OFF_WXO = OFF_WXKV + (size_t)2 * 1024 * 1024 * 2;
constexpr size_t OFF_WPQ = OFF_WXO + (size_t)2 * 1024 * 512 * 2;
constexpr size_t OFF_SUBK = OFF_WPQ + (size_t)2 * 2048 * 1024 * 2;
constexpr size_t OFF_PU = OFF_SUBK + (size_t)2 * 8 * 2 * 128 * 128 * 2;
constexpr size_t OFF_PV = OFF_PU + (size_t)2 * 16384 * 1024 * 2;
constexpr size_t OFF_MEMKV = OFF_PV + (size_t)2 * 16384 * 1024 * 2;
constexpr size_t WS_NEED = OFF_MEMKV + (size_t)2 * 2560 * 1024 * 2;

DI unsigned pk2(float a, float b) { f32x2 v = {a, b}; return __builtin_bit_cast(unsigned, __builtin_convertvector(v, bf2_t)); }
DI bf16_t bf1(float a) { return (bf16_t)(pk2(a, 0.f) & 0xffffu); }
DI float bf_lo(unsigned u) { return __uint_as_float(u << 16); }
DI float bf_hi(unsigned u) { return __uint_as_float(u & 0xffff0000u); }
#define MFMA32(a, b, c) __builtin_amdgcn_mfma_f32_32x32x16_bf16((a), (b), (c), 0, 0, 0)
DI int crow(int i, int h) { return (i & 3) + 8 * (i >> 2) + 4 * h; }
DI int tid() { int t = threadIdx.x; asm volatile("" : "+v"(t)); return t; }
template <int CTRL> DI float dpp(float v) { return __int_as_float(__builtin_amdgcn_update_dpp(0, __float_as_int(v), CTRL, 0xf, 0xf, true)); }
DI float xor16(float v) { return __int_as_float(__builtin_amdgcn_ds_swizzle(__float_as_int(v), 0x401F)); }
DI float xor32(float v, int lane) { return __int_as_float(__builtin_amdgcn_ds_bpermute((lane ^ 32) << 2, __float_as_int(v))); }
DI float row_sum(float v) { v += dpp<0xB1>(v); v += dpp<0x4E>(v); v += dpp<0x141>(v); v += dpp<0x140>(v); return v; }
DI float wave_sum(float v, int lane) { v = row_sum(v); v += xor16(v); v += xor32(v, lane); return v; }
DI float rdlane_f(float v, int l) { return __int_as_float(__builtin_amdgcn_readlane(__float_as_int(v), l)); }

constexpr int LDT = 72;
constexpr int GEMM_BUF = 128 * LDT;
constexpr int SMEM_RSTD = 4 * GEMM_BUF * 2;
constexpr int SMEM_BYTES = SMEM_RSTD + 512;

template <bool AF32>
DI void gemm_tile(const void* __restrict__ Ap, int lda, const bf16_t* __restrict__ Bp, int K, unsigned char* smem, f32x16 (&acc)[2][2]) {
  bf16_t* As = (bf16_t*)smem; bf16_t* Bs = As + 2 * GEMM_BUF; float* rs = (float*)(smem + SMEM_RSTD);
  const int t = tid(), lane = t & 63, wid = t >> 6, wm = wid >> 1, wn = wid & 1, r = lane & 31, h = lane >> 5;
#pragma unroll
  for (int a = 0; a < 2; ++a)
#pragma unroll
    for (int b = 0; b < 2; ++b)
#pragma unroll
      for (int i = 0; i < 16; ++i) acc[a][b][i] = 0.f;
  f32x4 af[8]; u32x4 ab[4]; u32x4 bb[4]; float ss[8];
#pragma unroll
  for (int i = 0; i < 8; ++i) ss[i] = 0.f;
  const int nk = K >> 6;
  const unsigned voA = AF32 ? (unsigned)(((t >> 4) * lda + (t & 15) * 4) * 4) : (unsigned)(((t >> 3) * lda + (t & 7) * 8) * 2);
  const unsigned voB = (unsigned)(((t >> 3) * K + (t & 7) * 8) * 2);
  const char* Ac = (const char*)Ap; const char* Bc = (const char*)Bp;
#define GEMM_LDG(kt) { \
    if constexpr (AF32) { _Pragma("unroll") for (int i = 0; i < 8; ++i) af[i] = *(const f32x4*)(Ac + ((size_t)(16 * i) * lda + (kt) * 64) * 4 + voA); } \
    else { _Pragma("unroll") for (int i = 0; i < 4; ++i) ab[i] = *(const u32x4*)(Ac + ((size_t)(32 * i) * lda + (kt) * 64) * 2 + voA); } \
    _Pragma("unroll") for (int i = 0; i < 4; ++i) bb[i] = *(const u32x4*)(Bc + ((size_t)(32 * i) * K + (kt) * 64) * 2 + voB); }
#define GEMM_STS(buf) { \
    bf16_t* a_ = As + (buf) * GEMM_BUF; bf16_t* b_ = Bs + (buf) * GEMM_BUF; \
    if constexpr (AF32) { _Pragma("unroll") for (int i = 0; i < 8; ++i) { f32x4 v = af[i]; ss[i] += v.x * v.x + v.y * v.y + v.z * v.z + v.w * v.w; \
        u32x2 pk = {pk2(v.x, v.y), pk2(v.z, v.w)}; *(u32x2*)(a_ + ((t >> 4) + 16 * i) * LDT + (t & 15) * 4) = pk; } } \
    else { _Pragma("unroll") for (int i = 0; i < 4; ++i) *(u32x4*)(a_ + ((t >> 3) + 32 * i) * LDT + (t & 7) * 8) = ab[i]; } \
    _Pragma("unroll") for (int i = 0; i < 4; ++i) *(u32x4*)(b_ + ((t >> 3) + 32 * i) * LDT + (t & 7) * 8) = bb[i]; }
  GEMM_LDG(0);
  GEMM_STS(0);
  __syncthreads();
#pragma unroll 1
  for (int kt = 0; kt < nk; ++kt) {
    const int cur = kt & 1;
    if (kt + 1 < nk) GEMM_LDG(kt + 1);
    {
      const bf16_t* a = As + cur * GEMM_BUF + (64 * wm + r) * LDT + 8 * h;
      const bf16_t* b = Bs + cur * GEMM_BUF + (64 * wn + r) * LDT + 8 * h;
#pragma unroll
      for (int ks = 0; ks < 4; ++ks) {
        const bf16x8 a0 = *(const bf16x8*)(a + 16 * ks), a1 = *(const bf16x8*)(a + 32 * LDT + 16 * ks);
        const bf16x8 b0 = *(const bf16x8*)(b + 16 * ks), b1 = *(const bf16x8*)(b + 32 * LDT + 16 * ks);
        acc[0][0] = MFMA32(a0, b0, acc[0][0]); acc[0][1] = MFMA32(a0, b1, acc[0][1]);
        acc[1][0] = MFMA32(a1, b0, acc[1][0]); acc[1][1] = MFMA32(a1, b1, acc[1][1]);
      }
    }
    if (kt + 1 < nk) GEMM_STS(cur ^ 1);
    __syncthreads();
  }
#undef GEMM_LDG
#undef GEMM_STS
  if constexpr (AF32) {
#pragma unroll
    for (int i = 0; i < 8; ++i) {
      float s = ss[i];
      s = row_sum(s);
      if ((t & 15) == 0) rs[(t >> 4) + 16 * i] = rsqrtf(s * (1.0f / 1024.0f) + RMS_EPS);
    }
    __syncthreads();
  }
}

template <int LDC>
DI void epi_bf16_scaled(const f32x16 (&acc)[2][2], unsigned char* smem, bf16_t* C) {
  const float* rs = (const float*)(smem + SMEM_RSTD);
  const int t = tid(), lane = t & 63, wid = t >> 6, wm = wid >> 1, wn = wid & 1, r = lane & 31, h = lane >> 5;
  bf16_t* ct = (bf16_t*)smem + (64 * wm + 4 * h) * 136 + 64 * wn + r;
  const float* rsw = rs + 64 * wm + 4 * h;
#pragma unroll
  for (int mi = 0; mi < 2; ++mi)
#pragma unroll
    for (int i = 0; i < 16; ++i) {
      const int rowc = 32 * mi + (i & 3) + 8 * (i >> 2);
      const float sc = rsw[rowc];
#pragma unroll
      for (int ni = 0; ni < 2; ++ni) ct[rowc * 136 + 32 * ni] = bf1(acc[mi][ni][i] * sc);
    }
  __syncthreads();
  const bf16_t* cs = (const bf16_t*)smem + (t >> 4) * 136 + 8 * (t & 15);
  char* cg_ = (char*)C; const unsigned vo = (unsigned)(((t >> 4) * LDC + 8 * (t & 15)) * 2);
#pragma unroll
  for (int j = 0; j < 8; ++j) *(u32x4*)(cg_ + (size_t)(16 * j) * LDC * 2 + vo) = *(const u32x4*)(cs + 16 * j * 136);
  __syncthreads();
}
DI void epi_resid(const f32x16 (&acc)[2][2], unsigned char* smem, float* X) {
  const int t = tid(), lane = t & 63, wid = t >> 6, wm = wid >> 1, wn = wid & 1, r = lane & 31, h = lane >> 5;
  float* ct = (float*)smem + (64 * wm + 4 * h) * 132 + 64 * wn + r;
#pragma unroll
  for (int mi = 0; mi < 2; ++mi)
#pragma unroll
    for (int i = 0; i < 16; ++i) {
      const int rowc = 32 * mi + (i & 3) + 8 * (i >> 2);
#pragma unroll
      for (int ni = 0; ni < 2; ++ni) ct[rowc * 132 + 32 * ni] = acc[mi][ni][i];
    }
  __syncthreads();
  const float* cs = (const float*)smem + (t >> 5) * 132 + 4 * (t & 31);
  char* xg = (char*)X; const unsigned vo = (unsigned)(((t >> 5) * DM + 4 * (t & 31)) * 4);
#pragma unroll
  for (int j = 0; j < 16; ++j) {
    f32x4* px = (f32x4*)(xg + (size_t)(8 * j) * DM * 4 + vo);
    const f32x4 a = *(const f32x4*)(cs + 8 * j * 132);
    *px = *px + a;
  }
  __syncthreads();
}

template <int D, class F>
DI void attn_tile(const bf16_t* Ks, const bf16_t* Vt, const bf16x8 (&qf)[D / 16], f32x16 (&o)[D / 32], float& m, float& l, F fn, int r, int h, int lane) {
  f32x16 s;
#pragma unroll
  for (int i = 0; i < 16; ++i) s[i] = 0.f;
#pragma unroll
  for (int ks = 0; ks < D / 16; ++ks) { const bf16x8 a = *(const bf16x8*)(Ks + r * (D + 8) + 16 * ks + 8 * h); s = MFMA32(a, qf[ks], s); }
  float mx = -INFINITY;
#pragma unroll
  for (int i = 0; i < 16; ++i) { s[i] = fn(s[i], i); mx = fmaxf(mx, s[i]); }
  mx = fmaxf(mx, xor32(mx, lane));
  const float mn = fmaxf(m, mx);
  const float alpha = __builtin_amdgcn_exp2f(m - mn);
  m = mn;
  float sum = 0.f;
#pragma unroll
  for (int i = 0; i < 16; ++i) { s[i] = __builtin_amdgcn_exp2f(s[i] - mn); sum += s[i]; }
  l = l * alpha + sum;
#pragma unroll
  for (int dt = 0; dt < D / 32; ++dt)
#pragma unroll
    for (int i = 0; i < 16; ++i) o[dt][i] *= alpha;
  bf16x8 pf[2];
#pragma unroll
  for (int s2 = 0; s2 < 2; ++s2) {
    u32x4 pk = {pk2(s[8 * s2], s[8 * s2 + 1]), pk2(s[8 * s2 + 2], s[8 * s2 + 3]), pk2(s[8 * s2 + 4], s[8 * s2 + 5]), pk2(s[8 * s2 + 6], s[8 * s2 + 7])};
    pf[s2] = __builtin_bit_cast(bf16x8, pk);
  }
#pragma unroll
  for (int dt = 0; dt < D / 32; ++dt)
#pragma unroll
    for (int s2 = 0; s2 < 2; ++s2) {
      const bf16_t* vp = Vt + (32 * dt + r) * 40 + 16 * s2 + 4 * h;
      const s16x4 lo = *(const s16x4*)vp, hi = *(const s16x4*)(vp + 8);
      const bf16x8 a = __builtin_shufflevector(lo, hi, 0, 1, 2, 3, 4, 5, 6, 7);
      o[dt] = MFMA32(a, pf[s2], o[dt]);
    }
}
DI void vt_store(bf16_t* Vt, u32x4 v, int c8, int kk) {
#pragma unroll
  for (int e = 0; e < 8; ++e) Vt[(8 * c8 + e) * 40 + kk] = (bf16_t)((v[e >> 1] >> (16 * (e & 1))) & 0xffffu);
}
template <int ND>
DI void attn_out(const f32x16 (&o)[ND], float l, bf16_t* yp, int h, int lane) {
  const float lt = l + xor32(l, lane);
  const float inv = 1.0f / lt;
#pragma unroll
  for (int dt = 0; dt < ND; ++dt)
#pragma unroll
    for (int g = 0; g < 4; ++g) {
      u32x2 v = {pk2(o[dt][4 * g] * inv, o[dt][4 * g + 1] * inv), pk2(o[dt][4 * g + 2] * inv, o[dt][4 * g + 3] * inv)};
      *(u32x2*)(yp + 32 * dt + 8 * g + 4 * h) = v;
    }
}

constexpr int AT64_BUF = 32 * 72 + 64 * 40;
DI void swa_item(const Params& p, int l, int item, unsigned char* smem) {
  const int t = tid(), lane = t & 63, w = t >> 6, r = lane & 31, h = lane >> 5;
  const int head = item % 6, n = (item / 6) & 63, b = item / 384, hkv = head / 3;
  bf16_t* st = (bf16_t*)smem;
  float* bt = (float*)(smem + 2 * AT64_BUF * 2);
  __syncthreads();
  for (int i = t; i < 257; i += 256) bt[i] = p.t5_bias[T5TAB[i] * 6 + head] * LOG2E;
  const size_t tok0 = (size_t)b * SEQ;
  const int q0 = n * 128 + 32 * w;
  bf16x8 qf[4];
  { const bf16_t* qp = ((bf16_t*)(p.ws + OFF_Z)) + (tok0 + q0 + r) * IN_DIM + Z_SWQ + head * 64 + 8 * h;
#pragma unroll
    for (int ks = 0; ks < 4; ++ks) qf[ks] = *(const bf16x8*)(qp + 16 * ks); }
  f32x16 o[2];
#pragma unroll
  for (int dt = 0; dt < 2; ++dt)
#pragma unroll
    for (int i = 0; i < 16; ++i) o[dt][i] = 0.f;
  float m = p.swa_sink[l * 6 + head] * LOG2E, lsum = (h == 0) ? 1.f : 0.f;
  const int kt_lo = (n == 0) ? 4 : 0, kt_hi = (n == 63) ? 8 : 12;
  const int kk = t >> 3, c8 = t & 7;
  const bf16_t* kbase = ((bf16_t*)(p.ws + OFF_Z)) + (tok0 + (size_t)(n * 128 + kk)) * IN_DIM + Z_SWK + hkv * 64 + 8 * c8;
  u32x4 kr, vr;
  { const bf16_t* kp = kbase + (ptrdiff_t)(32 * kt_lo - 128) * IN_DIM; kr = *(const u32x4*)kp; vr = *(const u32x4*)(kp + 128); }
  *(u32x4*)(st + kk * 72 + 8 * c8) = kr; vt_store(st + 32 * 72, vr, c8, kk);
  __syncthreads();
  const float sc2 = 0.125f * LOG2E;
  for (int kt = kt_lo; kt < kt_hi; ++kt) {
    const int cur = (kt - kt_lo) & 1;
    if (kt + 1 < kt_hi) { const bf16_t* kp = kbase + (ptrdiff_t)(32 * (kt + 1) - 128) * IN_DIM; kr = *(const u32x4*)kp; vr = *(const u32x4*)(kp + 128); }
    if (kt >= w && kt <= w + 8) {
      const int kb = 32 * kt - 128 - 32 * w - r + 4 * h;
      attn_tile<64>(st + cur * AT64_BUF, st + cur * AT64_BUF + 32 * 72, qf, o, m, lsum,
        [&](float sv, int i) { const int oi = kb + (i & 3) + 8 * (i >> 2) + 128; const bool ok = (unsigned)oi <= 256u; const float bias = bt[ok ? oi : 0]; return ok ? sv * sc2 + bias : -INFINITY; }, r, h, lane);
    }
    if (kt + 1 < kt_hi) { bf16_t* sb = st + (cur ^ 1) * AT64_BUF; *(u32x4*)(sb + kk * 72 + 8 * c8) = kr; vt_store(sb + 32 * 72, vr, c8, kk); }
    __syncthreads();
  }
  attn_out<2>(o, lsum, ((bf16_t*)(p.ws + OFF_YMIX)) + (tok0 + q0 + r) * DM + 640 + head * 64, h, lane);
}

DI void na_item(const Params& p, int l, int item, unsigned char* smem) {
  const int t = tid(), lane = t & 63, w = t >> 6, r = lane & 31, h = lane >> 5;
  const int hp = item % 3, rr = (item / 3) & 127, b = item / 384;
  const int hh = w >> 1, qh = w & 1, head = 2 * hp + hh;
  bf16_t* st = (bf16_t*)smem;
  constexpr int NBUF = 2 * AT64_BUF;
  float* bt = (float*)(smem + 2 * NBUF * 2);
  __syncthreads();
  for (int i = t; i < 930; i += 256) { const int e = i % 465, hsel = i / 465; bt[i] = p.na_rpb[((size_t)l * 465 + e) * 6 + 2 * hp + hsel] * LOG2E; }
  const size_t tok0 = (size_t)b * SEQ;
  const int r0 = min(max(rr - 4, 0), 120);
  const int c = 32 * qh + r;
  bf16x8 qf[4];
  { const bf16_t* qp = ((bf16_t*)(p.ws + OFF_Z)) + (tok0 + rr * 64 + c) * IN_DIM + Z_NAQ + head * 64 + 8 * h;
#pragma unroll
    for (int ks = 0; ks < 4; ++ks) qf[ks] = *(const bf16x8*)(qp + 16 * ks); }
  f32x16 o[2];
#pragma unroll
  for (int dt = 0; dt < 2; ++dt)
#pragma unroll
    for (int i = 0; i < 16; ++i) o[dt][i] = 0.f;
  float m = -1e30f, lsum = 0.f;
  const int kk = t >> 3, c8 = t & 7;
  const bf16_t* kbase = ((bf16_t*)(p.ws + OFF_Z)) + (tok0 + (size_t)((r0 + (kk >> 4)) * 64 + (kk & 15))) * IN_DIM + Z_NAK + (2 * hp) * 64 + 8 * c8;
  u32x4 k0r, k1r, v0r, v1r;
#define NA_LDG(kt) { const bf16_t* kp = kbase + (size_t)(((kt) >> 2) * 128 + ((kt) & 3) * 16) * IN_DIM; \
    k0r = *(const u32x4*)kp; k1r = *(const u32x4*)(kp + 64); v0r = *(const u32x4*)(kp + 384); v1r = *(const u32x4*)(kp + 448); }
#define NA_STS(buf) { bf16_t* sb = st + (buf) * NBUF; *(u32x4*)(sb + kk * 72 + 8 * c8) = k0r; *(u32x4*)(sb + AT64_BUF + kk * 72 + 8 * c8) = k1r; \
    vt_store(sb + 32 * 72, v0r, c8, kk); vt_store(sb + AT64_BUF + 32 * 72, v1r, c8, kk); }
  NA_LDG(0);
  NA_STS(0);
  __syncthreads();
  const float sc2 = 0.125f * LOG2E;
  const int c0 = min(max(c - 8, 0), 48);
  const float* bth = bt + hh * 465;
  for (int kt = 0; kt < 16; ++kt) {
    const int cur = kt & 1;
    if (kt + 1 < 16) NA_LDG(kt + 1);
    const int rp = kt >> 2, cb = kt & 3;
    if (cb >= qh && cb <= qh + 2) {
      const bf16_t* sb = st + cur * NBUF + hh * AT64_BUF;
      const int drb = r0 + 2 * rp - rr + 7;
      const int kcb = 16 * cb;
      attn_tile<64>(sb, sb + 32 * 72, qf, o, m, lsum,
        [&](float sv, int i) { const int kq = (i & 3) + 8 * (i >> 2) + 4 * h; const int kcol = kcb + (kq & 15); const int dr = drb + (kq >> 4);
          const bool ok = (kcol >= c0) && (kcol < c0 + 16); const int bi = dr * 31 + (kcol - c + 15); const float bias = bth[ok ? bi : 0];
          return ok ? sv * sc2 + bias : -INFINITY; }, r, h, lane);
    }
    if (kt + 1 < 16) NA_STS(cur ^ 1);
    __syncthreads();
  }
#undef NA_LDG
#undef NA_STS
  attn_out<2>(o, lsum, ((bf16_t*)(p.ws + OFF_YMIX)) + (tok0 + rr * 64 + c) * DM + head * 64, h, lane);
}

DI void conv_item(const Params& p, int l, int item) {
  const int t = tid();
  const size_t tok = (size_t)item * 8 + (t >> 5);
  const int c8 = t & 31, pos = (int)(tok & (SEQ - 1));
  const bf16_t* zr = ((bf16_t*)(p.ws + OFF_Z)) + tok * IN_DIM + 8 * c8;
  const u32x4 bv = *(const u32x4*)(zr + Z_SCB);
  const u32x4 cc = *(const u32x4*)(zr + Z_SCC), hc = *(const u32x4*)(zr + Z_SCH);
  u32x4 cm = {0, 0, 0, 0}, hm = {0, 0, 0, 0}, cp = {0, 0, 0, 0}, hpv = {0, 0, 0, 0};
  if (pos > 0) { cm = *(const u32x4*)(zr - IN_DIM + Z_SCC); hm = *(const u32x4*)(zr - IN_DIM + Z_SCH); }
  if (pos < SEQ - 1) { cp = *(const u32x4*)(zr + IN_DIM + Z_SCC); hpv = *(const u32x4*)(zr + IN_DIM + Z_SCH); }
  const float* cw = p.conv_w + (size_t)l * 3 * 256 + 8 * c8;
  float y[8];
#pragma unroll
  for (int e = 0; e < 8; ++e) {
    const int wd = e >> 1;
    const float fb = (e & 1) ? bf_hi(bv[wd]) : bf_lo(bv[wd]);
    const float um = ((e & 1) ? bf_hi(cm[wd]) : bf_lo(cm[wd])) * ((e & 1) ? bf_hi(hm[wd]) : bf_lo(hm[wd]));
    const float uc = ((e & 1) ? bf_hi(cc[wd]) : bf_lo(cc[wd])) * ((e & 1) ? bf_hi(hc[wd]) : bf_lo(hc[wd]));
    const float up = ((e & 1) ? bf_hi(cp[wd]) : bf_lo(cp[wd])) * ((e & 1) ? bf_hi(hpv[wd]) : bf_lo(hpv[wd]));
    y[e] = fb * (um * cw[e] + uc * cw[256 + e] + up * cw[512 + e]);
  }
  u32x4 ov = {pk2(y[0], y[1]), pk2(y[2], y[3]), pk2(y[4], y[5]), pk2(y[6], y[7])};
  *(u32x4*)(((bf16_t*)(p.ws + OFF_YMIX)) + tok * DM + 384 + 8 * c8) = ov;
}

constexpr int AT128_BUF = 32 * 136 + 128 * 40;
DI void xattn_item(const Params& p, int l, int item, unsigned char* smem) {
  const int t = tid(), lane = t & 63, w = t >> 6, r = lane & 31, h = lane >> 5;
  const int qt = item & 63, head = (item >> 6) & 3, b = item >> 8;
  bf16_t* st = (bf16_t*)smem;
  const size_t tok = (size_t)b * SEQ + qt * 128 + 32 * w + r;
  bf16x8 qf[8];
  { const bf16_t* qp = ((bf16_t*)(p.ws + OFF_Q)) + tok * 512 + head * 128 + 8 * h;
#pragma unroll
    for (int ks = 0; ks < 8; ++ks) qf[ks] = *(const bf16x8*)(qp + 16 * ks); }
  f32x16 o[4];
#pragma unroll
  for (int dt = 0; dt < 4; ++dt)
#pragma unroll
    for (int i = 0; i < 16; ++i) o[dt][i] = 0.f;
  float m = -1e30f, lsum = 0.f;
  const int kk = t >> 4, c8 = t & 15;
  const bf16_t* kbase = ((bf16_t*)(p.ws + OFF_MEMKV)) + ((size_t)l * 2560 + (size_t)b * 256 + kk) * 1024 + head * 128 + 8 * c8;
  u32x4 k0r, k1r, v0r, v1r;
#define XA_LDG(kt) { const bf16_t* kp = kbase + (size_t)(32 * (kt)) * 1024; \
    k0r = *(const u32x4*)kp; k1r = *(const u32x4*)(kp + 16 * 1024); v0r = *(const u32x4*)(kp + 512); v1r = *(const u32x4*)(kp + 16 * 1024 + 512); }
#define XA_STS(buf) { bf16_t* sb = st + (buf) * AT128_BUF; *(u32x4*)(sb + kk * 136 + 8 * c8) = k0r; *(u32x4*)(sb + (kk + 16) * 136 + 8 * c8) = k1r; \
    vt_store(sb + 32 * 136, v0r, c8, kk); vt_store(sb + 32 * 136, v1r, c8, kk + 16); }
  __syncthreads();
  XA_LDG(0);
  XA_STS(0);
  __syncthreads();
  const float sc2 = 0.08838834764831845f * LOG2E;
  for (int kt = 0; kt < 8; ++kt) {
    const int cur = kt & 1;
    if (kt + 1 < 8) XA_LDG(kt + 1);
    { const bf16_t* sb = st + cur * AT128_BUF;
      attn_tile<128>(sb, sb + 32 * 136, qf, o, m, lsum, [&](float sv, int) { return sv * sc2; }, r, h, lane); }
    if (kt + 1 < 8) XA_STS(cur ^ 1);
    __syncthreads();
  }
#undef XA_LDG
#undef XA_STS
  attn_out<4>(o, lsum, ((bf16_t*)(p.ws + OFF_O)) + tok * 512 + head * 128, h, lane);
}

DI void transpose_job(const float* __restrict__ src, int K, int N, const float* __restrict__ g, bf16_t* __restrict__ dst, unsigned char* smem) {
  float* tl = (float*)smem;
  const int tn = N / 64, ntile = (K / 64) * tn, t = threadIdx.x;
  for (int tile = blockIdx.x; tile < ntile; tile += gridDim.x) {
    const int k0 = (tile / tn) * 64, n0 = (tile % tn) * 64;
    __syncthreads();
#pragma unroll 4
    for (int i = 0; i < 16; ++i) { const int kk = (t >> 6) + 4 * i; float v = src[(size_t)(k0 + kk) * N + n0 + (t & 63)]; if (g) v *= g[k0 + kk]; tl[kk * 65 + (t & 63)] = v; }
    __syncthreads();
#pragma unroll 4
    for (int i = 0; i < 16; ++i) { const int nn = (t >> 6) + 4 * i; dst[(size_t)(n0 + nn) * K + k0 + (t & 63)] = bf1(tl[(t & 63) * 65 + nn]); }
  }
}
DI void convert_job(const float* __restrict__ src, bf16_t* __restrict__ dst, size_t n4) {
  for (size_t i = (size_t)blockIdx.x * 256 + threadIdx.x; i < n4; i += (size_t)gridDim.x * 256) {
    const f32x4 v = ((const f32x4*)src)[i];
    u32x2 o = {pk2(v.x, v.y), pk2(v.z, v.w)};
    ((u32x2*)dst)[i] = o;
  }
}

DI void phase_prologue(const Params& p, unsigned char* smem) {
  { const size_t n4p = (size_t)16384 * 256, n4 = (size_t)T * 256;
    for (size_t i = (size_t)blockIdx.x * 256 + threadIdx.x; i < n4; i += (size_t)gridDim.x * 256)
      ((f32x4*)p.x)[i] = (i < n4p) ? ((const f32x4*)p.x_prompt)[i] : ((const f32x4*)p.x_sample)[i - n4p]; }
  for (int l = 0; l < 2; ++l) {
    transpose_job(p.w_in + (size_t)l * 1024 * 2560, 1024, 2560, p.norm_mix_g + l * 1024, ((bf16_t*)(p.ws + OFF_WIN)) + (size_t)l * 2560 * 1024, smem);
    transpose_job(p.w_out + (size_t)l * 1024 * 1024, 1024, 1024, nullptr, ((bf16_t*)(p.ws + OFF_WOUT)) + (size_t)l * 1024 * 1024, smem);
    transpose_job(p.w_xq + (size_t)l * 1024 * 512, 1024, 512, p.norm_xa_g + l * 1024, ((bf16_t*)(p.ws + OFF_WXQ)) + (size_t)l * 512 * 1024, smem);
    transpose_job(p.w_xk + (size_t)l * 1024 * 512, 1024, 512, p.norm_mem_g + l * 1024, ((bf16_t*)(p.ws + OFF_WXKV)) + (size_t)l * 1024 * 1024, smem);
    transpose_job(p.w_xv + (size_t)l * 1024 * 512, 1024, 512, p.norm_mem_g + l * 1024, ((bf16_t*)(p.ws + OFF_WXKV)) + (size_t)l * 1024 * 1024 + (size_t)512 * 1024, smem);
    transpose_job(p.w_xo + (size_t)l * 512 * 1024, 512, 1024, nullptr, ((bf16_t*)(p.ws + OFF_WXO)) + (size_t)l * 1024 * 512, smem);
    transpose_job(p.peer_wq + (size_t)l * 1024 * 2048, 1024, 2048, p.norm_ffn_g + l * 1024, ((bf16_t*)(p.ws + OFF_WPQ)) + (size_t)l * 2048 * 1024, smem);
  }
  convert_job(p.peer_subkeys, ((bf16_t*)(p.ws + OFF_SUBK)), (size_t)2 * 8 * 2 * 128 * 128 / 4);
  convert_job(p.peer_u, ((bf16_t*)(p.ws + OFF_PU)), (size_t)2 * 16384 * 1024 / 4);
  convert_job(p.peer_v, ((bf16_t*)(p.ws + OFF_PV)), (size_t)2 * 16384 * 1024 / 4);
}

#define TILE_WALK(NT, MT8) const int nx_ = gridDim.x >> 3, xcd_ = blockIdx.x & 7; \
  for (int j_ = blockIdx.x >> 3; j_ < (MT8) * (NT); j_ += nx_) { const int mt = (j_ / (NT)) * 8 + xcd_, nt = j_ % (NT);

DI void phase_in_gemm(const Params& p, int l, unsigned char* smem) {
  f32x16 acc[2][2];
  { TILE_WALK(20, 80)
    gemm_tile<true>(p.x + (size_t)mt * 128 * DM, DM, ((bf16_t*)(p.ws + OFF_WIN)) + ((size_t)l * 2560 + nt * 128) * 1024, 1024, smem, acc);
    epi_bf16_scaled<IN_DIM>(acc, smem, ((bf16_t*)(p.ws + OFF_Z)) + (size_t)mt * 128 * IN_DIM + nt * 128);
  } }
  if (l == 0) {
    for (int j = blockIdx.x; j < 20 * 8 * 2; j += gridDim.x) {
      const int ll = j / 160, mt = (j % 160) >> 3, nt = j & 7, b = mt >> 1;
      const float* A = (b < 2 ? p.mem_prompt + (size_t)b * 256 * DM : p.mem_sample + (size_t)(b - 2) * 256 * DM) + (size_t)(mt & 1) * 128 * DM;
      gemm_tile<true>(A, DM, ((bf16_t*)(p.ws + OFF_WXKV)) + ((size_t)ll * 1024 + nt * 128) * 1024, 1024, smem, acc);
      epi_bf16_scaled<1024>(acc, smem, ((bf16_t*)(p.ws + OFF_MEMKV)) + ((size_t)ll * 2560 + mt * 128) * 1024 + nt * 128);
    }
  }
}
DI void phase_out_gemm(const Params& p, int l, unsigned char* smem) {
  f32x16 acc[2][2];
  TILE_WALK(8, 80)
    gemm_tile<false>(((bf16_t*)(p.ws + OFF_YMIX)) + (size_t)mt * 128 * DM, DM, ((bf16_t*)(p.ws + OFF_WOUT)) + ((size_t)l * 1024 + nt * 128) * 1024, 1024, smem, acc);
    epi_resid(acc, smem, p.x + (size_t)mt * 128 * DM + nt * 128);
  }
}
DI void phase_xq_gemm(const Params& p, int l, unsigned char* smem) {
  f32x16 acc[2][2];
  TILE_WALK(4, 80)
    gemm_tile<true>(p.x + (size_t)mt * 128 * DM, DM, ((bf16_t*)(p.ws + OFF_WXQ)) + ((size_t)l * 512 + nt * 128) * 1024, 1024, smem, acc);
    epi_bf16_scaled<512>(acc, smem, ((bf16_t*)(p.ws + OFF_Q)) + (size_t)mt * 128 * 512 + nt * 128);
  }
}
DI void phase_xo_gemm(const Params& p, int l, unsigned char* smem) {
  f32x16 acc[2][2];
  TILE_WALK(8, 80)
    gemm_tile<false>(((bf16_t*)(p.ws + OFF_O)) + (size_t)mt * 128 * 512, 512, ((bf16_t*)(p.ws + OFF_WXO)) + ((size_t)l * 1024 + nt * 128) * 512, 512, smem, acc);
    epi_resid(acc, smem, p.x + (size_t)mt * 128 * DM + nt * 128);
  }
}
DI void phase_peer_q(const Params& p, int l, unsigned char* smem) {
  f32x16 acc[2][2];
  const int t = tid(), lane = t & 63, wid = t >> 6, wm = wid >> 1, wn = wid & 1, r = lane & 31, h = lane >> 5;
  const float* rs = (const float*)(smem + SMEM_RSTD);
  bf16_t* Qs = (bf16_t*)smem; bf16_t* SKs = Qs + 128 * 136;
  TILE_WALK(16, 80)
    gemm_tile<true>(p.x + (size_t)mt * 128 * DM, DM, ((bf16_t*)(p.ws + OFF_WPQ)) + ((size_t)l * 2048 + nt * 128) * 1024, 1024, smem, acc);
#pragma unroll
    for (int mi = 0; mi < 2; ++mi)
#pragma unroll
      for (int i = 0; i < 16; ++i) {
        const int row = 64 * wm + 32 * mi + crow(i, h);
        const float sc = rs[row];
#pragma unroll
        for (int ni = 0; ni < 2; ++ni) Qs[row * 136 + 64 * wn + 32 * ni + r] = bf1(acc[mi][ni][i] * sc);
      }
    { const bf16_t* sk = ((bf16_t*)(p.ws + OFF_SUBK)) + ((size_t)(l * 16 + nt) * 128) * 128;
#pragma unroll
      for (int i = 0; i < 8; ++i) { const int row = (t >> 4) + 16 * i, c8 = t & 15; *(u32x4*)(SKs + row * 136 + 8 * c8) = *(const u32x4*)(sk + row * 128 + 8 * c8); } }
    __syncthreads();
    f32x16 sc[4];
#pragma unroll
    for (int n4 = 0; n4 < 4; ++n4)
#pragma unroll
      for (int i = 0; i < 16; ++i) sc[n4][i] = 0.f;
#pragma unroll 2
    for (int ks = 0; ks < 8; ++ks) {
      const bf16x8 bq = *(const bf16x8*)(Qs + (32 * wid + r) * 136 + 16 * ks + 8 * h);
#pragma unroll
      for (int n4 = 0; n4 < 4; ++n4) { const bf16x8 a = *(const bf16x8*)(SKs + (32 * n4 + r) * 136 + 16 * ks + 8 * h); sc[n4] = MFMA32(a, bq, sc[n4]); }
    }
    __syncthreads();
#pragma unroll
    for (int n4 = 0; n4 < 4; ++n4)
#pragma unroll
      for (int i = 0; i < 16; ++i) sc[n4][i] = __uint_as_float((__float_as_uint(sc[n4][i]) & ~127u) | (unsigned)(32 * n4 + crow(i, h)));
    float res[16];
#pragma unroll
    for (int rd = 0; rd < 16; ++rd) {
      float mx = -INFINITY;
#pragma unroll
      for (int n4 = 0; n4 < 4; ++n4)
#pragma unroll
        for (int i = 0; i < 16; ++i) mx = fmaxf(mx, sc[n4][i]);
      const float M = fmaxf(mx, xor32(mx, lane));
      res[rd] = M;
#pragma unroll
      for (int n4 = 0; n4 < 4; ++n4)
#pragma unroll
        for (int i = 0; i < 16; ++i) sc[n4][i] = (sc[n4][i] == M) ? -INFINITY : sc[n4][i];
    }
    if (h == 0) {
      float* dst = ((float*)(p.ws + OFF_TOPS)) + (((size_t)mt * 128 + 32 * wid + r) * 16 + nt) * 16;
#pragma unroll
      for (int g = 0; g < 4; ++g) { f32x4 v = {res[4 * g], res[4 * g + 1], res[4 * g + 2], res[4 * g + 3]}; *(f32x4*)(dst + 4 * g) = v; }
    }
  }
}

DI void phase_peer_experts(const Params& p, int l, bool last) {
  const int t = tid(), lane = t & 63, wid = t >> 6;
  const bf16_t* pu = ((bf16_t*)(p.ws + OFF_PU)) + (size_t)l * 16384 * 1024;
  const bf16_t* pv = ((bf16_t*)(p.ws + OFF_PV)) + (size_t)l * 16384 * 1024;
  const float* gf = p.norm_ffn_g + l * 1024;
  const int pr = PAIRTAB[lane], ci = pr >> 4, cj = pr & 15;
  for (int tok = blockIdx.x * 4 + wid; tok < T; tok += gridDim.x * 4) {
    float* xr = p.x + (size_t)tok * DM;
    f32x4 xa[4];
    xa[0] = *(const f32x4*)(xr + 8 * lane); xa[1] = *(const f32x4*)(xr + 8 * lane + 4); xa[2] = *(const f32x4*)(xr + 512 + 8 * lane); xa[3] = *(const f32x4*)(xr + 512 + 8 * lane + 4);
    float ss = 0.f;
#pragma unroll
    for (int k = 0; k < 4; ++k) ss += xa[k].x * xa[k].x + xa[k].y * xa[k].y + xa[k].z * xa[k].z + xa[k].w * xa[k].w;
    ss = wave_sum(ss, lane);
    const float rstd = rsqrtf(ss * (1.0f / 1024.0f) + RMS_EPS);
    float xn[16], out[16];
    { f32x4 gv[4];
      gv[0] = *(const f32x4*)(gf + 8 * lane); gv[1] = *(const f32x4*)(gf + 8 * lane + 4); gv[2] = *(const f32x4*)(gf + 512 + 8 * lane); gv[3] = *(const f32x4*)(gf + 512 + 8 * lane + 4);
#pragma unroll
    for (int k = 0; k < 4; ++k) { xn[4 * k] = xa[k].x * rstd * gv[k].x; xn[4 * k + 1] = xa[k].y * rstd * gv[k].y; xn[4 * k + 2] = xa[k].z * rstd * gv[k].z; xn[4 * k + 3] = xa[k].w * rstd * gv[k].w; } }
#pragma unroll
    for (int k = 0; k < 16; ++k) out[k] = 0.f;
    const float* ts = ((float*)(p.ws + OFF_TOPS)) + (size_t)tok * 256;
    for (int hd = 0; hd < 8; ++hd) {
      const float sa = ts[hd * 32 + ci], sb = ts[hd * 32 + 16 + cj];
      const float val = (lane < 50) ? sa + sb : -INFINITY;
      const int idx = (int)((__float_as_uint(sa) & 127u) * 128u + (__float_as_uint(sb) & 127u));
      int rank = 0;
#pragma unroll
      for (int c = 0; c < 50; ++c) { const float vc = rdlane_f(val, c); rank += ((vc > val) || (vc == val && c < lane)) ? 1 : 0; }
      const bool selected = (rank < 16) && (lane < 50);
      unsigned long long sel = __ballot(selected);
      const float vmax = rdlane_f(val, 0);
      const float e = selected ? __expf(val - vmax) : 0.f;
      const float esum = wave_sum(e, lane);
      const float gate = e / esum;
      int ce = 0; float cgt = 0.f;
#pragma unroll
      for (int rd = 0; rd < 16; ++rd) {
        const int s = __ffsll((long long)sel) - 1; sel &= sel - 1;
        const int ex = __builtin_amdgcn_readlane(idx, s); const float gg = rdlane_f(gate, s);
        ce = (lane == rd) ? ex : ce; cgt = (lane == rd) ? gg : cgt;
      }
      float myd = 0.f;
#pragma unroll
      for (int half = 0; half < 2; ++half) {
        u32x4 u0[8], u1[8];
#pragma unroll
        for (int k = 0; k < 8; ++k) {
          const int ex = __builtin_amdgcn_readlane(ce, half * 8 + k);
          const bf16_t* row = pu + (size_t)ex * 1024 + 8 * lane;
          u0[k] = *(const u32x4*)row; u1[k] = *(const u32x4*)(row + 512);
        }
#pragma unroll
        for (int k = 0; k < 8; ++k) {
          float d = 0.f;
#pragma unroll
          for (int e2 = 0; e2 < 4; ++e2) { d += bf_lo(u0[k][e2]) * xn[2 * e2] + bf_hi(u0[k][e2]) * xn[2 * e2 + 1]; d += bf_lo(u1[k][e2]) * xn[8 + 2 * e2] + bf_hi(u1[k][e2]) * xn[8 + 2 * e2 + 1]; }
          d = wave_sum(d, lane);
          myd = (lane == half * 8 + k) ? d : myd;
        }
      }
      const float wgt = cgt * (0.5f * myd * (1.0f + erff(myd * 0.70710678118654752f)));
#pragma unroll
      for (int half = 0; half < 2; ++half) {
        u32x4 u0[8], u1[8];
#pragma unroll
        for (int k = 0; k < 8; ++k) {
          const int ex = __builtin_amdgcn_readlane(ce, half * 8 + k);
          const bf16_t* row = pv + (size_t)ex * 1024 + 8 * lane;
          u0[k] = *(const u32x4*)row; u1[k] = *(const u32x4*)(row + 512);
        }
#pragma unroll
        for (int k = 0; k < 8; ++k) {
          const float wk = rdlane_f(wgt, half * 8 + k);
#pragma unroll
          for (int e2 = 0; e2 < 4; ++e2) {
            out[2 * e2] += wk * bf_lo(u0[k][e2]); out[2 * e2 + 1] += wk * bf_hi(u0[k][e2]);
            out[8 + 2 * e2] += wk * bf_lo(u1[k][e2]); out[8 + 2 * e2 + 1] += wk * bf_hi(u1[k][e2]);
          }
        }
      }
    }
    f32x4 xa2[4];
    xa2[0] = *(const f32x4*)(xr + 8 * lane); xa2[1] = *(const f32x4*)(xr + 8 * lane + 4); xa2[2] = *(const f32x4*)(xr + 512 + 8 * lane); xa2[3] = *(const f32x4*)(xr + 512 + 8 * lane + 4);
    f32x4 xo[4];
#pragma unroll
    for (int k = 0; k < 4; ++k) { xo[k].x = xa2[k].x + out[4 * k]; xo[k].y = xa2[k].y + out[4 * k + 1]; xo[k].z = xa2[k].z + out[4 * k + 2]; xo[k].w = xa2[k].w + out[4 * k + 3]; }
    if (last) {
      float s2 = 0.f;
#pragma unroll
      for (int k = 0; k < 4; ++k) s2 += xo[k].x * xo[k].x + xo[k].y * xo[k].y + xo[k].z * xo[k].z + xo[k].w * xo[k].w;
      s2 = wave_sum(s2, lane);
      const float r2 = rsqrtf(s2 * (1.0f / 1024.0f) + RMS_EPS);
      const float* fg = p.final_g;
      const f32x4 f0 = *(const f32x4*)(fg + 8 * lane), f1 = *(const f32x4*)(fg + 8 * lane + 4), f2 = *(const f32x4*)(fg + 512 + 8 * lane), f3 = *(const f32x4*)(fg + 512 + 8 * lane + 4);
      xo[0] = xo[0] * r2 * f0; xo[1] = xo[1] * r2 * f1; xo[2] = xo[2] * r2 * f2; xo[3] = xo[3] * r2 * f3;
    }
    *(f32x4*)(xr + 8 * lane) = xo[0]; *(f32x4*)(xr + 8 * lane + 4) = xo[1]; *(f32x4*)(xr + 512 + 8 * lane) = xo[2]; *(f32x4*)(xr + 512 + 8 * lane + 4) = xo[3];
  }
}

DI void run_phase(const Params& p, int ph, unsigned char* smem) {
  if (ph == 0) { phase_prologue(p, smem); return; }
  const int l = (ph - 1) >> 3, s = (ph - 1) & 7;
  switch (s) {
    case 0: phase_in_gemm(p, l, smem); break;
    case 1:
      for (int it = blockIdx.x; it < 3840; it += gridDim.x) na_item(p, l, it, smem);
      for (int it = blockIdx.x; it < 3840; it += gridDim.x) swa_item(p, l, it, smem);
      for (int it = blockIdx.x; it < 10240; it += gridDim.x) conv_item(p, l, it);
      break;
    case 2: phase_out_gemm(p, l, smem); break;
    case 3: phase_xq_gemm(p, l, smem); break;
    case 4: for (int it = blockIdx.x; it < 2560; it += gridDim.x) xattn_item(p, l, it, smem); break;
    case 5: phase_xo_gemm(p, l, smem); break;
    case 6: phase_peer_q(p, l, smem); break;
    case 7: phase_peer_experts(p, l, l == 1); break;
  }
}
#if ONE_LAUNCH
template <int L>
DI void run_layer(const Params& p, unsigned char* smem, cg::grid_group& grid) {
  phase_in_gemm(p, L, smem); grid.sync();
  for (int it = blockIdx.x; it < 3840; it += gridDim.x) na_item(p, L, it, smem);
  for (int it = blockIdx.x; it < 3840; it += gridDim.x) swa_item(p, L, it, smem);
  for (int it = blockIdx.x; it < 10240; it += gridDim.x) conv_item(p, L, it);
  grid.sync();
  phase_out_gemm(p, L, smem); grid.sync();
  phase_xq_gemm(p, L, smem); grid.sync();
  for (int it = blockIdx.x; it < 2560; it += gridDim.x) xattn_item(p, L, it, smem);
  grid.sync();
  phase_xo_gemm(p, L, smem); grid.sync();
  phase_peer_q(p, L, smem); grid.sync();
  phase_peer_experts(p, L, L == 1);
}
__global__ void __launch_bounds__(256, 2) fwd(Params p) {
  __shared__ __attribute__((aligned(16))) unsigned char smem[SMEM_BYTES];
  cg::grid_group grid = cg::this_grid();
  phase_prologue(p, smem); grid.sync();
  run_layer<0>(p, smem, grid); grid.sync();
  run_layer<1>(p, smem, grid);
}
#else
#define DK(name, body) __global__ void __launch_bounds__(256, 2) name(Params p, int l) { __shared__ __attribute__((aligned(16))) unsigned char smem[SMEM_BYTES]; body; }
DK(k_prologue, phase_prologue(p, smem))
DK(k_in_gemm, phase_in_gemm(p, l, smem))
DK(k_na, for (int it = blockIdx.x; it < 3840; it += gridDim.x) na_item(p, l, it, smem))
DK(k_swa, for (int it = blockIdx.x; it < 3840; it += gridDim.x) swa_item(p, l, it, smem))
DK(k_conv, for (int it = blockIdx.x; it < 10240; it += gridDim.x) conv_item(p, l, it))
DK(k_out_gemm, phase_out_gemm(p, l, smem))
DK(k_xq_gemm, phase_xq_gemm(p, l, smem))
DK(k_xattn, for (int it = blockIdx.x; it < 2560; it += gridDim.x) xattn_item(p, l, it, smem))
DK(k_xo_gemm, phase_xo_gemm(p, l, smem))
DK(k_peer_q, phase_peer_q(p, l, smem))
DK(k_peer_e, phase_peer_experts(p, l, l == 1))
#endif

extern "C" void kernel_launch(void* const* d_in, const int* in_sizes, int n_in, void* d_out, int out_size, void* d_ws, size_t ws_size, hipStream_t stream) {
  static int grid_blocks = 0;
  if (!grid_blocks) {
    int dev = 0, cus = 0, per_cu = 2;
    (void)hipGetDevice(&dev);
    (void)hipDeviceGetAttribute(&cus, hipDeviceAttributeMultiprocessorCount, dev);
#if ONE_LAUNCH
    (void)hipOccupancyMaxActiveBlocksPerMultiprocessor(&per_cu, fwd, 256, 0);
#endif
    if (per_cu > 2) per_cu = 2;
    if (per_cu < 1) per_cu = 1;
    grid_blocks = cus * per_cu;
    grid_blocks -= grid_blocks % 8;
  }
  Params p{};
  const float* const* in = (const float* const*)d_in;
  p.x_prompt = in[0]; p.x_sample = in[1]; p.mem_prompt = in[2]; p.mem_sample = in[3];
  p.norm_mix_g = in[4]; p.w_in = in[5]; p.na_rpb = in[6]; p.conv_w = in[7]; p.swa_sink = in[8]; p.t5_bias = in[9];
  p.w_out = in[10]; p.norm_xa_g = in[11]; p.norm_mem_g = in[12]; p.w_xq = in[13]; p.w_xk = in[14]; p.w_xv = in[15]; p.w_xo = in[16];
  p.norm_ffn_g = in[17]; p.peer_wq = in[18]; p.peer_subkeys = in[19]; p.peer_u = in[20]; p.peer_v = in[21]; p.final_g = in[22];
  p.x = (float*)d_out;
  p.ws = (unsigned char*)d_ws;
  if (WS_NEED > ws_size) { fprintf(stderr, "workspace too small: need %zu have %zu\n", (size_t)WS_NEED, ws_size); return; }
#if ONE_LAUNCH
  void* args[] = {&p};
  hipError_t e = hipLaunchCooperativeKernel((void*)fwd, dim3(grid_blocks), dim3(256), args, 0, stream);
  if (e != hipSuccess) fprintf(stderr, "cooperative launch failed: %s (grid %d)\n", hipGetErrorString(e), grid_blocks);
#else
  const dim3 g(grid_blocks), b(256);
  k_prologue<<<g, b, 0, stream>>>(p, 0);
  for (int l = 0; l < 2; ++l) {
    k_in_gemm<<<g, b, 0, stream>>>(p, l);
    k_na<<<g, b, 0, stream>>>(p, l);
    k_swa<<<g, b, 0, stream>>>(p, l);
    k_conv<<<g, b, 0, stream>>>(p, l);
    k_out_gemm<<<g, b, 0, stream>>>(p, l);
    k_xq_gemm<<<g, b, 0, stream>>>(p, l);
    k_xattn<<<g, b, 0, stream>>>(p, l);
    k_xo_gemm<<<g, b, 0, stream>>>(p, l);
    k_peer_q<<<g, b, 0, stream>>>(p, l);
    k_peer_e<<<g, b, 0, stream>>>(p, l);
  }
#endif
}
```

```cpp
#include <hip/hip_runtime.h>
#include <hip/hip_cooperative_groups.h>
#include <cstdio>
#include <cstdint>
namespace cg = cooperative_groups;

#ifndef ONE_LAUNCH
#define ONE_LAUNCH 1
#endif

#define DI __device__ __forceinline__
typedef unsigned short bf16_t;
typedef short bf16x8 __attribute__((ext_vector_type(8)));
typedef short s16x4 __attribute__((ext_vector_type(4)));
typedef float f32x16 __attribute__((ext_vector_type(16)));
typedef float f32x4 __attribute__((ext_vector_type(4)));
typedef float f32x2 __attribute__((ext_vector_type(2)));
typedef unsigned u32x4 __attribute__((ext_vector_type(4)));
typedef unsigned u32x2 __attribute__((ext_vector_type(2)));
typedef __bf16 bf2_t __attribute__((ext_vector_type(2)));

constexpr int T = 81920, DM = 1024, SEQ = 8192;
constexpr int IN_DIM = 2560;
constexpr float LOG2E = 1.4426950408889634f;
constexpr float RMS_EPS = 1e-6f;
constexpr int NPHASE = 17;

constexpr int Z_NAQ = 0, Z_NAK = 384, Z_NAV = 768, Z_SCB = 1152, Z_SCC = 1408, Z_SCH = 1664, Z_SWQ = 1920, Z_SWK = 2304, Z_SWV = 2432;

__device__ const unsigned char T5TAB[257] = {
15,15,15,15,15,15,15,15,15,15,15,15,15,15,15,15,15,15,15,15,15,15,15,15,15,15,15,15,15,15,15,15,15,15,15,15,15,15,14,14,14,14,14,14,14,14,14,14,14,14,14,14,14,14,14,14,14,14,14,14,14,14,14,14,14,13,13,13,13,13,13,13,13,13,13,13,13,13,13,13,13,13,13,12,12,12,12,12,12,12,12,12,12,12,12,12,12,11,11,11,11,11,11,11,11,11,10,10,10,10,10,10,10,9,9,9,9,8,8,8,8,7,6,5,4,3,2,1,0,17,18,19,20,21,22,23,24,24,24,24,25,25,25,25,26,26,26,26,26,26,26,27,27,27,27,27,27,27,27,27,28,28,28,28,28,28,28,28,28,28,28,28,28,28,29,29,29,29,29,29,29,29,29,29,29,29,29,29,29,29,29,29,30,30,30,30,30,30,30,30,30,30,30,30,30,30,30,30,30,30,30,30,30,30,30,30,30,30,30,31,31,31,31,31,31,31,31,31,31,31,31,31,31,31,31,31,31,31,31,31,31,31,31,31,31,31,31,31,31,31,31,31,31,31,31,31,31};
__device__ const unsigned char PAIRTAB[64] = {
0x00,0x01,0x02,0x03,0x04,0x05,0x06,0x07,0x08,0x09,0x0a,0x0b,0x0c,0x0d,0x0e,0x0f,
0x10,0x11,0x12,0x13,0x14,0x15,0x16,0x17,
0x20,0x21,0x22,0x23,0x24,
0x30,0x31,0x32,0x33,
0x40,0x41,0x42,
0x50,0x51,0x60,0x61,0x70,0x71,
0x80,0x90,0xa0,0xb0,0xc0,0xd0,0xe0,0xf0,
0,0,0,0,0,0,0,0,0,0,0,0,0,0};

struct Params {
  const float* x_prompt; const float* x_sample; const float* mem_prompt; const float* mem_sample;
  const float* norm_mix_g; const float* w_in; const float* na_rpb; const float* conv_w; const float* swa_sink; const float* t5_bias;
  const float* w_out; const float* norm_xa_g; const float* norm_mem_g; const float* w_xq; const float* w_xk; const float* w_xv; const float* w_xo;
  const float* norm_ffn_g; const float* peer_wq; const float* peer_subkeys; const float* peer_u; const float* peer_v; const float* final_g;
  float* x;
  unsigned char* ws;
};
constexpr size_t OFF_Z = 0;
constexpr size_t OFF_Q = 0;
constexpr size_t OFF_O = (size_t)T * 512 * 2;
constexpr size_t OFF_TOPS = (size_t)T * 1024 * 2;
constexpr size_t OFF_YMIX = OFF_Z + (size_t)T * IN_DIM * 2;
constexpr size_t OFF_WIN = OFF_YMIX + (size_t)T * DM * 2;
constexpr size_t OFF_WOUT = OFF_WIN + (size_t)2 * 2560 * 1024 * 2;
constexpr size_t OFF_WXQ = OFF_WOUT + (size_t)2 * 1024 * 1024 * 2;
constexpr size_t OFF_WXKV = OFF_WXQ + (size_t)2 * 512 * 1024 * 2;
constexpr size_t OFF_WXO = OFF_WXKV + (size_t)2 * 1024 * 1024 * 2;
constexpr size_t OFF_WPQ = OFF_WXO + (size_t)2 * 1024 * 512 * 2;
constexpr size_t OFF_SUBK = OFF_WPQ + (size_t)2 * 2048 * 1024 * 2;
constexpr size_t OFF_PU = OFF_SUBK + (size_t)2 * 8 * 2 * 128 * 128 * 2;
constexpr size_t OFF_PV = OFF_PU + (size_t)2 * 16384 * 1024 * 2;
constexpr size_t OFF_MEMKV = OFF_PV + (size_t)2 * 16384 * 1024 * 2;
constexpr size_t WS_NEED = OFF_MEMKV + (size_t)2 * 2560 * 1024 * 2;

DI unsigned pk2(float a, float b) { f32x2 v = {a, b}; return __builtin_bit_cast(unsigned, __builtin_convertvector(v, bf2_t)); }
DI bf16_t bf1(float a) { return (bf16_t)(pk2(a, 0.f) & 0xffffu); }
DI float bf_lo(unsigned u) { return __uint_as_float(u << 16); }
DI float bf_hi(unsigned u) { return __uint_as_float(u & 0xffff0000u); }
#define MFMA32(a, b, c) __builtin_amdgcn_mfma_f32_32x32x16_bf16((a), (b), (c), 0, 0, 0)
DI int crow(int i, int h) { return (i & 3) + 8 * (i >> 2) + 4 * h; }
DI int tid() { int t = threadIdx.x; asm volatile("" : "+v"(t)); return t; }
template <int CTRL> DI float dpp(float v) { return __int_as_float(__builtin_amdgcn_update_dpp(0, __float_as_int(v), CTRL, 0xf, 0xf, true)); }
DI float xor16(float v) { return __int_as_float(__builtin_amdgcn_ds_swizzle(__float_as_int(v), 0x401F)); }
DI float xor32(float v, int lane) { return __int_as_float(__builtin_amdgcn_ds_bpermute((lane ^ 32) << 2, __float_as_int(v))); }
DI float row_sum(float v) { v += dpp<0xB1>(v); v += dpp<0x4E>(v); v += dpp<0x141>(v); v += dpp<0x140>(v); return v; }
DI float wave_sum(float v, int lane) { v = row_sum(v); v += xor16(v); v += xor32(v, lane); return v; }
DI float rdlane_f(float v, int l) { return __int_as_float(__builtin_amdgcn_readlane(__float_as_int(v), l)); }

constexpr int LDT = 72;
constexpr int GEMM_BUF = 128 * LDT;
constexpr int SMEM_RSTD = 4 * GEMM_BUF * 2;
constexpr int SMEM_BYTES = SMEM_RSTD + 512;

template <bool AF32>
DI void gemm_tile(const void* __restrict__ Ap, int lda, const bf16_t* __restrict__ Bp, int K, unsigned char* smem, f32x16 (&acc)[2][2]) {
  bf16_t* As = (bf16_t*)smem; bf16_t* Bs = As + 2 * GEMM_BUF; float* rs = (float*)(smem + SMEM_RSTD);
  const int t = tid(), lane = t & 63, wid = t >> 6, wm = wid >> 1, wn = wid & 1, r = lane & 31, h = lane >> 5;
#pragma unroll
  for (int a = 0; a < 2; ++a)
#pragma unroll
    for (int b = 0; b < 2; ++b)
#pragma unroll
      for (int i = 0; i < 16; ++i) acc[a][b][i] = 0.f;
  f32x4 af[8]; u32x4 ab[4]; u32x4 bb[4]; float ss[8];
#pragma unroll
  for (int i = 0; i < 8; ++i) ss[i] = 0.f;
  const int nk = K >> 6;
  const unsigned voA = AF32 ? (unsigned)(((t >> 4) * lda + (t & 15) * 4) * 4) : (unsigned)(((t >> 3) * lda + (t & 7) * 8) * 2);
  const unsigned voB = (unsigned)(((t >> 3) * K + (t & 7) * 8) * 2);
  const char* Ac = (const char*)Ap; const char* Bc = (const char*)Bp;
#define GEMM_LDG(kt) { \
    if constexpr (AF32) { _Pragma("unroll") for (int i = 0; i < 8; ++i) af[i] = *(const f32x4*)(Ac + ((size_t)(16 * i) * lda + (kt) * 64) * 4 + voA); } \
    else { _Pragma("unroll") for (int i = 0; i < 4; ++i) ab[i] = *(const u32x4*)(Ac + ((size_t)(32 * i) * lda + (kt) * 64) * 2 + voA); } \
    _Pragma("unroll") for (int i = 0; i < 4; ++i) bb[i] = *(const u32x4*)(Bc + ((size_t)(32 * i) * K + (kt) * 64) * 2 + voB); }
#define GEMM_STS(buf) { \
    bf16_t* a_ = As + (buf) * GEMM_BUF; bf16_t* b_ = Bs + (buf) * GEMM_BUF; \
    if constexpr (AF32) { _Pragma("unroll") for (int i = 0; i < 8; ++i) { f32x4 v = af[i]; ss[i] += v.x * v.x + v.y * v.y + v.z * v.z + v.w * v.w; \
        u32x2 pk = {pk2(v.x, v.y), pk2(v.z, v.w)}; *(u32x2*)(a_ + ((t >> 4) + 16 * i) * LDT + (t & 15) * 4) = pk; } } \
    else { _Pragma("unroll") for (int i = 0; i < 4; ++i) *(u32x4*)(a_ + ((t >> 3) + 32 * i) * LDT + (t & 7) * 8) = ab[i]; } \
    _Pragma("unroll") for (int i = 0; i < 4; ++i) *(u32x4*)(b_ + ((t >> 3) + 32 * i) * LDT + (t & 7) * 8) = bb[i]; }
  GEMM_LDG(0);
  GEMM_STS(0);
  __syncthreads();
#pragma unroll 1
  for (int kt = 0; kt < nk; ++kt) {
    const int cur = kt & 1;
    if (kt + 1 < nk) GEMM_LDG(kt + 1);
    {
      const bf16_t* a = As + cur * GEMM_BUF + (64 * wm + r) * LDT + 8 * h;
      const bf16_t* b = Bs + cur * GEMM_BUF + (64 * wn + r) * LDT + 8 * h;
#pragma unroll
      for (int ks = 0; ks < 4; ++ks) {
        const bf16x8 a0 = *(const bf16x8*)(a + 16 * ks), a1 = *(const bf16x8*)(a + 32 * LDT + 16 * ks);
        const bf16x8 b0 = *(const bf16x8*)(b + 16 * ks), b1 = *(const bf16x8*)(b + 32 * LDT + 16 * ks);
        acc[0][0] = MFMA32(a0, b0, acc[0][0]); acc[0][1] = MFMA32(a0, b1, acc[0][1]);
        acc[1][0] = MFMA32(a1, b0, acc[1][0]); acc[1][1] = MFMA32(a1, b1, acc[1][1]);
      }
    }
    if (kt + 1 < nk) GEMM_STS(cur ^ 1);
    __syncthreads();
  }
#undef GEMM_LDG
#undef GEMM_STS
  if constexpr (AF32) {
#pragma unroll
    for (int i = 0; i < 8; ++i) {
      float s = ss[i];
      s = row_sum(s);
      if ((t & 15) == 0) rs[(t >> 4) + 16 * i] = rsqrtf(s * (1.0f / 1024.0f) + RMS_EPS);
    }
    __syncthreads();
  }
}

template <int LDC>
DI void epi_bf16_scaled(const f32x16 (&acc)[2][2], unsigned char* smem, bf16_t* C) {
  const float* rs = (const float*)(smem + SMEM_RSTD);
  const int t = tid(), lane = t & 63, wid = t >> 6, wm = wid >> 1, wn = wid & 1, r = lane & 31, h = lane >> 5;
  bf16_t* ct = (bf16_t*)smem + (64 * wm + 4 * h) * 136 + 64 * wn + r;
  const float* rsw = rs + 64 * wm + 4 * h;
#pragma unroll
  for (int mi = 0; mi < 2; ++mi)
#pragma unroll
    for (int i = 0; i < 16; ++i) {
      const int rowc = 32 * mi + (i & 3) + 8 * (i >> 2);
      const float sc = rsw[rowc];
#pragma unroll
      for (int ni = 0; ni < 2; ++ni) ct[rowc * 136 + 32 * ni] = bf1(acc[mi][ni][i] * sc);
    }
  __syncthreads();
  const bf16_t* cs = (const bf16_t*)smem + (t >> 4) * 136 + 8 * (t & 15);
  char* cg_ = (char*)C; const unsigned vo = (unsigned)(((t >> 4) * LDC + 8 * (t & 15)) * 2);
#pragma unroll
  for (int j = 0; j < 8; ++j) *(u32x4*)(cg_ + (size_t)(16 * j) * LDC * 2 + vo) = *(const u32x4*)(cs + 16 * j * 136);
  __syncthreads();
}
DI void epi_resid(const f32x16 (&acc)[2][2], unsigned char* smem, float* X) {
  const int t = tid(), lane = t & 63, wid = t >> 6, wm = wid >> 1, wn = wid & 1, r = lane & 31, h = lane >> 5;
  float* ct = (float*)smem + (64 * wm + 4 * h) * 132 + 64 * wn + r;
#pragma unroll
  for (int mi = 0; mi < 2; ++mi)
#pragma unroll
    for (int i = 0; i < 16; ++i) {
      const int rowc = 32 * mi + (i & 3) + 8 * (i >> 2);
#pragma unroll
      for (int ni = 0; ni < 2; ++ni) ct[rowc * 132 + 32 * ni] = acc[mi][ni][i];
    }
  __syncthreads();
  const float* cs = (const float*)smem + (t >> 5) * 132 + 4 * (t & 31);
  char* xg = (char*)X; const unsigned vo = (unsigned)(((t >> 5) * DM + 4 * (t & 31)) * 4);
#pragma unroll
  for (int j = 0; j < 16; ++j) {
    f32x4* px = (f32x4*)(xg + (size_t)(8 * j) * DM * 4 + vo);
    const f32x4 a = *(const f32x4*)(cs + 8 * j * 132);
    *px = *px + a;
  }
  __syncthreads();
}

template <int D, class F>
DI void attn_tile(const bf16_t* Ks, const bf16_t* Vt, const bf16x8 (&qf)[D / 16], f32x16 (&o)[D / 32], float& m, float& l, F fn, int r, int h, int lane) {
  f32x16 s;
#pragma unroll
  for (int i = 0; i < 16; ++i) s[i] = 0.f;
#pragma unroll
  for (int ks = 0; ks < D / 16; ++ks) { const bf16x8 a = *(const bf16x8*)(Ks + r * (D + 8) + 16 * ks + 8 * h); s = MFMA32(a, qf[ks], s); }
  float mx = -INFINITY;
#pragma unroll
  for (int i = 0; i < 16; ++i) { s[i] = fn(s[i], i); mx = fmaxf(mx, s[i]); }
  mx = fmaxf(mx, xor32(mx, lane));
  const float mn = fmaxf(m, mx);
  const float alpha = __builtin_amdgcn_exp2f(m - mn);
  m = mn;
  float sum = 0.f;
#pragma unroll
  for (int i = 0; i < 16; ++i) { s[i] = __builtin_amdgcn_exp2f(s[i] - mn); sum += s[i]; }
  l = l * alpha + sum;
#pragma unroll
  for (int dt = 0; dt < D / 32; ++dt)
#pragma unroll
    for (int i = 0; i < 16; ++i) o[dt][i] *= alpha;
  bf16x8 pf[2];
#pragma unroll
  for (int s2 = 0; s2 < 2; ++s2) {
    u32x4 pk = {pk2(s[8 * s2], s[8 * s2 + 1]), pk2(s[8 * s2 + 2], s[8 * s2 + 3]), pk2(s[8 * s2 + 4], s[8 * s2 + 5]), pk2(s[8 * s2 + 6], s[8 * s2 + 7])};
    pf[s2] = __builtin_bit_cast(bf16x8, pk);
  }
#pragma unroll
  for (int dt = 0; dt < D / 32; ++dt)
#pragma unroll
    for (int s2 = 0; s2 < 2; ++s2) {
      const bf16_t* vp = Vt + (32 * dt + r) * 40 + 16 * s2 + 4 * h;
      const s16x4 lo = *(const s16x4*)vp, hi = *(const s16x4*)(vp + 8);
      const bf16x8 a = __builtin_shufflevector(lo, hi, 0, 1, 2, 3, 4, 5, 6, 7);
      o[dt] = MFMA32(a, pf[s2], o[dt]);
    }
}
DI void vt_store(bf16_t* Vt, u32x4 v, int c8, int kk) {
#pragma unroll
  for (int e = 0; e < 8; ++e) Vt[(8 * c8 + e) * 40 + kk] = (bf16_t)((v[e >> 1] >> (16 * (e & 1))) & 0xffffu);
}
template <int ND>
DI void attn_out(const f32x16 (&o)[ND], float l, bf16_t* yp, int h, int lane) {
  const float lt = l + xor32(l, lane);
  const float inv = 1.0f / lt;
#pragma unroll
  for (int dt = 0; dt < ND; ++dt)
#pragma unroll
    for (int g = 0; g < 4; ++g) {
      u32x2 v = {pk2(o[dt][4 * g] * inv, o[dt][4 * g + 1] * inv), pk2(o[dt][4 * g + 2] * inv, o[dt][4 * g + 3] * inv)};
      *(u32x2*)(yp + 32 * dt + 8 * g + 4 * h) = v;
    }
}

constexpr int AT64_BUF = 32 * 72 + 64 * 40;
DI void swa_item(const Params& p, int l, int item, unsigned char* smem) {
  const int t = tid(), lane = t & 63, w = t >> 6, r = lane & 31, h = lane >> 5;
  const int head = item % 6, n = (item / 6) & 63, b = item / 384, hkv = head / 3;
  bf16_t* st = (bf16_t*)smem;
  float* bt = (float*)(smem + 2 * AT64_BUF * 2);
  __syncthreads();
  for (int i = t; i < 257; i += 256) bt[i] = p.t5_bias[T5TAB[i] * 6 + head] * LOG2E;
  const size_t tok0 = (size_t)b * SEQ;
  const int q0 = n * 128 + 32 * w;
  bf16x8 qf[4];
  { const bf16_t* qp = ((bf16_t*)(p.ws + OFF_Z)) + (tok0 + q0 + r) * IN_DIM + Z_SWQ + head * 64 + 8 * h;
#pragma unroll
    for (int ks = 0; ks < 4; ++ks) qf[ks] = *(const bf16x8*)(qp + 16 * ks); }
  f32x16 o[2];
#pragma unroll
  for (int dt = 0; dt < 2; ++dt)
#pragma unroll
    for (int i = 0; i < 16; ++i) o[dt][i] = 0.f;
  float m = p.swa_sink[l * 6 + head] * LOG2E, lsum = (h == 0) ? 1.f : 0.f;
  const int kt_lo = (n == 0) ? 4 : 0, kt_hi = (n == 63) ? 8 : 12;
  const int kk = t >> 3, c8 = t & 7;
  const bf16_t* kbase = ((bf16_t*)(p.ws + OFF_Z)) + (tok0 + (size_t)(n * 128 + kk)) * IN_DIM + Z_SWK + hkv * 64 + 8 * c8;
  u32x4 kr, vr;
  { const bf16_t* kp = kbase + (ptrdiff_t)(32 * kt_lo - 128) * IN_DIM; kr = *(const u32x4*)kp; vr = *(const u32x4*)(kp + 128); }
  *(u32x4*)(st + kk * 72 + 8 * c8) = kr; vt_store(st + 32 * 72, vr, c8, kk);
  __syncthreads();
  const float sc2 = 0.125f * LOG2E;
  for (int kt = kt_lo; kt < kt_hi; ++kt) {
    const int cur = (kt - kt_lo) & 1;
    if (kt + 1 < kt_hi) { const bf16_t* kp = kbase + (ptrdiff_t)(32 * (kt + 1) - 128) * IN_DIM; kr = *(const u32x4*)kp; vr = *(const u32x4*)(kp + 128); }
    if (kt >= w && kt <= w + 8) {
      const int kb = 32 * kt - 128 - 32 * w - r + 4 * h;
      attn_tile<64>(st + cur * AT64_BUF, st + cur * AT64_BUF + 32 * 72, qf, o, m, lsum,
        [&](float sv, int i) { const int oi = kb + (i & 3) + 8 * (i >> 2) + 128; const bool ok = (unsigned)oi <= 256u; const float bias = bt[ok ? oi : 0]; return ok ? sv * sc2 + bias : -INFINITY; }, r, h, lane);
    }
    if (kt + 1 < kt_hi) { bf16_t* sb = st + (cur ^ 1) * AT64_BUF; *(u32x4*)(sb + kk * 72 + 8 * c8) = kr; vt_store(sb + 32 * 72, vr, c8, kk); }
    __syncthreads();
  }
  attn_out<2>(o, lsum, ((bf16_t*)(p.ws + OFF_YMIX)) + (tok0 + q0 + r) * DM + 640 + head * 64, h, lane);
}

DI void na_item(const Params& p, int l, int item, unsigned char* smem) {
  const int t = tid(), lane = t & 63, w = t >> 6, r = lane & 31, h = lane >> 5;
  const int hp = item % 3, rr = (item / 3) & 127, b = item / 384;
  const int hh = w >> 1, qh = w & 1, head = 2 * hp + hh;
  bf16_t* st = (bf16_t*)smem;
  constexpr int NBUF = 2 * AT64_BUF;
  float* bt = (float*)(smem + 2 * NBUF * 2);
  __syncthreads();
  for (int i = t; i < 930; i += 256) { const int e = i % 465, hsel = i / 465; bt[i] = p.na_rpb[((size_t)l * 465 + e) * 6 + 2 * hp + hsel] * LOG2E; }
  const size_t tok0 = (size_t)b * SEQ;
  const int r0 = min(max(rr - 4, 0), 120);
  const int c = 32 * qh + r;
  bf16x8 qf[4];
  { const bf16_t* qp = ((bf16_t*)(p.ws + OFF_Z)) + (tok0 + rr * 64 + c) * IN_DIM + Z_NAQ + head * 64 + 8 * h;
#pragma unroll
    for (int ks = 0; ks < 4; ++ks) qf[ks] = *(const bf16x8*)(qp + 16 * ks); }
  f32x16 o[2];
#pragma unroll
  for (int dt = 0; dt < 2; ++dt)
#pragma unroll
    for (int i = 0; i < 16; ++i) o[dt][i] = 0.f;
  float m = -1e30f, lsum = 0.f;
  const int kk = t >> 3, c8 = t & 7;
  const bf16_t* kbase = ((bf16_t*)(p.ws + OFF_Z)) + (tok0 + (size_t)((r0 + (kk >> 4)) * 64 + (kk & 15))) * IN_DIM + Z_NAK + (2 * hp) * 64 + 8 * c8;
  u32x4 k0r, k1r, v0r, v1r;
#define NA_LDG(kt) { const bf16_t* kp = kbase + (size_t)(((kt) >> 2) * 128 + ((kt) & 3) * 16) * IN_DIM; \
    k0r = *(const u32x4*)kp; k1r = *(const u32x4*)(kp + 64); v0r = *(const u32x4*)(kp + 384); v1r = *(const u32x4*)(kp + 448); }
#define NA_STS(buf) { bf16_t* sb = st + (buf) * NBUF; *(u32x4*)(sb + kk * 72 + 8 * c8) = k0r; *(u32x4*)(sb + AT64_BUF + kk * 72 + 8 * c8) = k1r; \
    vt_store(sb + 32 * 72, v0r, c8, kk); vt_store(sb + AT64_BUF + 32 * 72, v1r, c8, kk); }
  NA_LDG(0);
  NA_STS(0);
  __syncthreads();
  const float sc2 = 0.125f * LOG2E;
  const int c0 = min(max(c - 8, 0), 48);
  const float* bth = bt + hh * 465;
  for (int kt = 0; kt < 16; ++kt) {
    const int cur = kt & 1;
    if (kt + 1 < 16) NA_LDG(kt + 1);
    const int rp = kt >> 2, cb = kt & 3;
    if (cb >= qh && cb <= qh + 2) {
      const bf16_t* sb = st + cur * NBUF + hh * AT64_BUF;
      const int drb = r0 + 2 * rp - rr + 7;
      const int kcb = 16 * cb;
      attn_tile<64>(sb, sb + 32 * 72, qf, o, m, lsum,
        [&](float sv, int i) { const int kq = (i & 3) + 8 * (i >> 2) + 4 * h; const int kcol = kcb + (kq & 15); const int dr = drb + (kq >> 4);
          const bool ok = (kcol >= c0) && (kcol < c0 + 16); const int bi = dr * 31 + (kcol - c + 15); const float bias = bth[ok ? bi : 0];
          return ok ? sv * sc2 + bias : -INFINITY; }, r, h, lane);
    }
    if (kt + 1 < 16) NA_STS(cur ^ 1);
    __syncthreads();
  }
#undef NA_LDG
#undef NA_STS
  attn_out<2>(o, lsum, ((bf16_t*)(p.ws + OFF_YMIX)) + (tok0 + rr * 64 + c) * DM + head * 64, h, lane);
}

DI void conv_item(const Params& p, int l, int item) {
  const int t = tid();
  const size_t tok = (size_t)item * 8 + (t >> 5);
  const int c8 = t & 31, pos = (int)(tok & (SEQ - 1));
  const bf16_t* zr = ((bf16_t*)(p.ws + OFF_Z)) + tok * IN_DIM + 8 * c8;
  const u32x4 bv = *(const u32x4*)(zr + Z_SCB);
  const u32x4 cc = *(const u32x4*)(zr + Z_SCC), hc = *(const u32x4*)(zr + Z_SCH);
  u32x4 cm = {0, 0, 0, 0}, hm = {0, 0, 0, 0}, cp = {0, 0, 0, 0}, hpv = {0, 0, 0, 0};
  if (pos > 0) { cm = *(const u32x4*)(zr - IN_DIM + Z_SCC); hm = *(const u32x4*)(zr - IN_DIM + Z_SCH); }
  if (pos < SEQ - 1) { cp = *(const u32x4*)(zr + IN_DIM + Z_SCC); hpv = *(const u32x4*)(zr + IN_DIM + Z_SCH); }
  const float* cw = p.conv_w + (size_t)l * 3 * 256 + 8 * c8;
  float y[8];
#pragma unroll
  for (int e = 0; e < 8; ++e) {
    const int wd = e >> 1;
    const float fb = (e & 1) ? bf_hi(bv[wd]) : bf_lo(bv[wd]);
    const float um = ((e & 1) ? bf_hi(cm[wd]) : bf_lo(cm[wd])) * ((e & 1) ? bf_hi(hm[wd]) : bf_lo(hm[wd]));
    const float uc = ((e & 1) ? bf_hi(cc[wd]) : bf_lo(cc[wd])) * ((e & 1) ? bf_hi(hc[wd]) : bf_lo(hc[wd]));
    const float up = ((e & 1) ? bf_hi(cp[wd]) : bf_lo(cp[wd])) * ((e & 1) ? bf_hi(hpv[wd]) : bf_lo(hpv[wd]));
    y[e] = fb * (um * cw[e] + uc * cw[256 + e] + up * cw[512 + e]);
  }
  u32x4 ov = {pk2(y[0], y[1]), pk2(y[2], y[3]), pk2(y[4], y[5]), pk2(y[6], y[7])};
  *(u32x4*)(((bf16_t*)(p.ws + OFF_YMIX)) + tok * DM + 384 + 8 * c8) = ov;
}

constexpr int AT128_BUF = 32 * 136 + 128 * 40;
DI void xattn_item(const Params& p, int l, int item, unsigned char* smem) {
  const int t = tid(), lane = t & 63, w = t >> 6, r = lane & 31, h = lane >> 5;
  const int qt = item & 63, head = (item >> 6) & 3, b = item >> 8;
  bf16_t* st = (bf16_t*)smem;
  const size_t tok = (size_t)b * SEQ + qt * 128 + 32 * w + r;
  bf16x8 qf[8];
  { const bf16_t* qp = ((bf16_t*)(p.ws + OFF_Q)) + tok * 512 + head * 128 + 8 * h;
#pragma unroll
    for (int ks = 0; ks < 8; ++ks) qf[ks] = *(const bf16x8*)(qp + 16 * ks); }
  f32x16 o[4];
#pragma unroll
  for (int dt = 0; dt < 4; ++dt)
#pragma unroll
    for (int i = 0; i < 16; ++i) o[dt][i] = 0.f;
  float m = -1e30f, lsum = 0.f;
  const int kk = t >> 4, c8 = t & 15;
  const bf16_t* kbase = ((bf16_t*)(p.ws + OFF_MEMKV)) + ((size_t)l * 2560 + (size_t)b * 256 + kk) * 1024 + head * 128 + 8 * c8;
  u32x4 k0r, k1r, v0r, v1r;
#define XA_LDG(kt) { const bf16_t* kp = kbase + (size_t)(32 * (kt)) * 1024; \
    k0r = *(const u32x4*)kp; k1r = *(const u32x4*)(kp + 16 * 1024); v0r = *(const u32x4*)(kp + 512); v1r = *(const u32x4*)(kp + 16 * 1024 + 512); }
#define XA_STS(buf) { bf16_t* sb = st + (buf) * AT128_BUF; *(u32x4*)(sb + kk * 136 + 8 * c8) = k0r; *(u32x4*)(sb + (kk + 16) * 136 + 8 * c8) = k1r; \
    vt_store(sb + 32 * 136, v0r, c8, kk); vt_store(sb + 32 * 136, v1r, c8, kk + 16); }
  __syncthreads();
  XA_LDG(0);
  XA_STS(0);
  __syncthreads();
  const float sc2 = 0.08838834764831845f * LOG2E;
  for (int kt = 0; kt < 8; ++kt) {
    const int cur = kt & 1;
    if (kt + 1 < 8) XA_LDG(kt + 1);
    { const bf16_t* sb = st + cur * AT128_BUF;
      attn_tile<128>(sb, sb + 32 * 136, qf, o, m, lsum, [&](float sv, int) { return sv * sc2; }, r, h, lane); }
    if (kt + 1 < 8) XA_STS(cur ^ 1);
    __syncthreads();
  }
#undef XA_LDG
#undef XA_STS
  attn_out<4>(o, lsum, ((bf16_t*)(p.ws + OFF_O)) + tok * 512 + head * 128, h, lane);
}

DI void transpose_job(const float* __restrict__ src, int K, int N, const float* __restrict__ g, bf16_t* __restrict__ dst, unsigned char* smem) {
  float* tl = (float*)smem;
  const int tn = N / 64, ntile = (K / 64) * tn, t = threadIdx.x;
  for (int tile = blockIdx.x; tile < ntile; tile += gridDim.x) {
    const int k0 = (tile / tn) * 64, n0 = (tile % tn) * 64;
    __syncthreads();
#pragma unroll 4
    for (int i = 0; i < 16; ++i) { const int kk = (t >> 6) + 4 * i; float v = src[(size_t)(k0 + kk) * N + n0 + (t & 63)]; if (g) v *= g[k0 + kk]; tl[kk * 65 + (t & 63)] = v; }
    __syncthreads();
#pragma unroll 4
    for (int i = 0; i < 16; ++i) { const int nn = (t >> 6) + 4 * i; dst[(size_t)(n0 + nn) * K + k0 + (t & 63)] = bf1(tl[(t & 63) * 65 + nn]); }
  }
}
DI void convert_job(const float* __restrict__ src, bf16_t* __restrict__ dst, size_t n4) {
  for (size_t i = (size_t)blockIdx.x * 256 + threadIdx.x; i < n4; i += (size_t)gridDim.x * 256) {
    const f32x4 v = ((const f32x4*)src)[i];
    u32x2 o = {pk2(v.x, v.y), pk2(v.z, v.w)};
    ((u32x2*)dst)[i] = o;
  }
}

constexpr float F8_SCALE = 64.0f, F8_INV = 1.0f / 64.0f;
DI unsigned pk4_fp8(f32x4 v) {
  int w = 0;
  w = __builtin_amdgcn_cvt_pk_fp8_f32(v.x * F8_SCALE, v.y * F8_SCALE, w, false);
  w = __builtin_amdgcn_cvt_pk_fp8_f32(v.z * F8_SCALE, v.w * F8_SCALE, w, true);
  return (unsigned)w;
}
DI void convert_fp8_job(const float* __restrict__ src, unsigned char* __restrict__ dst, size_t n16) {
  for (size_t i = (size_t)blockIdx.x * 256 + threadIdx.x; i < n16; i += (size_t)gridDim.x * 256) {
    const f32x4* s = (const f32x4*)src + 4 * i;
    u32x4 o = {pk4_fp8(s[0]), pk4_fp8(s[1]), pk4_fp8(s[2]), pk4_fp8(s[3])};
    ((u32x4*)dst)[i] = o;
  }
}

DI void phase_prologue(const Params& p, unsigned char* smem) {
  { const size_t n4p = (size_t)16384 * 256, n4 = (size_t)T * 256;
    for (size_t i = (size_t)blockIdx.x * 256 + threadIdx.x; i < n4; i += (size_t)gridDim.x * 256)
      ((f32x4*)p.x)[i] = (i < n4p) ? ((const f32x4*)p.x_prompt)[i] : ((const f32x4*)p.x_sample)[i - n4p]; }
  for (int l = 0; l < 2; ++l) {
    transpose_job(p.w_in + (size_t)l * 1024 * 2560, 1024, 2560, p.norm_mix_g + l * 1024, ((bf16_t*)(p.ws + OFF_WIN)) + (size_t)l * 2560 * 1024, smem);
    transpose_job(p.w_out + (size_t)l * 1024 * 1024, 1024, 1024, nullptr, ((bf16_t*)(p.ws + OFF_WOUT)) + (size_t)l * 1024 * 1024, smem);
    transpose_job(p.w_xq + (size_t)l * 1024 * 512, 1024, 512, p.norm_xa_g + l * 1024, ((bf16_t*)(p.ws + OFF_WXQ)) + (size_t)l * 512 * 1024, smem);
    transpose_job(p.w_xk + (size_t)l * 1024 * 512, 1024, 512, p.norm_mem_g + l * 1024, ((bf16_t*)(p.ws + OFF_WXKV)) + (size_t)l * 1024 * 1024, smem);
    transpose_job(p.w_xv + (size_t)l * 1024 * 512, 1024, 512, p.norm_mem_g + l * 1024, ((bf16_t*)(p.ws + OFF_WXKV)) + (size_t)l * 1024 * 1024 + (size_t)512 * 1024, smem);
    transpose_job(p.w_xo + (size_t)l * 512 * 1024, 512, 1024, nullptr, ((bf16_t*)(p.ws + OFF_WXO)) + (size_t)l * 1024 * 512, smem);
    transpose_job(p.peer_wq + (size_t)l * 1024 * 2048, 1024, 2048, p.norm_ffn_g + l * 1024, ((bf16_t*)(p.ws + OFF_WPQ)) + (size_t)l * 2048 * 1024, smem);
  }
  convert_job(p.peer_subkeys, ((bf16_t*)(p.ws + OFF_SUBK)), (size_t)2 * 8 * 2 * 128 * 128 / 4);
  convert_fp8_job(p.peer_u, (unsigned char*)(p.ws + OFF_PU), (size_t)2 * 16384 * 1024 / 16);
  convert_fp8_job(p.peer_v, (unsigned char*)(p.ws + OFF_PV), (size_t)2 * 16384 * 1024 / 16);
}

#define TILE_WALK(NT, MT8) const int nx_ = gridDim.x >> 3, xcd_ = blockIdx.x & 7; \
  for (int j_ = blockIdx.x >> 3; j_ < (MT8) * (NT); j_ += nx_) { const int mt = (j_ / (NT)) * 8 + xcd_, nt = j_ % (NT);

DI void phase_in_gemm(const Params& p, int l, unsigned char* smem) {
  f32x16 acc[2][2];
  { TILE_WALK(20, 80)
    gemm_tile<true>(p.x + (size_t)mt * 128 * DM, DM, ((bf16_t*)(p.ws + OFF_WIN)) + ((size_t)l * 2560 + nt * 128) * 1024, 1024, smem, acc);
    epi_bf16_scaled<IN_DIM>(acc, smem, ((bf16_t*)(p.ws + OFF_Z)) + (size_t)mt * 128 * IN_DIM + nt * 128);
  } }
  if (l == 0) {
    for (int j = blockIdx.x; j < 20 * 8 * 2; j += gridDim.x) {
      const int ll = j / 160, mt = (j % 160) >> 3, nt = j & 7, b = mt >> 1;
      const float* A = (b < 2 ? p.mem_prompt + (size_t)b * 256 * DM : p.mem_sample + (size_t)(b - 2) * 256 * DM) + (size_t)(mt & 1) * 128 * DM;
      gemm_tile<true>(A, DM, ((bf16_t*)(p.ws + OFF_WXKV)) + ((size_t)ll * 1024 + nt * 128) * 1024, 1024, smem, acc);
      epi_bf16_scaled<1024>(acc, smem, ((bf16_t*)(p.ws + OFF_MEMKV)) + ((size_t)ll * 2560 + mt * 128) * 1024 + nt * 128);
    }
  }
}
DI void phase_out_gemm(const Params& p, int l, unsigned char* smem) {
  f32x16 acc[2][2];
  TILE_WALK(8, 80)
    gemm_tile<false>(((bf16_t*)(p.ws + OFF_YMIX)) + (size_t)mt * 128 * DM, DM, ((bf16_t*)(p.ws + OFF_WOUT)) + ((size_t)l * 1024 + nt * 128) * 1024, 1024, smem, acc);
    epi_resid(acc, smem, p.x + (size_t)mt * 128 * DM + nt * 128);
  }
}
DI void phase_xq_gemm(const Params& p, int l, unsigned char* smem) {
  f32x16 acc[2][2];
  TILE_WALK(4, 80)
    gemm_tile<true>(p.x + (size_t)mt * 128 * DM, DM, ((bf16_t*)(p.ws + OFF_WXQ)) + ((size_t)l * 512 + nt * 128) * 1024, 1024, smem, acc);
    epi_bf16_scaled<512>(acc, smem, ((bf16_t*)(p.ws + OFF_Q)) + (size_t)mt * 128 * 512 + nt * 128);
  }
}
DI void phase_xo_gemm(const Params& p, int l, unsigned char* smem) {
  f32x16 acc[2][2];
  TILE_WALK(8, 80)
    gemm_tile<false>(((bf16_t*)(p.ws + OFF_O)) + (size_t)mt * 128 * 512, 512, ((bf16_t*)(p.ws + OFF_WXO)) + ((size_t)l * 1024 + nt * 128) * 512, 512, smem, acc);
    epi_resid(acc, smem, p.x + (size_t)mt * 128 * DM + nt * 128);
  }
}
DI void phase_peer_q(const Params& p, int l, unsigned char* smem) {
  f32x16 acc[2][2];
  const int t = tid(), lane = t & 63, wid = t >> 6, wm = wid >> 1, wn = wid & 1, r = lane & 31, h = lane >> 5;
  const float* rs = (const float*)(smem + SMEM_RSTD);
  bf16_t* Qs = (bf16_t*)smem; bf16_t* SKs = Qs + 128 * 136;
  TILE_WALK(16, 80)
    gemm_tile<true>(p.x + (size_t)mt * 128 * DM, DM, ((bf16_t*)(p.ws + OFF_WPQ)) + ((size_t)l * 2048 + nt * 128) * 1024, 1024, smem, acc);
#pragma unroll
    for (int mi = 0; mi < 2; ++mi)
#pragma unroll
      for (int i = 0; i < 16; ++i) {
        const int row = 64 * wm + 32 * mi + crow(i, h);
        const float sc = rs[row];
#pragma unroll
        for (int ni = 0; ni < 2; ++ni) Qs[row * 136 + 64 * wn + 32 * ni + r] = bf1(acc[mi][ni][i] * sc);
      }
    { const bf16_t* sk = ((bf16_t*)(p.ws + OFF_SUBK)) + ((size_t)(l * 16 + nt) * 128) * 128;
#pragma unroll
      for (int i = 0; i < 8; ++i) { const int row = (t >> 4) + 16 * i, c8 = t & 15; *(u32x4*)(SKs + row * 136 + 8 * c8) = *(const u32x4*)(sk + row * 128 + 8 * c8); } }
    __syncthreads();
    f32x16 sc[4];
#pragma unroll
    for (int n4 = 0; n4 < 4; ++n4)
#pragma unroll
      for (int i = 0; i < 16; ++i) sc[n4][i] = 0.f;
#pragma unroll 2
    for (int ks = 0; ks < 8; ++ks) {
      const bf16x8 bq = *(const bf16x8*)(Qs + (32 * wid + r) * 136 + 16 * ks + 8 * h);
#pragma unroll
      for (int n4 = 0; n4 < 4; ++n4) { const bf16x8 a = *(const bf16x8*)(SKs + (32 * n4 + r) * 136 + 16 * ks + 8 * h); sc[n4] = MFMA32(a, bq, sc[n4]); }
    }
    __syncthreads();
#pragma unroll
    for (int n4 = 0; n4 < 4; ++n4)
#pragma unroll
      for (int i = 0; i < 16; ++i) sc[n4][i] = __uint_as_float((__float_as_uint(sc[n4][i]) & ~127u) | (unsigned)(32 * n4 + crow(i, h)));
    float res[16];
#pragma unroll
    for (int rd = 0; rd < 16; ++rd) {
      float mx = -INFINITY;
#pragma unroll
      for (int n4 = 0; n4 < 4; ++n4)
#pragma unroll
        for (int i = 0; i < 16; ++i) mx = fmaxf(mx, sc[n4][i]);
      const float M = fmaxf(mx, xor32(mx, lane));
      res[rd] = M;
#pragma unroll
      for (int n4 = 0; n4 < 4; ++n4)
#pragma unroll
        for (int i = 0; i < 16; ++i) sc[n4][i] = (sc[n4][i] == M) ? -INFINITY : sc[n4][i];
    }
    if (h == 0) {
      float* dst = ((float*)(p.ws + OFF_TOPS)) + (((size_t)mt * 128 + 32 * wid + r) * 16 + nt) * 16;
#pragma unroll
      for (int g = 0; g < 4; ++g) { f32x4 v = {res[4 * g], res[4 * g + 1], res[4 * g + 2], res[4 * g + 3]}; *(f32x4*)(dst + 4 * g) = v; }
    }
  }
}

DI void fp8x16_dot(const u32x4 u, const float (&xn)[16], float& d) {
#pragma unroll
  for (int dw = 0; dw < 4; ++dw) {
    const f32x2 lo = __builtin_amdgcn_cvt_pk_f32_fp8((int)u[dw], false), hi = __builtin_amdgcn_cvt_pk_f32_fp8((int)u[dw], true);
    d += lo.x * xn[4 * dw] + lo.y * xn[4 * dw + 1]; d += hi.x * xn[4 * dw + 2] + hi.y * xn[4 * dw + 3];
  }
}
DI void fp8x16_axpy(const u32x4 u, float w, float (&out)[16]) {
#pragma unroll
  for (int dw = 0; dw < 4; ++dw) {
    const f32x2 lo = __builtin_amdgcn_cvt_pk_f32_fp8((int)u[dw], false), hi = __builtin_amdgcn_cvt_pk_f32_fp8((int)u[dw], true);
    out[4 * dw] += w * lo.x; out[4 * dw + 1] += w * lo.y; out[4 * dw + 2] += w * hi.x; out[4 * dw + 3] += w * hi.y;
  }
}
DI void phase_peer_experts(const Params& p, int l, bool last) {
  const int t = tid(), lane = t & 63, wid = t >> 6;
  const unsigned char* pu = (const unsigned char*)(p.ws + OFF_PU) + (size_t)l * 16384 * 1024 + 16 * lane;
  const unsigned char* pv = (const unsigned char*)(p.ws + OFF_PV) + (size_t)l * 16384 * 1024 + 16 * lane;
  const float* gf = p.norm_ffn_g + l * 1024 + 16 * lane;
  const int pr = PAIRTAB[lane], ci = pr >> 4, cj = pr & 15;
  for (int tok = blockIdx.x * 4 + wid; tok < T; tok += gridDim.x * 4) {
    float* xr = p.x + (size_t)tok * DM + 16 * lane;
    float xn[16], out[16];
    {
      f32x4 xa[4];
#pragma unroll
      for (int k = 0; k < 4; ++k) xa[k] = *(const f32x4*)(xr + 4 * k);
      float ss = 0.f;
#pragma unroll
      for (int k = 0; k < 4; ++k) ss += xa[k].x * xa[k].x + xa[k].y * xa[k].y + xa[k].z * xa[k].z + xa[k].w * xa[k].w;
      ss = wave_sum(ss, lane);
      const float rstd = rsqrtf(ss * (1.0f / 1024.0f) + RMS_EPS);
#pragma unroll
      for (int k = 0; k < 4; ++k) { const f32x4 g = *(const f32x4*)(gf + 4 * k);
        xn[4 * k] = xa[k].x * rstd * g.x; xn[4 * k + 1] = xa[k].y * rstd * g.y; xn[4 * k + 2] = xa[k].z * rstd * g.z; xn[4 * k + 3] = xa[k].w * rstd * g.w; }
    }
#pragma unroll
    for (int k = 0; k < 16; ++k) out[k] = 0.f;
    const float* ts = ((float*)(p.ws + OFF_TOPS)) + (size_t)tok * 256;
    for (int hd = 0; hd < 8; ++hd) {
      const float sa = ts[hd * 32 + ci], sb = ts[hd * 32 + 16 + cj];
      const float val = (lane < 50) ? sa + sb : -INFINITY;
      const int idx = (int)((__float_as_uint(sa) & 127u) * 128u + (__float_as_uint(sb) & 127u));
      int rank = 0;
#pragma unroll
      for (int c = 0; c < 50; ++c) { const float vc = rdlane_f(val, c); rank += ((vc > val) || (vc == val && c < lane)) ? 1 : 0; }
      const bool selected = (rank < 16) && (lane < 50);
      unsigned long long sel = __ballot(selected);
      const float vmax = rdlane_f(val, 0);
      const float e = selected ? __expf(val - vmax) : 0.f;
      const float esum = wave_sum(e, lane);
      const float gate = e / esum;
      int ce = 0; float cgt = 0.f;
#pragma unroll
      for (int rd = 0; rd < 16; ++rd) {
        const int s = __ffsll((long long)sel) - 1; sel &= sel - 1;
        const int ex = __builtin_amdgcn_readlane(idx, s); const float gg = rdlane_f(gate, s);
        ce = (lane == rd) ? ex : ce; cgt = (lane == rd) ? gg : cgt;
      }
      float myd = 0.f;
      {
        u32x4 u[16];
#pragma unroll
        for (int k = 0; k < 16; ++k) { const int ex = __builtin_amdgcn_readlane(ce, k); u[k] = *(const u32x4*)(pu + (size_t)ex * 1024); }
#pragma unroll
        for (int k = 0; k < 16; ++k) {
          float d = 0.f;
          fp8x16_dot(u[k], xn, d);
          d = wave_sum(d, lane);
          myd = (lane == k) ? d : myd;
        }
      }
      myd *= F8_INV;
      const float wgt = cgt * (0.5f * myd * (1.0f + erff(myd * 0.70710678118654752f))) * F8_INV;
      {
        u32x4 u[16];
#pragma unroll
        for (int k = 0; k < 16; ++k) { const int ex = __builtin_amdgcn_readlane(ce, k); u[k] = *(const u32x4*)(pv + (size_t)ex * 1024); }
#pragma unroll
        for (int k = 0; k < 16; ++k) fp8x16_axpy(u[k], rdlane_f(wgt, k), out);
      }
    }
    f32x4 xo[4];
#pragma unroll
    for (int k = 0; k < 4; ++k) { const f32x4 xa = *(const f32x4*)(xr + 4 * k); xo[k].x = xa.x + out[4 * k]; xo[k].y = xa.y + out[4 * k + 1]; xo[k].z = xa.z + out[4 * k + 2]; xo[k].w = xa.w + out[4 * k + 3]; }
    if (last) {
      float s2 = 0.f;
#pragma unroll
      for (int k = 0; k < 4; ++k) s2 += xo[k].x * xo[k].x + xo[k].y * xo[k].y + xo[k].z * xo[k].z + xo[k].w * xo[k].w;
      s2 = wave_sum(s2, lane);
      const float r2 = rsqrtf(s2 * (1.0f / 1024.0f) + RMS_EPS);
      const float* fg = p.final_g + 16 * lane;
#pragma unroll
      for (int k = 0; k < 4; ++k) xo[k] = xo[k] * r2 * *(const f32x4*)(fg + 4 * k);
    }
#pragma unroll
    for (int k = 0; k < 4; ++k) *(f32x4*)(xr + 4 * k) = xo[k];
  }
}

DI void run_phase(const Params& p, int ph, unsigned char* smem) {
  if (ph == 0) { phase_prologue(p, smem); return; }
  const int l = (ph - 1) >> 3, s = (ph - 1) & 7;
  switch (s) {
    case 0: phase_in_gemm(p, l, smem); break;
    case 1:
      for (int it = blockIdx.x; it < 3840; it += gridDim.x) na_item(p, l, it, smem);
      for (int it = blockIdx.x; it < 3840; it += gridDim.x) swa_item(p, l, it, smem);
      for (int it = blockIdx.x; it < 10240; it += gridDim.x) conv_item(p, l, it);
      break;
    case 2: phase_out_gemm(p, l, smem); break;
    case 3: phase_xq_gemm(p, l, smem); break;
    case 4: for (int it = blockIdx.x; it < 2560; it += gridDim.x) xattn_item(p, l, it, smem); break;
    case 5: phase_xo_gemm(p, l, smem); break;
    case 6: phase_peer_q(p, l, smem); break;
    case 7: phase_peer_experts(p, l, l == 1); break;
  }
}
#if ONE_LAUNCH
template <int L>
DI void run_layer(const Params& p, unsigned char* smem, cg::grid_group& grid) {
  phase_in_gemm(p, L, smem); grid.sync();
  for (int it = blockIdx.x; it < 3840; it += gridDim.x) na_item(p, L, it, smem);
  for (int it = blockIdx.x; it < 3840; it += gridDim.x) swa_item(p, L, it, smem);
  for (int it = blockIdx.x; it < 10240; it += gridDim.x) conv_item(p, L, it);
  grid.sync();
  phase_out_gemm(p, L, smem); grid.sync();
  phase_xq_gemm(p, L, smem); grid.sync();
  for (int it = blockIdx.x; it < 2560; it += gridDim.x) xattn_item(p, L, it, smem);
  grid.sync();
  phase_xo_gemm(p, L, smem); grid.sync();
  phase_peer_q(p, L, smem); grid.sync();
  phase_peer_experts(p, L, L == 1);
}
__global__ void __launch_bounds__(256, 2) fwd(Params p) {
  __shared__ __attribute__((aligned(16))) unsigned char smem[SMEM_BYTES];
  cg::grid_group grid = cg::this_grid();
  phase_prologue(p, smem); grid.sync();
  run_layer<0>(p, smem, grid); grid.sync();
  run_layer<1>(p, smem, grid);
}
#else
#define DK(name, body) __global__ void __launch_bounds__(256, 2) name(Params p, int l) { __shared__ __attribute__((aligned(16))) unsigned char smem[SMEM_BYTES]; body; }
DK(k_prologue, phase_prologue(p, smem))
DK(k_in_gemm, phase_in_gemm(p, l, smem))
DK(k_na, for (int it = blockIdx.x; it < 3840; it += gridDim.x) na_item(p, l, it, smem))
DK(k_swa, for (int it = blockIdx.x; it < 3840; it += gridDim.x) swa_item(p, l, it, smem))
DK(k_conv, for (int it = blockIdx.x; it < 10240; it += gridDim.x) conv_item(p, l, it))
DK(k_out_gemm, phase_out_gemm(p, l, smem))
DK(k_xq_gemm, phase_xq_gemm(p, l, smem))
DK(k_xattn, for (int it = blockIdx.x; it < 2560; it += gridDim.x) xattn_item(p, l, it, smem))
DK(k_xo_gemm, phase_xo_gemm(p, l, smem))
DK(k_peer_q, phase_peer_q(p, l, smem))
DK(k_peer_e, phase_peer_experts(p, l, l == 1))
#endif

extern "C" void kernel_launch(void* const* d_in, const int* in_sizes, int n_in, void* d_out, int out_size, void* d_ws, size_t ws_size, hipStream_t stream) {
  static int grid_blocks = 0;
  if (!grid_blocks) {
    int dev = 0, cus = 0, per_cu = 2;
    (void)hipGetDevice(&dev);
    (void)hipDeviceGetAttribute(&cus, hipDeviceAttributeMultiprocessorCount, dev);
#if ONE_LAUNCH
    (void)hipOccupancyMaxActiveBlocksPerMultiprocessor(&per_cu, fwd, 256, 0);
#endif
    if (per_cu > 2) per_cu = 2;
    if (per_cu < 1) per_cu = 1;
    grid_blocks = cus * per_cu;
    grid_blocks -= grid_blocks % 8;
  }
  Params p{};
  const float* const* in = (const float* const*)d_in;
  p.x_prompt = in[0]; p.x_sample = in[1]; p.mem_prompt = in[2]; p.mem_sample = in[3];
  p.norm_mix_g = in[4]; p.w_in = in[5]; p.na_rpb = in[6]; p.conv_w = in[7]; p.swa_sink = in[8]; p.t5_bias = in[9];
  p.w_out = in[10]; p.norm_xa_g = in[11]; p.norm_mem_g = in[12]; p.w_xq = in[13]; p.w_xk = in[14]; p.w_xv = in[15]; p.w_xo = in[16];
  p.norm_ffn_g = in[17]; p.peer_wq = in[18]; p.peer_subkeys = in[19]; p.peer_u = in[20]; p.peer_v = in[21]; p.final_g = in[22];
  p.x = (float*)d_out;
  p.ws = (unsigned char*)d_ws;
  if (WS_NEED > ws_size) { fprintf(stderr, "workspace too small: need %zu have %zu\n", (size_t)WS_NEED, ws_size); return; }
#if ONE_LAUNCH
  void* args[] = {&p};
  hipError_t e = hipLaunchCooperativeKernel((void*)fwd, dim3(grid_blocks), dim3(256), args, 0, stream);
  if (e != hipSuccess) fprintf(stderr, "cooperative launch failed: %s (grid %d)\n", hipGetErrorString(e), grid_blocks);
#else
  const dim3 g(grid_blocks), b(256);
  k_prologue<<<g, b, 0, stream>>>(p, 0);
  for (int l = 0; l < 2; ++l) {
    k_in_gemm<<<g, b, 0, stream>>>(p, l);
    k_na<<<g, b, 0, stream>>>(p, l);
    k_swa<<<g, b, 0, stream>>>(p, l);
    k_conv<<<g, b, 0, stream>>>(p, l);
    k_out_gemm<<<g, b, 0, stream>>>(p, l);
    k_xq_gemm<<<g, b, 0, stream>>>(p, l);
    k_xattn<<<g, b, 0, stream>>>(p, l);
    k_xo_gemm<<<g, b, 0, stream>>>(p, l);
    k_peer_q<<<g, b, 0, stream>>>(p, l);
    k_peer_e<<<g, b, 0, stream>>>(p, l);
  }
#endif
}
```

```cpp
#include <hip/hip_runtime.h>
#include <hip/hip_cooperative_groups.h>
#include <cstdio>
#include <cstdint>
namespace cg = cooperative_groups;

#ifndef PROBE
#define PROBE 0
#endif
#ifndef ONE_LAUNCH
#define ONE_LAUNCH 1
#endif

#define DI __device__ __forceinline__
typedef unsigned short bf16_t;
typedef short bf16x8 __attribute__((ext_vector_type(8)));
typedef short s16x4 __attribute__((ext_vector_type(4)));
typedef float f32x16 __attribute__((ext_vector_type(16)));
typedef float f32x4 __attribute__((ext_vector_type(4)));
typedef float f32x2 __attribute__((ext_vector_type(2)));
typedef unsigned u32x4 __attribute__((ext_vector_type(4)));
typedef unsigned u32x2 __attribute__((ext_vector_type(2)));
typedef __bf16 bf2_t __attribute__((ext_vector_type(2)));

constexpr int T = 81920, DM = 1024, SEQ = 8192;
constexpr int IN_DIM = 2560;
constexpr float LOG2E = 1.4426950408889634f;
constexpr float RMS_EPS = 1e-6f;
constexpr int NPHASE = 17;

constexpr int Z_NAQ = 0, Z_NAK = 384, Z_NAV = 768, Z_SCB = 1152, Z_SCC = 1408, Z_SCH = 1664, Z_SWQ = 1920, Z_SWK = 2304, Z_SWV = 2432;

__device__ const unsigned char T5TAB[257] = {
15,15,15,15,15,15,15,15,15,15,15,15,15,15,15,15,15,15,15,15,15,15,15,15,15,15,15,15,15,15,15,15,15,15,15,15,15,15,14,14,14,14,14,14,14,14,14,14,14,14,14,14,14,14,14,14,14,14,14,14,14,14,14,14,14,13,13,13,13,13,13,13,13,13,13,13,13,13,13,13,13,13,13,12,12,12,12,12,12,12,12,12,12,12,12,12,12,11,11,11,11,11,11,11,11,11,10,10,10,10,10,10,10,9,9,9,9,8,8,8,8,7,6,5,4,3,2,1,0,17,18,19,20,21,22,23,24,24,24,24,25,25,25,25,26,26,26,26,26,26,26,27,27,27,27,27,27,27,27,27,28,28,28,28,28,28,28,28,28,28,28,28,28,28,29,29,29,29,29,29,29,29,29,29,29,29,29,29,29,29,29,29,30,30,30,30,30,30,30,30,30,30,30,30,30,30,30,30,30,30,30,30,30,30,30,30,30,30,30,31,31,31,31,31,31,31,31,31,31,31,31,31,31,31,31,31,31,31,31,31,31,31,31,31,31,31,31,31,31,31,31,31,31,31,31,31,31};
__device__ const unsigned char PAIRTAB[64] = {
0x00,0x01,0x02,0x03,0x04,0x05,0x06,0x07,0x08,0x09,0x0a,0x0b,0x0c,0x0d,0x0e,0x0f,
0x10,0x11,0x12,0x13,0x14,0x15,0x16,0x17,
0x20,0x21,0x22,0x23,0x24,
0x30,0x31,0x32,0x33,
0x40,0x41,0x42,
0x50,0x51,0x60,0x61,0x70,0x71,
0x80,0x90,0xa0,0xb0,0xc0,0xd0,0xe0,0xf0,
0,0,0,0,0,0,0,0,0,0,0,0,0,0};

struct Params {
  const float* x_prompt; const float* x_sample; const float* mem_prompt; const float* mem_sample;
  const float* norm_mix_g; const float* w_in; const float* na_rpb; const float* conv_w; const float* swa_sink; const float* t5_bias;
  const float* w_out; const float* norm_xa_g; const float* norm_mem_g; const float* w_xq; const float* w_xk; const float* w_xv; const float* w_xo;
  const float* norm_ffn_g; const float* peer_wq; const float* peer_subkeys; const float* peer_u; const float* peer_v; const float* final_g;
  float* x;
  unsigned char* ws;
};
constexpr size_t OFF_Z = 0;
constexpr size_t OFF_Q = 0;
constexpr size_t OFF_O = (size_t)T * 512 * 2;
constexpr size_t OFF_TOPS = (size_t)T * 1024 * 2;
constexpr size_t OFF_YMIX = OFF_Z + (size_t)T * IN_DIM * 2;
constexpr size_t OFF_WIN = OFF_YMIX + (size_t)T * DM * 2;
constexpr size_t OFF_WOUT = OFF_WIN + (size_t)2 * 2560 * 1024 * 2;
constexpr size_t OFF_WXQ = OFF_WOUT + (size_t)2 * 1024 * 1024 * 2;
constexpr size_t OFF_WXKV = OFF_WXQ + (size_t)2 * 512 * 1024 * 2;
constexpr size_t OFF_WXO = OFF_WXKV + (size_t)2 * 1024 * 1024 * 2;
constexpr size_t OFF_WPQ = OFF_WXO + (size_t)2 * 1024 * 512 * 2;
constexpr size_t OFF_SUBK = OFF_WPQ + (size_t)2 * 2048 * 1024 * 2;
constexpr size_t OFF_PU = OFF_SUBK + (size_t)2 * 8 * 2 * 128 * 128 * 2;
constexpr size_t OFF_PV = OFF_PU + (size_t)2 * 16384 * 1024 * 2;
constexpr size_t OFF_MEMKV = OFF_PV + (size_t)2 * 16384 * 1024 * 2;
constexpr size_t OFF_XB = OFF_MEMKV + (size_t)2 * 2560 * 1024 * 2;
constexpr size_t OFF_MEMB = OFF_XB + (size_t)T * DM * 2;
constexpr size_t WS_NEED = OFF_MEMB + (size_t)2560 * 1024 * 2;

DI unsigned pk2(float a, float b) { f32x2 v = {a, b}; return __builtin_bit_cast(unsigned, __builtin_convertvector(v, bf2_t)); }
DI bf16_t bf1(float a) { return (bf16_t)(pk2(a, 0.f) & 0xffffu); }
DI float bf_lo(unsigned u) { return __uint_as_float(u << 16); }
DI float bf_hi(unsigned u) { return __uint_as_float(u & 0xffff0000u); }
#define MFMA32(a, b, c) __builtin_amdgcn_mfma_f32_32x32x16_bf16((a), (b), (c), 0, 0, 0)
DI int crow(int i, int h) { return (i & 3) + 8 * (i >> 2) + 4 * h; }
DI int tid() { int t = threadIdx.x & 255; asm volatile("" : "+v"(t)); return t; }
DI int tid512() { int t = threadIdx.x; asm volatile("" : "+v"(t)); return t; }
#define VHALF (__builtin_amdgcn_readfirstlane((int)(threadIdx.x >> 8)))
#define VB ((int)(blockIdx.x * 2) + VHALF)
#define NVB ((int)(gridDim.x * 2))
template <int CTRL> DI float dpp(float v) { return __int_as_float(__builtin_amdgcn_update_dpp(0, __float_as_int(v), CTRL, 0xf, 0xf, true)); }
DI float xor16(float v) { return __int_as_float(__builtin_amdgcn_ds_swizzle(__float_as_int(v), 0x401F)); }
DI float xor32(float v, int lane) { return __int_as_float(__builtin_amdgcn_ds_bpermute((lane ^ 32) << 2, __float_as_int(v))); }
DI float row_sum(float v) { v += dpp<0xB1>(v); v += dpp<0x4E>(v); v += dpp<0x141>(v); v += dpp<0x140>(v); return v; }
DI float wave_sum(float v, int lane) { v = row_sum(v); v += xor16(v); v += xor32(v, lane); return v; }
DI float rdlane_f(float v, int l) { return __int_as_float(__builtin_amdgcn_readlane(__float_as_int(v), l)); }

constexpr int LDT = 72;
constexpr int VSMEM = 74240;
constexpr int GBUF = 512 * LDT * 2;
constexpr int SMEM_RSTD = 2 * GBUF;
constexpr int SMEM_BYTES = 2 * VSMEM;
static_assert(SMEM_RSTD + 1024 <= SMEM_BYTES, "LDS map");

template <bool SUMSQ>
DI void gemm_tile(const bf16_t* __restrict__ Ap, int lda, const bf16_t* __restrict__ Bp, int K, unsigned char* smem, f32x16 (&acc)[4][2]) {
  float* rs = (float*)(smem + SMEM_RSTD);
  const int t = tid512(), lane = t & 63, wid = t >> 6, wm = wid >> 2, wn = wid & 3, r = lane & 31, h = lane >> 5;
#pragma unroll
  for (int a = 0; a < 4; ++a)
#pragma unroll
    for (int b = 0; b < 2; ++b)
#pragma unroll
      for (int i = 0; i < 16; ++i) acc[a][b][i] = 0.f;
  u32x4 ar[4], br[4]; float ss[4];
#pragma unroll
  for (int i = 0; i < 4; ++i) ss[i] = 0.f;
  const int nk = K >> 6;
  const unsigned voA = (unsigned)(((t >> 3) * lda + (t & 7) * 8) * 2), voB = (unsigned)(((t >> 3) * K + (t & 7) * 8) * 2);
  const char* Ac = (const char*)Ap; const char* Bc = (const char*)Bp;
  const int stoff = ((t >> 3) * LDT + (t & 7) * 8) * 2;
#define GEMM_LDG(kt) { \
    _Pragma("unroll") for (int i = 0; i < 4; ++i) ar[i] = *(const u32x4*)(Ac + ((size_t)(64 * i) * lda + (kt) * 64) * 2 + voA); \
    _Pragma("unroll") for (int i = 0; i < 4; ++i) br[i] = *(const u32x4*)(Bc + ((size_t)(64 * i) * K + (kt) * 64) * 2 + voB); }
#define GEMM_STS(buf) { unsigned char* sa_ = smem + (buf) * GBUF + stoff; \
    _Pragma("unroll") for (int i = 0; i < 4; ++i) { *(u32x4*)(sa_ + 64 * i * LDT * 2) = ar[i]; \
      if constexpr (SUMSQ) { _Pragma("unroll") for (int e = 0; e < 4; ++e) { const float lo = bf_lo(ar[i][e]), hi = bf_hi(ar[i][e]); ss[i] += lo * lo + hi * hi; } } } \
    _Pragma("unroll") for (int i = 0; i < 4; ++i) *(u32x4*)(sa_ + 256 * LDT * 2 + 64 * i * LDT * 2) = br[i]; }
  GEMM_LDG(0);
  __syncthreads();
  GEMM_STS(0);
  __syncthreads();
#pragma unroll 1
  for (int kt = 0; kt < nk; ++kt) {
    const int cur = kt & 1;
    if (kt + 1 < nk) GEMM_LDG(kt + 1);
    const bf16_t* a = (const bf16_t*)(smem + cur * GBUF) + (128 * wm + r) * LDT + 8 * h;
    const bf16_t* b = (const bf16_t*)(smem + cur * GBUF) + 256 * LDT + (64 * wn + r) * LDT + 8 * h;
#pragma unroll
    for (int ks = 0; ks < 4; ++ks) {
      const bf16x8 b0 = *(const bf16x8*)(b + 16 * ks), b1 = *(const bf16x8*)(b + 32 * LDT + 16 * ks);
#pragma unroll
      for (int mi = 0; mi < 4; ++mi) {
        const bf16x8 av = *(const bf16x8*)(a + 32 * mi * LDT + 16 * ks);
        acc[mi][0] = MFMA32(av, b0, acc[mi][0]); acc[mi][1] = MFMA32(av, b1, acc[mi][1]);
      }
    }
    if (kt + 1 < nk) GEMM_STS(cur ^ 1);
    __syncthreads();
  }
#undef GEMM_LDG
#undef GEMM_STS
  if constexpr (SUMSQ) {
#pragma unroll
    for (int i = 0; i < 4; ++i) {
      float s = ss[i];
      s += dpp<0xB1>(s); s += dpp<0x4E>(s); s += dpp<0x141>(s);
      if ((t & 7) == 0) rs[(t >> 3) + 64 * i] = rsqrtf(s * (1.0f / 1024.0f) + RMS_EPS);
    }
    __syncthreads();
  }
}

template <int LDC>
DI void epi_bf16_scaled(const f32x16 (&acc)[4][2], unsigned char* smem, bf16_t* C) {
  const float* rs = (const float*)(smem + SMEM_RSTD);
  const int t = tid512(), lane = t & 63, wid = t >> 6, wm = wid >> 2, wn = wid & 3, r = lane & 31, h = lane >> 5;
  bf16_t* ct = (bf16_t*)smem + (128 * wm + 4 * h) * 264 + 64 * wn + r;
  const float* rsw = rs + 128 * wm + 4 * h;
#pragma unroll
  for (int mi = 0; mi < 4; ++mi)
#pragma unroll
    for (int i = 0; i < 16; ++i) {
      const int rowc = 32 * mi + (i & 3) + 8 * (i >> 2);
      const float sc = rsw[rowc];
#pragma unroll
      for (int ni = 0; ni < 2; ++ni) ct[rowc * 264 + 32 * ni] = bf1(acc[mi][ni][i] * sc);
    }
  __syncthreads();
  const bf16_t* cs = (const bf16_t*)smem + (t >> 5) * 264 + 8 * (t & 31);
  char* cg_ = (char*)C; const unsigned vo = (unsigned)(((t >> 5) * LDC + 8 * (t & 31)) * 2);
#pragma unroll
  for (int j = 0; j < 16; ++j) *(u32x4*)(cg_ + (size_t)(16 * j) * LDC * 2 + vo) = *(const u32x4*)(cs + 16 * j * 264);
}
DI void epi_resid(const f32x16 (&acc)[4][2], unsigned char* smem, float* X, bf16_t* XB) {
  const int t = tid512(), lane = t & 63, wid = t >> 6, wm = wid >> 2, wn = wid & 3, r = lane & 31, h = lane >> 5;
  float* ct = (float*)smem + (128 * wm + 4 * h) * 132 + 64 * (wn & 1) + r;
  const float* cs = (const float*)smem + (t >> 5) * 132 + 4 * (t & 31);
  const unsigned vo = (unsigned)((t >> 5) * DM + 4 * (t & 31));
#pragma unroll 1
  for (int hf = 0; hf < 2; ++hf) {
    if (hf) __syncthreads();
    if ((wn >> 1) == hf) {
#pragma unroll
      for (int mi = 0; mi < 4; ++mi)
#pragma unroll
        for (int i = 0; i < 16; ++i) {
          const int rowc = 32 * mi + (i & 3) + 8 * (i >> 2);
#pragma unroll
          for (int ni = 0; ni < 2; ++ni) ct[rowc * 132 + 32 * ni] = acc[mi][ni][i];
        }
    }
    __syncthreads();
    char* xg = (char*)(X + 128 * hf); char* bg = (char*)(XB + 128 * hf);
#pragma unroll
    for (int j = 0; j < 16; ++j) {
      f32x4* px = (f32x4*)(xg + ((size_t)(16 * j) * DM + vo) * 4);
      const f32x4 v = *px + *(const f32x4*)(cs + 16 * j * 132);
      *px = v;
      u32x2 pk = {pk2(v.x, v.y), pk2(v.z, v.w)};
      *(u32x2*)(bg + ((size_t)(16 * j) * DM + vo) * 2) = pk;
    }
  }
}

template <int D, class F>
DI void attn_tile(const bf16_t* Ks, const bf16_t* Vt, const bf16x8 (&qf)[D / 16], f32x16 (&o)[D / 32], float& m, float& l, F fn, int r, int h, int lane) {
  f32x16 s;
#pragma unroll
  for (int i = 0; i < 16; ++i) s[i] = 0.f;
#pragma unroll
  for (int ks = 0; ks < D / 16; ++ks) { const bf16x8 a = *(const bf16x8*)(Ks + r * (D + 8) + 16 * ks + 8 * h); s = MFMA32(a, qf[ks], s); }
  float mx = -INFINITY;
#pragma unroll
  for (int i = 0; i < 16; ++i) { s[i] = fn(s[i], i); mx = fmaxf(mx, s[i]); }
  mx = fmaxf(mx, xor32(mx, lane));
  const float mn = fmaxf(m, mx);
  const float alpha = __builtin_amdgcn_exp2f(m - mn);
  m = mn;
  float sum = 0.f;
#pragma unroll
  for (int i = 0; i < 16; ++i) { s[i] = __builtin_amdgcn_exp2f(s[i] - mn); sum += s[i]; }
  l = l * alpha + sum;
#pragma unroll
  for (int dt = 0; dt < D / 32; ++dt)
#pragma unroll
    for (int i = 0; i < 16; ++i) o[dt][i] *= alpha;
  bf16x8 pf[2];
#pragma unroll
  for (int s2 = 0; s2 < 2; ++s2) {
    u32x4 pk = {pk2(s[8 * s2], s[8 * s2 + 1]), pk2(s[8 * s2 + 2], s[8 * s2 + 3]), pk2(s[8 * s2 + 4], s[8 * s2 + 5]), pk2(s[8 * s2 + 6], s[8 * s2 + 7])};
    pf[s2] = __builtin_bit_cast(bf16x8, pk);
  }
#pragma unroll
  for (int dt = 0; dt < D / 32; ++dt)
#pragma unroll
    for (int s2 = 0; s2 < 2; ++s2) {
      const bf16_t* vp = Vt + (32 * dt + r) * 40 + 16 * s2 + 4 * h;
      const s16x4 lo = *(const s16x4*)vp, hi = *(const s16x4*)(vp + 8);
      const bf16x8 a = __builtin_shufflevector(lo, hi, 0, 1, 2, 3, 4, 5, 6, 7);
      o[dt] = MFMA32(a, pf[s2], o[dt]);
    }
}
DI void vt_store(bf16_t* Vt, u32x4 v, int c8, int kk) {
#pragma unroll
  for (int e = 0; e < 8; ++e) Vt[(8 * c8 + e) * 40 + kk] = (bf16_t)((v[e >> 1] >> (16 * (e & 1))) & 0xffffu);
}
template <int ND>
DI void attn_out(const f32x16 (&o)[ND], float l, bf16_t* yp, int h, int lane) {
  const float lt = l + xor32(l, lane);
  const float inv = 1.0f / lt;
#pragma unroll
  for (int dt = 0; dt < ND; ++dt)
#pragma unroll
    for (int g = 0; g < 4; ++g) {
      u32x2 v = {pk2(o[dt][4 * g] * inv, o[dt][4 * g + 1] * inv), pk2(o[dt][4 * g + 2] * inv, o[dt][4 * g + 3] * inv)};
      *(u32x2*)(yp + 32 * dt + 8 * g + 4 * h) = v;
    }
}

constexpr int AT64_BUF = 32 * 72 + 64 * 40;
DI void swa_item(const Params& p, int l, int item, unsigned char* smem) {
  const int t = tid(), lane = t & 63, w = t >> 6, r = lane & 31, h = lane >> 5;
  const int head = item % 6, n = (item / 6) & 63, b = item / 384, hkv = head / 3;
  bf16_t* st = (bf16_t*)smem;
  float* bt = (float*)(smem + 2 * AT64_BUF * 2);
  __syncthreads();
  for (int i = t; i < 257; i += 256) bt[i] = p.t5_bias[T5TAB[i] * 6 + head] * LOG2E;
  const size_t tok0 = (size_t)b * SEQ;
  const int q0 = n * 128 + 32 * w;
  bf16x8 qf[4];
  { const bf16_t* qp = ((bf16_t*)(p.ws + OFF_Z)) + (tok0 + q0 + r) * IN_DIM + Z_SWQ + head * 64 + 8 * h;
#pragma unroll
    for (int ks = 0; ks < 4; ++ks) qf[ks] = *(const bf16x8*)(qp + 16 * ks); }
  f32x16 o[2];
#pragma unroll
  for (int dt = 0; dt < 2; ++dt)
#pragma unroll
    for (int i = 0; i < 16; ++i) o[dt][i] = 0.f;
  float m = p.swa_sink[l * 6 + head] * LOG2E, lsum = (h == 0) ? 1.f : 0.f;
  const int kt_lo = (n == 0) ? 4 : 0, kt_hi = (n == 63) ? 8 : 12;
  const int kk = t >> 3, c8 = t & 7;
  const bf16_t* kbase = ((bf16_t*)(p.ws + OFF_Z)) + (tok0 + (size_t)(n * 128 + kk)) * IN_DIM + Z_SWK + hkv * 64 + 8 * c8;
  u32x4 kr = {0, 0, 0, 0}, vr = {0, 0, 0, 0};
  if (kt_lo == 0) { const bf16_t* kp = kbase + (ptrdiff_t)(-128) * IN_DIM; kr = *(const u32x4*)kp; vr = *(const u32x4*)(kp + 128);
    *(u32x4*)(st + kk * 72 + 8 * c8) = kr; vt_store(st + 32 * 72, vr, c8, kk); }
  __syncthreads();
  const float sc2 = 0.125f * LOG2E;
  for (int kt = 0; kt < 12; ++kt) {
    const int cur = kt & 1;
    const bool nxt = (kt + 1 >= kt_lo) && (kt + 1 < kt_hi);
    if (nxt) { const bf16_t* kp = kbase + (ptrdiff_t)(32 * (kt + 1) - 128) * IN_DIM; kr = *(const u32x4*)kp; vr = *(const u32x4*)(kp + 128); }
    if (kt >= kt_lo && kt < kt_hi && kt >= w && kt <= w + 8) {
      const int kb = 32 * kt - 128 - 32 * w - r + 4 * h;
      attn_tile<64>(st + cur * AT64_BUF, st + cur * AT64_BUF + 32 * 72, qf, o, m, lsum,
        [&](float sv, int i) { const int oi = kb + (i & 3) + 8 * (i >> 2) + 128; const bool ok = (unsigned)oi <= 256u; const float bias = bt[ok ? oi : 0]; return ok ? sv * sc2 + bias : -INFINITY; }, r, h, lane);
    }
    if (nxt) { bf16_t* sb = st + (cur ^ 1) * AT64_BUF; *(u32x4*)(sb + kk * 72 + 8 * c8) = kr; vt_store(sb + 32 * 72, vr, c8, kk); }
    __syncthreads();
  }
  attn_out<2>(o, lsum, ((bf16_t*)(p.ws + OFF_YMIX)) + (tok0 + q0 + r) * DM + 640 + head * 64, h, lane);
}

DI void na_item(const Params& p, int l, int item, unsigned char* smem) {
  const int t = tid(), lane = t & 63, w = t >> 6, r = lane & 31, h = lane >> 5;
  const int hp = item % 3, rr = (item / 3) & 127, b = item / 384;
  const int hh = w >> 1, qh = w & 1, head = 2 * hp + hh;
  bf16_t* st = (bf16_t*)smem;
  constexpr int NBUF = 2 * AT64_BUF;
  float* bt = (float*)(smem + 2 * NBUF * 2);
  __syncthreads();
  for (int i = t; i < 930; i += 256) { const int e = i % 465, hsel = i / 465; bt[i] = p.na_rpb[((size_t)l * 465 + e) * 6 + 2 * hp + hsel] * LOG2E; }
  const size_t tok0 = (size_t)b * SEQ;
  const int r0 = min(max(rr - 4, 0), 120);
  const int c = 32 * qh + r;
  bf16x8 qf[4];
  { const bf16_t* qp = ((bf16_t*)(p.ws + OFF_Z)) + (tok0 + rr * 64 + c) * IN_DIM + Z_NAQ + head * 64 + 8 * h;
#pragma unroll
    for (int ks = 0; ks < 4; ++ks) qf[ks] = *(const bf16x8*)(qp + 16 * ks); }
  f32x16 o[2];
#pragma unroll
  for (int dt = 0; dt < 2; ++dt)
#pragma unroll
    for (int i = 0; i < 16; ++i) o[dt][i] = 0.f;
  float m = -1e30f, lsum = 0.f;
  const int kk = t >> 3, c8 = t & 7;
  const bf16_t* kbase = ((bf16_t*)(p.ws + OFF_Z)) + (tok0 + (size_t)((r0 + (kk >> 4)) * 64 + (kk & 15))) * IN_DIM + Z_NAK + (2 * hp) * 64 + 8 * c8;
  u32x4 k0r, k1r, v0r, v1r;
#define NA_LDG(kt) { const bf16_t* kp = kbase + (size_t)(((kt) >> 2) * 128 + ((kt) & 3) * 16) * IN_DIM; \
    k0r = *(const u32x4*)kp; k1r = *(const u32x4*)(kp + 64); v0r = *(const u32x4*)(kp + 384); v1r = *(const u32x4*)(kp + 448); }
#define NA_STS(buf) { bf16_t* sb = st + (buf) * NBUF; *(u32x4*)(sb + kk * 72 + 8 * c8) = k0r; *(u32x4*)(sb + AT64_BUF + kk * 72 + 8 * c8) = k1r; \
    vt_store(sb + 32 * 72, v0r, c8, kk); vt_store(sb + AT64_BUF + 32 * 72, v1r, c8, kk); }
  NA_LDG(0);
  NA_STS(0);
  __syncthreads();
  const float sc2 = 0.125f * LOG2E;
  const int c0 = min(max(c - 8, 0), 48);
  const float* bth = bt + hh * 465;
  for (int kt = 0; kt < 16; ++kt) {
    const int cur = kt & 1;
    if (kt + 1 < 16) NA_LDG(kt + 1);
    const int rp = kt >> 2, cb = kt & 3;
    if (cb >= qh && cb <= qh + 2) {
      const bf16_t* sb = st + cur * NBUF + hh * AT64_BUF;
      const int drb = r0 + 2 * rp - rr + 7;
      const int kcb = 16 * cb;
      attn_tile<64>(sb, sb + 32 * 72, qf, o, m, lsum,
        [&](float sv, int i) { const int kq = (i & 3) + 8 * (i >> 2) + 4 * h; const int kcol = kcb + (kq & 15); const int dr = drb + (kq >> 4);
          const bool ok = (kcol >= c0) && (kcol < c0 + 16); const int bi = dr * 31 + (kcol - c + 15); const float bias = bth[ok ? bi : 0];
          return ok ? sv * sc2 + bias : -INFINITY; }, r, h, lane);
    }
    if (kt + 1 < 16) NA_STS(cur ^ 1);
    __syncthreads();
  }
#undef NA_LDG
#undef NA_STS
  attn_out<2>(o, lsum, ((bf16_t*)(p.ws + OFF_YMIX)) + (tok0 + rr * 64 + c) * DM + head * 64, h, lane);
}

DI void conv_item(const Params& p, int l, int item) {
  const int t = tid();
  const size_t tok = (size_t)item * 8 + (t >> 5);
  const int c8 = t & 31, pos = (int)(tok & (SEQ - 1));
  const bf16_t* zr = ((bf16_t*)(p.ws + OFF_Z)) + tok * IN_DIM + 8 * c8;
  const u32x4 bv = *(const u32x4*)(zr + Z_SCB);
  const u32x4 cc = *(const u32x4*)(zr + Z_SCC), hc = *(const u32x4*)(zr + Z_SCH);
  u32x4 cm = {0, 0, 0, 0}, hm = {0, 0, 0, 0}, cp = {0, 0, 0, 0}, hpv = {0, 0, 0, 0};
  if (pos > 0) { cm = *(const u32x4*)(zr - IN_DIM + Z_SCC); hm = *(const u32x4*)(zr - IN_DIM + Z_SCH); }
  if (pos < SEQ - 1) { cp = *(const u32x4*)(zr + IN_DIM + Z_SCC); hpv = *(const u32x4*)(zr + IN_DIM + Z_SCH); }
  const float* cw = p.conv_w + (size_t)l * 3 * 256 + 8 * c8;
  float y[8];
#pragma unroll
  for (int e = 0; e < 8; ++e) {
    const int wd = e >> 1;
    const float fb = (e & 1) ? bf_hi(bv[wd]) : bf_lo(bv[wd]);
    const float um = ((e & 1) ? bf_hi(cm[wd]) : bf_lo(cm[wd])) * ((e & 1) ? bf_hi(hm[wd]) : bf_lo(hm[wd]));
    const float uc = ((e & 1) ? bf_hi(cc[wd]) : bf_lo(cc[wd])) * ((e & 1) ? bf_hi(hc[wd]) : bf_lo(hc[wd]));
    const float up = ((e & 1) ? bf_hi(cp[wd]) : bf_lo(cp[wd])) * ((e & 1) ? bf_hi(hpv[wd]) : bf_lo(hpv[wd]));
    y[e] = fb * (um * cw[e] + uc * cw[256 + e] + up * cw[512 + e]);
  }
  u32x4 ov = {pk2(y[0], y[1]), pk2(y[2], y[3]), pk2(y[4], y[5]), pk2(y[6], y[7])};
  *(u32x4*)(((bf16_t*)(p.ws + OFF_YMIX)) + tok * DM + 384 + 8 * c8) = ov;
}

constexpr int AT128_BUF = 32 * 136 + 128 * 40;
DI void xattn_item(const Params& p, int l, int item, unsigned char* smem) {
  const int t = tid(), lane = t & 63, w = t >> 6, r = lane & 31, h = lane >> 5;
  const int qt = item & 63, head = (item >> 6) & 3, b = item >> 8;
  bf16_t* st = (bf16_t*)smem;
  const size_t tok = (size_t)b * SEQ + qt * 128 + 32 * w + r;
  bf16x8 qf[8];
  { const bf16_t* qp = ((bf16_t*)(p.ws + OFF_Q)) + tok * 512 + head * 128 + 8 * h;
#pragma unroll
    for (int ks = 0; ks < 8; ++ks) qf[ks] = *(const bf16x8*)(qp + 16 * ks); }
  f32x16 o[4];
#pragma unroll
  for (int dt = 0; dt < 4; ++dt)
#pragma unroll
    for (int i = 0; i < 16; ++i) o[dt][i] = 0.f;
  float m = -1e30f, lsum = 0.f;
  const int kk = t >> 4, c8 = t & 15;
  const bf16_t* kbase = ((bf16_t*)(p.ws + OFF_MEMKV)) + ((size_t)l * 2560 + (size_t)b * 256 + kk) * 1024 + head * 128 + 8 * c8;
  u32x4 k0r, k1r, v0r, v1r;
#define XA_LDG(kt) { const bf16_t* kp = kbase + (size_t)(32 * (kt)) * 1024; \
    k0r = *(const u32x4*)kp; k1r = *(const u32x4*)(kp + 16 * 1024); v0r = *(const u32x4*)(kp + 512); v1r = *(const u32x4*)(kp + 16 * 1024 + 512); }
#define XA_STS(buf) { bf16_t* sb = st + (buf) * AT128_BUF; *(u32x4*)(sb + kk * 136 + 8 * c8) = k0r; *(u32x4*)(sb + (kk + 16) * 136 + 8 * c8) = k1r; \
    vt_store(sb + 32 * 136, v0r, c8, kk); vt_store(sb + 32 * 136, v1r, c8, kk + 16); }
  __syncthreads();
  XA_LDG(0);
  XA_STS(0);
  __syncthreads();
  const float sc2 = 0.08838834764831845f * LOG2E;
  for (int kt = 0; kt < 8; ++kt) {
    const int cur = kt & 1;
    if (kt + 1 < 8) XA_LDG(kt + 1);
    { const bf16_t* sb = st + cur * AT128_BUF;
      attn_tile<128>(sb, sb + 32 * 136, qf, o, m, lsum, [&](float sv, int) { return sv * sc2; }, r, h, lane); }
    if (kt + 1 < 8) XA_STS(cur ^ 1);
    __syncthreads();
  }
#undef XA_LDG
#undef XA_STS
  attn_out<4>(o, lsum, ((bf16_t*)(p.ws + OFF_O)) + tok * 512 + head * 128, h, lane);
}

DI void transpose_job(const float* __restrict__ src, int K, int N, const float* __restrict__ g, bf16_t* __restrict__ dst, unsigned char* smem) {
  float* tl = (float*)smem;
  const int tn = N / 64, ntile = (K / 64) * tn, t = tid();
  for (int tile = VB; tile < ntile; tile += NVB) {
    const int k0 = (tile / tn) * 64, n0 = (tile % tn) * 64;
    __syncthreads();
#pragma unroll 4
    for (int i = 0; i < 16; ++i) { const int kk = (t >> 6) + 4 * i; float v = src[(size_t)(k0 + kk) * N + n0 + (t & 63)]; if (g) v *= g[k0 + kk]; tl[kk * 65 + (t & 63)] = v; }
    __syncthreads();
#pragma unroll 4
    for (int i = 0; i < 16; ++i) { const int nn = (t >> 6) + 4 * i; dst[(size_t)(n0 + nn) * K + k0 + (t & 63)] = bf1(tl[(t & 63) * 65 + nn]); }
  }
}
DI void convert_job(const float* __restrict__ src, bf16_t* __restrict__ dst, size_t n4) {
  for (size_t i = (size_t)VB * 256 + tid(); i < n4; i += (size_t)NVB * 256) {
    const f32x4 v = ((const f32x4*)src)[i];
    u32x2 o = {pk2(v.x, v.y), pk2(v.z, v.w)};
    ((u32x2*)dst)[i] = o;
  }
}

constexpr float F8_SCALE = 64.0f, F8_INV = 1.0f / 64.0f;
DI unsigned pk4_fp8(f32x4 v) {
  int w = 0;
  w = __builtin_amdgcn_cvt_pk_fp8_f32(v.x * F8_SCALE, v.y * F8_SCALE, w, false);
  w = __builtin_amdgcn_cvt_pk_fp8_f32(v.z * F8_SCALE, v.w * F8_SCALE, w, true);
  return (unsigned)w;
}
DI void convert_fp8_job(const float* __restrict__ src, unsigned char* __restrict__ dst, size_t n16) {
  for (size_t i = (size_t)VB * 256 + tid(); i < n16; i += (size_t)NVB * 256) {
    const f32x4* s = (const f32x4*)src + 4 * i;
    u32x4 o = {pk4_fp8(s[0]), pk4_fp8(s[1]), pk4_fp8(s[2]), pk4_fp8(s[3])};
    ((u32x4*)dst)[i] = o;
  }
}

DI void phase_prologue(const Params& p, unsigned char* smem) {
  { const size_t n4p = (size_t)16384 * 256, n4 = (size_t)T * 256;
    for (size_t i = (size_t)VB * 256 + tid(); i < n4; i += (size_t)NVB * 256)
    { const f32x4 v = (i < n4p) ? ((const f32x4*)p.x_prompt)[i] : ((const f32x4*)p.x_sample)[i - n4p];
      ((f32x4*)p.x)[i] = v; u32x2 pk = {pk2(v.x, v.y), pk2(v.z, v.w)}; ((u32x2*)(p.ws + OFF_XB))[i] = pk; } }
  convert_job(p.mem_prompt, (bf16_t*)(p.ws + OFF_MEMB), (size_t)512 * 1024 / 4);
  convert_job(p.mem_sample, (bf16_t*)(p.ws + OFF_MEMB) + (size_t)512 * 1024, (size_t)2048 * 1024 / 4);
  for (int l = 0; l < 2; ++l) {
    transpose_job(p.w_in + (size_t)l * 1024 * 2560, 1024, 2560, p.norm_mix_g + l * 1024, ((bf16_t*)(p.ws + OFF_WIN)) + (size_t)l * 2560 * 1024, smem);
    transpose_job(p.w_out + (size_t)l * 1024 * 1024, 1024, 1024, nullptr, ((bf16_t*)(p.ws + OFF_WOUT)) + (size_t)l * 1024 * 1024, smem);
    transpose_job(p.w_xq + (size_t)l * 1024 * 512, 1024, 512, p.norm_xa_g + l * 1024, ((bf16_t*)(p.ws + OFF_WXQ)) + (size_t)l * 512 * 1024, smem);
    transpose_job(p.w_xk + (size_t)l * 1024 * 512, 1024, 512, p.norm_mem_g + l * 1024, ((bf16_t*)(p.ws + OFF_WXKV)) + (size_t)l * 1024 * 1024, smem);
    transpose_job(p.w_xv + (size_t)l * 1024 * 512, 1024, 512, p.norm_mem_g + l * 1024, ((bf16_t*)(p.ws + OFF_WXKV)) + (size_t)l * 1024 * 1024 + (size_t)512 * 1024, smem);
    transpose_job(p.w_xo + (size_t)l * 512 * 1024, 512, 1024, nullptr, ((bf16_t*)(p.ws + OFF_WXO)) + (size_t)l * 1024 * 512, smem);
    transpose_job(p.peer_wq + (size_t)l * 1024 * 2048, 1024, 2048, p.norm_ffn_g + l * 1024, ((bf16_t*)(p.ws + OFF_WPQ)) + (size_t)l * 2048 * 1024, smem);
  }
  convert_job(p.peer_subkeys, ((bf16_t*)(p.ws + OFF_SUBK)), (size_t)2 * 8 * 2 * 128 * 128 / 4);
  convert_fp8_job(p.peer_u, (unsigned char*)(p.ws + OFF_PU), (size_t)2 * 16384 * 1024 / 16);
  convert_fp8_job(p.peer_v, (unsigned char*)(p.ws + OFF_PV), (size_t)2 * 16384 * 1024 / 16);
}

#define TILE_WALK(NT, MT8) const int nx_ = gridDim.x >> 3, xcd_ = blockIdx.x & 7; \
  for (int j_ = blockIdx.x >> 3; j_ < (MT8) * (NT); j_ += nx_) { const int mt = (j_ / (NT)) * 8 + xcd_, nt = j_ % (NT);

DI void phase_in_gemm(const Params& p, int l, unsigned char* smem) {
  f32x16 acc[4][2];
  { TILE_WALK(10, 40)
    gemm_tile<true>(((bf16_t*)(p.ws + OFF_XB)) + (size_t)mt * 256 * DM, DM, ((bf16_t*)(p.ws + OFF_WIN)) + ((size_t)l * 2560 + nt * 256) * 1024, 1024, smem, acc);
    epi_bf16_scaled<IN_DIM>(acc, smem, ((bf16_t*)(p.ws + OFF_Z)) + (size_t)mt * 256 * IN_DIM + nt * 256);
  } }
  if (l == 0) {
    for (int j = blockIdx.x; j < 10 * 4 * 2; j += gridDim.x) {
      const int ll = j / 40, mt = (j % 40) >> 2, nt = j & 3;
      gemm_tile<true>(((bf16_t*)(p.ws + OFF_MEMB)) + (size_t)mt * 256 * DM, DM, ((bf16_t*)(p.ws + OFF_WXKV)) + ((size_t)ll * 1024 + nt * 256) * 1024, 1024, smem, acc);
      epi_bf16_scaled<1024>(acc, smem, ((bf16_t*)(p.ws + OFF_MEMKV)) + ((size_t)ll * 2560 + mt * 256) * 1024 + nt * 256);
    }
  }
}
DI void phase_out_gemm(const Params& p, int l, unsigned char* smem) {
  f32x16 acc[4][2];
  TILE_WALK(4, 40)
    gemm_tile<false>(((bf16_t*)(p.ws + OFF_YMIX)) + (size_t)mt * 256 * DM, DM, ((bf16_t*)(p.ws + OFF_WOUT)) + ((size_t)l * 1024 + nt * 256) * 1024, 1024, smem, acc);
    epi_resid(acc, smem, p.x + (size_t)mt * 256 * DM + nt * 256, ((bf16_t*)(p.ws + OFF_XB)) + (size_t)mt * 256 * DM + nt * 256);
  }
}
DI void phase_xq_gemm(const Params& p, int l, unsigned char* smem) {
  f32x16 acc[4][2];
  TILE_WALK(2, 40)
    gemm_tile<true>(((bf16_t*)(p.ws + OFF_XB)) + (size_t)mt * 256 * DM, DM, ((bf16_t*)(p.ws + OFF_WXQ)) + ((size_t)l * 512 + nt * 256) * 1024, 1024, smem, acc);
    epi_bf16_scaled<512>(acc, smem, ((bf16_t*)(p.ws + OFF_Q)) + (size_t)mt * 256 * 512 + nt * 256);
  }
}
DI void phase_xo_gemm(const Params& p, int l, unsigned char* smem) {
  f32x16 acc[4][2];
  TILE_WALK(4, 40)
    gemm_tile<false>(((bf16_t*)(p.ws + OFF_O)) + (size_t)mt * 256 * 512, 512, ((bf16_t*)(p.ws + OFF_WXO)) + ((size_t)l * 1024 + nt * 256) * 512, 512, smem, acc);
    epi_resid(acc, smem, p.x + (size_t)mt * 256 * DM + nt * 256, ((bf16_t*)(p.ws + OFF_XB)) + (size_t)mt * 256 * DM + nt * 256);
  }
}
DI void phase_peer_q(const Params& p, int l, unsigned char* smem) {
  f32x16 acc[4][2];
  const float* rs = (const float*)(smem + SMEM_RSTD);
  bf16_t* Qs = (bf16_t*)smem;
  TILE_WALK(8, 40)
    gemm_tile<true>(((bf16_t*)(p.ws + OFF_XB)) + (size_t)mt * 256 * DM, DM, ((bf16_t*)(p.ws + OFF_WPQ)) + ((size_t)l * 2048 + nt * 256) * 1024, 1024, smem, acc);
    const int t = tid512(), lane = t & 63, wid = t >> 6, wm = wid >> 2, wn = wid & 3, r = lane & 31, h = lane >> 5;
    {
      bf16_t* qw = Qs + (128 * wm + 4 * h) * 264 + 64 * wn + r;
      const float* rsw = rs + 128 * wm + 4 * h;
#pragma unroll
      for (int mi = 0; mi < 4; ++mi)
#pragma unroll
        for (int i = 0; i < 16; ++i) {
          const int rowc = 32 * mi + (i & 3) + 8 * (i >> 2);
          const float sc = rsw[rowc];
#pragma unroll
          for (int ni = 0; ni < 2; ++ni) qw[rowc * 264 + 32 * ni] = bf1(acc[mi][ni][i] * sc);
        }
    }
    __syncthreads();
#pragma unroll 1
    for (int pp = 0; pp < 2; ++pp) {
      const bf16_t* sk = ((bf16_t*)(p.ws + OFF_SUBK)) + ((size_t)(l * 16 + nt * 2 + pp) * 128) * 128 + r * 128 + 8 * h;
      f32x16 sc[4];
#pragma unroll
      for (int n4 = 0; n4 < 4; ++n4)
#pragma unroll
        for (int i = 0; i < 16; ++i) sc[n4][i] = 0.f;
#pragma unroll 2
      for (int ks = 0; ks < 8; ++ks) {
        const bf16x8 bq = *(const bf16x8*)(Qs + (32 * wid + r) * 264 + 128 * pp + 16 * ks + 8 * h);
#pragma unroll
        for (int n4 = 0; n4 < 4; ++n4) { const bf16x8 a = *(const bf16x8*)(sk + (32 * n4) * 128 + 16 * ks); sc[n4] = MFMA32(a, bq, sc[n4]); }
      }
#pragma unroll
      for (int n4 = 0; n4 < 4; ++n4)
#pragma unroll
        for (int i = 0; i < 16; ++i) sc[n4][i] = __uint_as_float((__float_as_uint(sc[n4][i]) & ~127u) | (unsigned)(32 * n4 + crow(i, h)));
      float res[16];
#pragma unroll
      for (int rd = 0; rd < 16; ++rd) {
        float mx = -INFINITY;
#pragma unroll
        for (int n4 = 0; n4 < 4; ++n4)
#pragma unroll
          for (int i = 0; i < 16; ++i) mx = fmaxf(mx, sc[n4][i]);
        const float M = fmaxf(mx, xor32(mx, lane));
        res[rd] = M;
#pragma unroll
        for (int n4 = 0; n4 < 4; ++n4)
#pragma unroll
          for (int i = 0; i < 16; ++i) sc[n4][i] = (sc[n4][i] == M) ? -INFINITY : sc[n4][i];
      }
      if (h == 0) {
        float* dst = ((float*)(p.ws + OFF_TOPS)) + (((size_t)mt * 256 + 32 * wid + r) * 16 + nt * 2 + pp) * 16;
#pragma unroll
        for (int g = 0; g < 4; ++g) { f32x4 v = {res[4 * g], res[4 * g + 1], res[4 * g + 2], res[4 * g + 3]}; *(f32x4*)(dst + 4 * g) = v; }
      }
    }
  }
}

DI void fp8x16_dot(const u32x4 u, const float (&xn)[16], float& d) {
#pragma unroll
  for (int dw = 0; dw < 4; ++dw) {
    const f32x2 lo = __builtin_amdgcn_cvt_pk_f32_fp8((int)u[dw], false), hi = __builtin_amdgcn_cvt_pk_f32_fp8((int)u[dw], true);
    d += lo.x * xn[4 * dw] + lo.y * xn[4 * dw + 1]; d += hi.x * xn[4 * dw + 2] + hi.y * xn[4 * dw + 3];
  }
}
DI void fp8x16_axpy(const u32x4 u, float w, float (&out)[16]) {
#pragma unroll
  for (int dw = 0; dw < 4; ++dw) {
    const f32x2 lo = __builtin_amdgcn_cvt_pk_f32_fp8((int)u[dw], false), hi = __builtin_amdgcn_cvt_pk_f32_fp8((int)u[dw], true);
    out[4 * dw] += w * lo.x; out[4 * dw + 1] += w * lo.y; out[4 * dw + 2] += w * hi.x; out[4 * dw + 3] += w * hi.y;
  }
}
DI void phase_peer_experts(const Params& p, int l, bool last) {
  const int t = tid(), lane = t & 63, wid = t >> 6;
  const unsigned char* pu = (const unsigned char*)(p.ws + OFF_PU) + (size_t)l * 16384 * 1024 + 16 * lane;
  const unsigned char* pv = (const unsigned char*)(p.ws + OFF_PV) + (size_t)l * 16384 * 1024 + 16 * lane;
  const float* gf = p.norm_ffn_g + l * 1024 + 16 * lane;
  const int pr = PAIRTAB[lane], ci = pr >> 4, cj = pr & 15;
  for (int tok = VB * 4 + wid; tok < T; tok += NVB * 4) {
    float* xr = p.x + (size_t)tok * DM + 16 * lane;
    float xn[16], out[16];
    {
      f32x4 xa[4];
#pragma unroll
      for (int k = 0; k < 4; ++k) xa[k] = *(const f32x4*)(xr + 4 * k);
      float ss = 0.f;
#pragma unroll
      for (int k = 0; k < 4; ++k) ss += xa[k].x * xa[k].x + xa[k].y * xa[k].y + xa[k].z * xa[k].z + xa[k].w * xa[k].w;
      ss = wave_sum(ss, lane);
      const float rstd = rsqrtf(ss * (1.0f / 1024.0f) + RMS_EPS);
#pragma unroll
      for (int k = 0; k < 4; ++k) { const f32x4 g = *(const f32x4*)(gf + 4 * k);
        xn[4 * k] = xa[k].x * rstd * g.x; xn[4 * k + 1] = xa[k].y * rstd * g.y; xn[4 * k + 2] = xa[k].z * rstd * g.z; xn[4 * k + 3] = xa[k].w * rstd * g.w; }
    }
#pragma unroll
    for (int k = 0; k < 16; ++k) out[k] = 0.f;
    const float* ts = ((float*)(p.ws + OFF_TOPS)) + (size_t)tok * 256;
    for (int hd = 0; hd < 8; ++hd) {
      const float sa = ts[hd * 32 + ci], sb = ts[hd * 32 + 16 + cj];
      const float val = (lane < 50) ? sa + sb : -INFINITY;
      const int idx = (int)((__float_as_uint(sa) & 127u) * 128u + (__float_as_uint(sb) & 127u));
      int rank = 0;
#pragma unroll
      for (int c = 0; c < 50; ++c) { const float vc = rdlane_f(val, c); rank += ((vc > val) || (vc == val && c < lane)) ? 1 : 0; }
      const bool selected = (rank < 16) && (lane < 50);
      unsigned long long sel = __ballot(selected);
      const float vmax = rdlane_f(val, 0);
      const float e = selected ? __expf(val - vmax) : 0.f;
      const float esum = wave_sum(e, lane);
      const float gate = e / esum;
      int ce = 0; float cgt = 0.f;
#pragma unroll
      for (int rd = 0; rd < 16; ++rd) {
        const int s = __ffsll((long long)sel) - 1; sel &= sel - 1;
        const int ex = __builtin_amdgcn_readlane(idx, s); const float gg = rdlane_f(gate, s);
        ce = (lane == rd) ? ex : ce; cgt = (lane == rd) ? gg : cgt;
      }
      float myd = 0.f;
      {
        u32x4 u[16];
#pragma unroll
        for (int k = 0; k < 16; ++k) { const int ex = __builtin_amdgcn_readlane(ce, k); u[k] = *(const u32x4*)(pu + (size_t)ex * 1024); }
#pragma unroll
        for (int k = 0; k < 16; ++k) {
          float d = 0.f;
          fp8x16_dot(u[k], xn, d);
          d = wave_sum(d, lane);
          myd = (lane == k) ? d : myd;
        }
      }
      myd *= F8_INV;
      const float wgt = cgt * (0.5f * myd * (1.0f + erff(myd * 0.70710678118654752f))) * F8_INV;
      {
        u32x4 u[16];
#pragma unroll
        for (int k = 0; k < 16; ++k) { const int ex = __builtin_amdgcn_readlane(ce, k); u[k] = *(const u32x4*)(pv + (size_t)ex * 1024); }
#pragma unroll
        for (int k = 0; k < 16; ++k) fp8x16_axpy(u[k], rdlane_f(wgt, k), out);
      }
    }
    f32x4 xo[4];
#pragma unroll
    for (int k = 0; k < 4; ++k) { const f32x4 xa = *(const f32x4*)(xr + 4 * k); xo[k].x = xa.x + out[4 * k]; xo[k].y = xa.y + out[4 * k + 1]; xo[k].z = xa.z + out[4 * k + 2]; xo[k].w = xa.w + out[4 * k + 3]; }
    if (last) {
      float s2 = 0.f;
#pragma unroll
      for (int k = 0; k < 4; ++k) s2 += xo[k].x * xo[k].x + xo[k].y * xo[k].y + xo[k].z * xo[k].z + xo[k].w * xo[k].w;
      s2 = wave_sum(s2, lane);
      const float r2 = rsqrtf(s2 * (1.0f / 1024.0f) + RMS_EPS);
      const float* fg = p.final_g + 16 * lane;
#pragma unroll
      for (int k = 0; k < 4; ++k) xo[k] = xo[k] * r2 * *(const f32x4*)(fg + 4 * k);
    }
#pragma unroll
    for (int k = 0; k < 4; ++k) *(f32x4*)(xr + 4 * k) = xo[k];
    if (!last) {
      bf16_t* xb = (bf16_t*)(p.ws + OFF_XB) + (size_t)tok * DM + 16 * lane;
      u32x4 b0 = {pk2(xo[0].x, xo[0].y), pk2(xo[0].z, xo[0].w), pk2(xo[1].x, xo[1].y), pk2(xo[1].z, xo[1].w)};
      u32x4 b1 = {pk2(xo[2].x, xo[2].y), pk2(xo[2].z, xo[2].w), pk2(xo[3].x, xo[3].y), pk2(xo[3].z, xo[3].w)};
      *(u32x4*)xb = b0; *(u32x4*)(xb + 8) = b1;
    }
  }
}

template <int L>
DI void run_layer(const Params& p, unsigned char* smem, unsigned char* vsm, cg::grid_group& grid) {
  phase_in_gemm(p, L, smem);
  grid.sync();
  for (int it = VB; it < 3840; it += NVB) na_item(p, L, it, vsm);
  for (int it = VB; it < 3840; it += NVB) swa_item(p, L, it, vsm);
  for (int it = VB; it < 10240; it += NVB) conv_item(p, L, it);
  grid.sync();
  phase_out_gemm(p, L, smem); grid.sync();
  phase_xq_gemm(p, L, smem);
  grid.sync();
  for (int it = VB; it < 2560; it += NVB) xattn_item(p, L, it, vsm);
  grid.sync();
  phase_xo_gemm(p, L, smem); grid.sync();
  phase_peer_q(p, L, smem);
  grid.sync();
  phase_peer_experts(p, L, L == 1);
}
__global__ void __launch_bounds__(512, 2) fwd(Params p) {
  __shared__ __attribute__((aligned(16))) unsigned char smem[SMEM_BYTES];
  unsigned char* vsm = smem + VHALF * VSMEM;
  cg::grid_group grid = cg::this_grid();
  phase_prologue(p, vsm);
  grid.sync();
  run_layer<0>(p, smem, vsm, grid); grid.sync();
  run_layer<1>(p, smem, vsm, grid);
}

extern "C" void kernel_launch(void* const* d_in, const int* in_sizes, int n_in, void* d_out, int out_size, void* d_ws, size_t ws_size, hipStream_t stream) {
  static int grid_blocks = 0;
  if (!grid_blocks) {
    int dev = 0, cus = 0, per_cu = 1;
    (void)hipGetDevice(&dev);
    (void)hipDeviceGetAttribute(&cus, hipDeviceAttributeMultiprocessorCount, dev);
    (void)hipOccupancyMaxActiveBlocksPerMultiprocessor(&per_cu, fwd, 512, 0);
    if (per_cu < 1) per_cu = 1;
    grid_blocks = cus;
    grid_blocks -= grid_blocks % 8;
  }
  Params p{};
  const float* const* in = (const float* const*)d_in;
  p.x_prompt = in[0]; p.x_sample = in[1]; p.mem_prompt = in[2]; p.mem_sample = in[3];
  p.norm_mix_g = in[4]; p.w_in = in[5]; p.na_rpb = in[6]; p.conv_w = in[7]; p.swa_sink = in[8]; p.t5_bias = in[9];
  p.w_out = in[10]; p.norm_xa_g = in[11]; p.norm_mem_g = in[12]; p.w_xq = in[13]; p.w_xk = in[14]; p.w_xv = in[15]; p.w_xo = in[16];
  p.norm_ffn_g = in[17]; p.peer_wq = in[18]; p.peer_subkeys = in[19]; p.peer_u = in[20]; p.peer_v = in[21]; p.final_g = in[22];
  p.x = (float*)d_out;
  p.ws = (unsigned char*)d_ws;
  if (WS_NEED > ws_size) { fprintf(stderr, "workspace too small: need %zu have %zu\n", (size_t)WS_NEED, ws_size); return; }
  void* args[] = {&p};
  hipError_t e = hipLaunchCooperativeKernel((void*)fwd, dim3(grid_blocks), dim3(512), args, 0, stream);
  if (e != hipSuccess) fprintf(stderr, "cooperative launch failed: %s (grid %d)\n", hipGetErrorString(e), grid_blocks);
}
```

```cpp
#include <hip/hip_runtime.h>
#include <hip/hip_cooperative_groups.h>
#include <cstdio>
#include <cstdint>
namespace cg = cooperative_groups;

#ifndef PROBE
#define PROBE 0
#endif
#ifndef ONE_LAUNCH
#define ONE_LAUNCH 1
#endif

#define DI __device__ __forceinline__
typedef unsigned short bf16_t;
typedef short bf16x8 __attribute__((ext_vector_type(8)));
typedef short s16x4 __attribute__((ext_vector_type(4)));
typedef float f32x16 __attribute__((ext_vector_type(16)));
typedef float f32x4 __attribute__((ext_vector_type(4)));
typedef float f32x2 __attribute__((ext_vector_type(2)));
typedef unsigned u32x4 __attribute__((ext_vector_type(4)));
typedef unsigned u32x2 __attribute__((ext_vector_type(2)));
typedef __bf16 bf2_t __attribute__((ext_vector_type(2)));

constexpr int T = 81920, DM = 1024, SEQ = 8192;
constexpr int IN_DIM = 2560;
constexpr float LOG2E = 1.4426950408889634f;
constexpr float RMS_EPS = 1e-6f;
constexpr int NPHASE = 17;

constexpr int Z_NAQ = 0, Z_NAK = 384, Z_NAV = 768, Z_SCB = 1152, Z_SCC = 1408, Z_SCH = 1664, Z_SWQ = 1920, Z_SWK = 2304, Z_SWV = 2432;

__device__ const unsigned char T5TAB[257] = {
15,15,15,15,15,15,15,15,15,15,15,15,15,15,15,15,15,15,15,15,15,15,15,15,15,15,15,15,15,15,15,15,15,15,15,15,15,15,14,14,14,14,14,14,14,14,14,14,14,14,14,14,14,14,14,14,14,14,14,14,14,14,14,14,14,13,13,13,13,13,13,13,13,13,13,13,13,13,13,13,13,13,13,12,12,12,12,12,12,12,12,12,12,12,12,12,12,11,11,11,11,11,11,11,11,11,10,10,10,10,10,10,10,9,9,9,9,8,8,8,8,7,6,5,4,3,2,1,0,17,18,19,20,21,22,23,24,24,24,24,25,25,25,25,26,26,26,26,26,26,26,27,27,27,27,27,27,27,27,27,28,28,28,28,28,28,28,28,28,28,28,28,28,28,29,29,29,29,29,29,29,29,29,29,29,29,29,29,29,29,29,29,30,30,30,30,30,30,30,30,30,30,30,30,30,30,30,30,30,30,30,30,30,30,30,30,30,30,30,31,31,31,31,31,31,31,31,31,31,31,31,31,31,31,31,31,31,31,31,31,31,31,31,31,31,31,31,31,31,31,31,31,31,31,31,31,31};
__device__ const unsigned char PAIRTAB[64] = {
0x00,0x01,0x02,0x03,0x04,0x05,0x06,0x07,0x08,0x09,0x0a,0x0b,0x0c,0x0d,0x0e,0x0f,
0x10,0x11,0x12,0x13,0x14,0x15,0x16,0x17,
0x20,0x21,0x22,0x23,0x24,
0x30,0x31,0x32,0x33,
0x40,0x41,0x42,
0x50,0x51,0x60,0x61,0x70,0x71,
0x80,0x90,0xa0,0xb0,0xc0,0xd0,0xe0,0xf0,
0,0,0,0,0,0,0,0,0,0,0,0,0,0};

struct Params {
  const float* x_prompt; const float* x_sample; const float* mem_prompt; const float* mem_sample;
  const float* norm_mix_g; const float* w_in; const float* na_rpb; const float* conv_w; const float* swa_sink; const float* t5_bias;
  const float* w_out; const float* norm_xa_g; const float* norm_mem_g; const float* w_xq; const float* w_xk; const float* w_xv; const float* w_xo;
  const float* norm_ffn_g; const float* peer_wq; const float* peer_subkeys; const float* peer_u; const float* peer_v; const float* final_g;
  float* x;
  unsigned char* ws;
};
constexpr size_t OFF_Z = 0;
constexpr size_t OFF_Q = 0;
constexpr size_t OFF_O = (size_t)T * 512 * 2;
constexpr size_t OFF_TOPS = (size_t)T * 1024 * 2;
constexpr size_t OFF_YMIX = OFF_Z + (size_t)T * IN_DIM * 2;
constexpr size_t OFF_WIN = OFF_YMIX + (size_t)T * DM * 2;
constexpr size_t OFF_WOUT = OFF_WIN + (size_t)2 * 2560 * 1024 * 2;
constexpr size_t OFF_WXQ = OFF_WOUT + (size_t)2 * 1024 * 1024 * 2;
constexpr size_t OFF_WXKV = OFF_WXQ + (size_t)2 * 512 * 1024 * 2;
constexpr size_t OFF_WXO = OFF_WXKV + (size_t)2 * 1024 * 1024 * 2;
constexpr size_t OFF_WPQ = OFF_WXO + (size_t)2 * 1024 * 512 * 2;
constexpr size_t OFF_SUBK = OFF_WPQ + (size_t)2 * 2048 * 1024 * 2;
constexpr size_t OFF_PU = OFF_SUBK + (size_t)2 * 8 * 2 * 128 * 128 * 2;
constexpr size_t OFF_PV = OFF_PU + (size_t)2 * 16384 * 1024 * 2;
constexpr size_t OFF_MEMKV = OFF_PV + (size_t)2 * 16384 * 1024 * 2;
constexpr size_t OFF_XB = OFF_MEMKV + (size_t)2 * 2560 * 1024 * 2;
constexpr size_t OFF_MEMB = OFF_XB + (size_t)T * DM * 2;
constexpr size_t WS_NEED = OFF_MEMB + (size_t)2560 * 1024 * 2;

DI unsigned pk2(float a, float b) { f32x2 v = {a, b}; return __builtin_bit_cast(unsigned, __builtin_convertvector(v, bf2_t)); }
DI bf16_t bf1(float a) { return (bf16_t)(pk2(a, 0.f) & 0xffffu); }
DI float bf_lo(unsigned u) { return __uint_as_float(u << 16); }
DI float bf_hi(unsigned u) { return __uint_as_float(u & 0xffff0000u); }
#define MFMA32(a, b, c) __builtin_amdgcn_mfma_f32_32x32x16_bf16((a), (b), (c), 0, 0, 0)
DI int crow(int i, int h) { return (i & 3) + 8 * (i >> 2) + 4 * h; }
DI int tid() { int t = threadIdx.x & 255; asm volatile("" : "+v"(t)); return t; }
DI int tid512() { int t = threadIdx.x; asm volatile("" : "+v"(t)); return t; }
#define VHALF (__builtin_amdgcn_readfirstlane((int)(threadIdx.x >> 8)))
#define VB ((int)(blockIdx.x * 2) + VHALF)
#define NVB ((int)(gridDim.x * 2))
template <int CTRL> DI float dpp(float v) { return __int_as_float(__builtin_amdgcn_update_dpp(0, __float_as_int(v), CTRL, 0xf, 0xf, true)); }
DI float xor16(float v) { return __int_as_float(__builtin_amdgcn_ds_swizzle(__float_as_int(v), 0x401F)); }
DI float xor32(float v, int lane) { return __int_as_float(__builtin_amdgcn_ds_bpermute((lane ^ 32) << 2, __float_as_int(v))); }
DI float row_sum(float v) { v += dpp<0xB1>(v); v += dpp<0x4E>(v); v += dpp<0x141>(v); v += dpp<0x140>(v); return v; }
DI float wave_sum(float v, int lane) { v = row_sum(v); v += xor16(v); v += xor32(v, lane); return v; }
DI float rdlane_f(float v, int l) { return __int_as_float(__builtin_amdgcn_readlane(__float_as_int(v), l)); }

constexpr int LDT = 72;
constexpr int VSMEM = 74240;
constexpr int GBUF = 512 * LDT * 2;
constexpr int SMEM_RSTD = 2 * GBUF;
constexpr int SMEM_BYTES = 2 * VSMEM;
static_assert(SMEM_RSTD + 1024 <= SMEM_BYTES, "LDS map");

template <bool SUMSQ>
DI void gemm_tile(const bf16_t* __restrict__ Ap, int lda, const bf16_t* __restrict__ Bp, int K, unsigned char* smem, f32x16 (&acc)[4][2]) {
  float* rs = (float*)(smem + SMEM_RSTD);
  const int t = tid512(), lane = t & 63, wid = t >> 6, wm = wid >> 2, wn = wid & 3, r = lane & 31, h = lane >> 5;
#pragma unroll
  for (int a = 0; a < 4; ++a)
#pragma unroll
    for (int b = 0; b < 2; ++b)
#pragma unroll
      for (int i = 0; i < 16; ++i) acc[a][b][i] = 0.f;
  u32x4 ar[4], br[4]; float ss[4];
#pragma unroll
  for (int i = 0; i < 4; ++i) ss[i] = 0.f;
  const int nk = K >> 6;
  const unsigned voA = (unsigned)(((t >> 3) * lda + (t & 7) * 8) * 2), voB = (unsigned)(((t >> 3) * K + (t & 7) * 8) * 2);
  const char* Ac = (const char*)Ap; const char* Bc = (const char*)Bp;
  const int stoff = ((t >> 3) * LDT + (t & 7) * 8) * 2;
#define GEMM_LDG(kt) { \
    _Pragma("unroll") for (int i = 0; i < 4; ++i) ar[i] = *(const u32x4*)(Ac + ((size_t)(64 * i) * lda + (kt) * 64) * 2 + voA); \
    _Pragma("unroll") for (int i = 0; i < 4; ++i) br[i] = *(const u32x4*)(Bc + ((size_t)(64 * i) * K + (kt) * 64) * 2 + voB); }
#define GEMM_STS(buf) { unsigned char* sa_ = smem + (buf) * GBUF + stoff; \
    _Pragma("unroll") for (int i = 0; i < 4; ++i) { *(u32x4*)(sa_ + 64 * i * LDT * 2) = ar[i]; \
      if constexpr (SUMSQ) { _Pragma("unroll") for (int e = 0; e < 4; ++e) { const float lo = bf_lo(ar[i][e]), hi = bf_hi(ar[i][e]); ss[i] += lo * lo + hi * hi; } } } \
    _Pragma("unroll") for (int i = 0; i < 4; ++i) *(u32x4*)(sa_ + 256 * LDT * 2 + 64 * i * LDT * 2) = br[i]; }
  GEMM_LDG(0);
  __syncthreads();
  GEMM_STS(0);
  __syncthreads();
#pragma unroll 1
  for (int kt = 0; kt < nk; ++kt) {
    const int cur = kt & 1;
    if (kt + 1 < nk) GEMM_LDG(kt + 1);
    const bf16_t* a = (const bf16_t*)(smem + cur * GBUF) + (128 * wm + r) * LDT + 8 * h;
    const bf16_t* b = (const bf16_t*)(smem + cur * GBUF) + 256 * LDT + (64 * wn + r) * LDT + 8 * h;
#pragma unroll
    for (int ks = 0; ks < 4; ++ks) {
      const bf16x8 b0 = *(const bf16x8*)(b + 16 * ks), b1 = *(const bf16x8*)(b + 32 * LDT + 16 * ks);
#pragma unroll
      for (int mi = 0; mi < 4; ++mi) {
        const bf16x8 av = *(const bf16x8*)(a + 32 * mi * LDT + 16 * ks);
        acc[mi][0] = MFMA32(av, b0, acc[mi][0]); acc[mi][1] = MFMA32(av, b1, acc[mi][1]);
      }
    }
    if (kt + 1 < nk) GEMM_STS(cur ^ 1);
    __syncthreads();
  }
#undef GEMM_LDG
#undef GEMM_STS
  if constexpr (SUMSQ) {
#pragma unroll
    for (int i = 0; i < 4; ++i) {
      float s = ss[i];
      s += dpp<0xB1>(s); s += dpp<0x4E>(s); s += dpp<0x141>(s);
      if ((t & 7) == 0) rs[(t >> 3) + 64 * i] = rsqrtf(s * (1.0f / 1024.0f) + RMS_EPS);
    }
    __syncthreads();
  }
}

template <int LDC>
DI void epi_bf16_scaled(const f32x16 (&acc)[4][2], unsigned char* smem, bf16_t* C) {
  const float* rs = (const float*)(smem + SMEM_RSTD);
  const int t = tid512(), lane = t & 63, wid = t >> 6, wm = wid >> 2, wn = wid & 3, r = lane & 31, h = lane >> 5;
  bf16_t* ct = (bf16_t*)smem + (128 * wm + 4 * h) * 264 + 64 * wn + r;
  const float* rsw = rs + 128 * wm + 4 * h;
#pragma unroll
  for (int mi = 0; mi < 4; ++mi)
#pragma unroll
    for (int i = 0; i < 16; ++i) {
      const int rowc = 32 * mi + (i & 3) + 8 * (i >> 2);
      const float sc = rsw[rowc];
#pragma unroll
      for (int ni = 0; ni < 2; ++ni) ct[rowc * 264 + 32 * ni] = bf1(acc[mi][ni][i] * sc);
    }
  __syncthreads();
  const bf16_t* cs = (const bf16_t*)smem + (t >> 5) * 264 + 8 * (t & 31);
  char* cg_ = (char*)C; const unsigned vo = (unsigned)(((t >> 5) * LDC + 8 * (t & 31)) * 2);
#pragma unroll
  for (int j = 0; j < 16; ++j) *(u32x4*)(cg_ + (size_t)(16 * j) * LDC * 2 + vo) = *(const u32x4*)(cs + 16 * j * 264);
}
DI void epi_resid(const f32x16 (&acc)[4][2], unsigned char* smem, float* X, bf16_t* XB) {
  const int t = tid512(), lane = t & 63, wid = t >> 6, wm = wid >> 2, wn = wid & 3, r = lane & 31, h = lane >> 5;
  float* ct = (float*)smem + (128 * wm + 4 * h) * 132 + 64 * (wn & 1) + r;
  const float* cs = (const float*)smem + (t >> 5) * 132 + 4 * (t & 31);
  const unsigned vo = (unsigned)((t >> 5) * DM + 4 * (t & 31));
#pragma unroll 1
  for (int hf = 0; hf < 2; ++hf) {
    if (hf) __syncthreads();
    if ((wn >> 1) == hf) {
#pragma unroll
      for (int mi = 0; mi < 4; ++mi)
#pragma unroll
        for (int i = 0; i < 16; ++i) {
          const int rowc = 32 * mi + (i & 3) + 8 * (i >> 2);
#pragma unroll
          for (int ni = 0; ni < 2; ++ni) ct[rowc * 132 + 32 * ni] = acc[mi][ni][i];
        }
    }
    __syncthreads();
    char* xg = (char*)(X + 128 * hf); char* bg = (char*)(XB + 128 * hf);
#pragma unroll
    for (int j = 0; j < 16; ++j) {
      f32x4* px = (f32x4*)(xg + ((size_t)(16 * j) * DM + vo) * 4);
      const f32x4 v = *px + *(const f32x4*)(cs + 16 * j * 132);
      *px = v;
      u32x2 pk = {pk2(v.x, v.y), pk2(v.z, v.w)};
      *(u32x2*)(bg + ((size_t)(16 * j) * DM + vo) * 2) = pk;
    }
  }
}

template <int D, class F>
DI void attn_tile(const bf16_t* Ks, const bf16_t* Vt, const bf16x8 (&qf)[D / 16], f32x16 (&o)[D / 32], float& m, float& l, F fn, int r, int h, int lane) {
  f32x16 s;
#pragma unroll
  for (int i = 0; i < 16; ++i) s[i] = 0.f;
#pragma unroll
  for (int ks = 0; ks < D / 16; ++ks) { const bf16x8 a = *(const bf16x8*)(Ks + r * (D + 8) + 16 * ks + 8 * h); s = MFMA32(a, qf[ks], s); }
  float mx = -INFINITY;
#pragma unroll
  for (int i = 0; i < 16; ++i) { s[i] = fn(s[i], i); mx = fmaxf(mx, s[i]); }
  mx = fmaxf(mx, xor32(mx, lane));
  const float mn = fmaxf(m, mx);
  const float alpha = __builtin_amdgcn_exp2f(m - mn);
  m = mn;
  float sum = 0.f;
#pragma unroll
  for (int i = 0; i < 16; ++i) { s[i] = __builtin_amdgcn_exp2f(s[i] - mn); sum += s[i]; }
  l = l * alpha + sum;
#pragma unroll
  for (int dt = 0; dt < D / 32; ++dt)
#pragma unroll
    for (int i = 0; i < 16; ++i) o[dt][i] *= alpha;
  bf16x8 pf[2];
#pragma unroll
  for (int s2 = 0; s2 < 2; ++s2) {
    u32x4 pk = {pk2(s[8 * s2], s[8 * s2 + 1]), pk2(s[8 * s2 + 2], s[8 * s2 + 3]), pk2(s[8 * s2 + 4], s[8 * s2 + 5]), pk2(s[8 * s2 + 6], s[8 * s2 + 7])};
    pf[s2] = __builtin_bit_cast(bf16x8, pk);
  }
#pragma unroll
  for (int dt = 0; dt < D / 32; ++dt)
#pragma unroll
    for (int s2 = 0; s2 < 2; ++s2) {
      const int cx = (4 * dt + (r >> 3)) & 7;
      const bf16_t* vrow = Vt + (32 * dt + r) * 40;
      const s16x4 lo = *(const s16x4*)(vrow + (((4 * s2 + h) ^ cx) << 2)), hi = *(const s16x4*)(vrow + (((4 * s2 + h + 2) ^ cx) << 2));
      const bf16x8 a = __builtin_shufflevector(lo, hi, 0, 1, 2, 3, 4, 5, 6, 7);
      o[dt] = MFMA32(a, pf[s2], o[dt]);
    }
}
DI void vt_store(bf16_t* Vt, u32x4 v, int c8, int kk) {
#pragma unroll
  for (int e = 0; e < 8; ++e) Vt[(8 * c8 + e) * 40 + (kk ^ ((c8 & 7) << 2))] = (bf16_t)((v[e >> 1] >> (16 * (e & 1))) & 0xffffu);
}
template <int ND>
DI void attn_out(const f32x16 (&o)[ND], float l, bf16_t* yp, int h, int lane) {
  const float lt = l + xor32(l, lane);
  const float inv = 1.0f / lt;
#pragma unroll
  for (int dt = 0; dt < ND; ++dt)
#pragma unroll
    for (int g = 0; g < 4; ++g) {
      u32x2 v = {pk2(o[dt][4 * g] * inv, o[dt][4 * g + 1] * inv), pk2(o[dt][4 * g + 2] * inv, o[dt][4 * g + 3] * inv)};
      *(u32x2*)(yp + 32 * dt + 8 * g + 4 * h) = v;
    }
}

constexpr int AT64_BUF = 32 * 72 + 64 * 40;
DI void swa_item(const Params& p, int l, int item, unsigned char* smem) {
  const int t = tid(), lane = t & 63, w = t >> 6, r = lane & 31, h = lane >> 5;
  const int head = item % 6, n = (item / 6) & 63, b = item / 384, hkv = head / 3;
  bf16_t* st = (bf16_t*)smem;
  float* bt = (float*)(smem + 2 * AT64_BUF * 2);
  __syncthreads();
  for (int i = t; i < 257; i += 256) bt[i] = p.t5_bias[T5TAB[i] * 6 + head] * LOG2E;
  const size_t tok0 = (size_t)b * SEQ;
  const int q0 = n * 128 + 32 * w;
  bf16x8 qf[4];
  { const bf16_t* qp = ((bf16_t*)(p.ws + OFF_Z)) + (tok0 + q0 + r) * IN_DIM + Z_SWQ + head * 64 + 8 * h;
#pragma unroll
    for (int ks = 0; ks < 4; ++ks) qf[ks] = *(const bf16x8*)(qp + 16 * ks); }
  f32x16 o[2];
#pragma unroll
  for (int dt = 0; dt < 2; ++dt)
#pragma unroll
    for (int i = 0; i < 16; ++i) o[dt][i] = 0.f;
  float m = p.swa_sink[l * 6 + head] * LOG2E, lsum = (h == 0) ? 1.f : 0.f;
  const int kt_lo = (n == 0) ? 4 : 0, kt_hi = (n == 63) ? 8 : 12;
  const int kk = t >> 3, c8 = t & 7;
  const bf16_t* kbase = ((bf16_t*)(p.ws + OFF_Z)) + (tok0 + (size_t)(n * 128 + kk)) * IN_DIM + Z_SWK + hkv * 64 + 8 * c8;
  u32x4 kr = {0, 0, 0, 0}, vr = {0, 0, 0, 0};
  if (kt_lo == 0) { const bf16_t* kp = kbase + (ptrdiff_t)(-128) * IN_DIM; kr = *(const u32x4*)kp; vr = *(const u32x4*)(kp + 128);
    *(u32x4*)(st + kk * 72 + 8 * c8) = kr; vt_store(st + 32 * 72, vr, c8, kk); }
  __syncthreads();
  const float sc2 = 0.125f * LOG2E;
  for (int kt = 0; kt < 12; ++kt) {
    const int cur = kt & 1;
    const bool nxt = (kt + 1 >= kt_lo) && (kt + 1 < kt_hi);
    if (nxt) { const bf16_t* kp = kbase + (ptrdiff_t)(32 * (kt + 1) - 128) * IN_DIM; kr = *(const u32x4*)kp; vr = *(const u32x4*)(kp + 128); }
    if (kt >= kt_lo && kt < kt_hi && kt >= w && kt <= w + 8) {
      const int kb = 32 * kt - 128 - 32 * w - r + 4 * h;
      attn_tile<64>(st + cur * AT64_BUF, st + cur * AT64_BUF + 32 * 72, qf, o, m, lsum,
        [&](float sv, int i) { const int oi = kb + (i & 3) + 8 * (i >> 2) + 128; const bool ok = (unsigned)oi <= 256u; const float bias = bt[ok ? oi : 0]; return ok ? sv * sc2 + bias : -INFINITY; }, r, h, lane);
    }
    if (nxt) { bf16_t* sb = st + (cur ^ 1) * AT64_BUF; *(u32x4*)(sb + kk * 72 + 8 * c8) = kr; vt_store(sb + 32 * 72, vr, c8, kk); }
    __syncthreads();
  }
  attn_out<2>(o, lsum, ((bf16_t*)(p.ws + OFF_YMIX)) + (tok0 + q0 + r) * DM + 640 + head * 64, h, lane);
}

DI void na_item(const Params& p, int l, int item, unsigned char* smem) {
  const int t = tid(), lane = t & 63, w = t >> 6, r = lane & 31, h = lane >> 5;
  const int hp = item % 3, rr = (item / 3) & 127, b = item / 384;
  const int hh = w >> 1, qh = w & 1, head = 2 * hp + hh;
  bf16_t* st = (bf16_t*)smem;
  constexpr int NBUF = 2 * AT64_BUF;
  float* bt = (float*)(smem + 2 * NBUF * 2);
  __syncthreads();
  for (int i = t; i < 930; i += 256) { const int e = i % 465, hsel = i / 465; bt[i] = p.na_rpb[((size_t)l * 465 + e) * 6 + 2 * hp + hsel] * LOG2E; }
  const size_t tok0 = (size_t)b * SEQ;
  const int r0 = min(max(rr - 4, 0), 120);
  const int c = 32 * qh + r;
  bf16x8 qf[4];
  { const bf16_t* qp = ((bf16_t*)(p.ws + OFF_Z)) + (tok0 + rr * 64 + c) * IN_DIM + Z_NAQ + head * 64 + 8 * h;
#pragma unroll
    for (int ks = 0; ks < 4; ++ks) qf[ks] = *(const bf16x8*)(qp + 16 * ks); }
  f32x16 o[2];
#pragma unroll
  for (int dt = 0; dt < 2; ++dt)
#pragma unroll
    for (int i = 0; i < 16; ++i) o[dt][i] = 0.f;
  float m = -1e30f, lsum = 0.f;
  const int kk = t >> 3, c8 = t & 7;
  const bf16_t* kbase = ((bf16_t*)(p.ws + OFF_Z)) + (tok0 + (size_t)((r0 + (kk >> 4)) * 64 + (kk & 15))) * IN_DIM + Z_NAK + (2 * hp) * 64 + 8 * c8;
  u32x4 k0r, k1r, v0r, v1r;
#define NA_LDG(kt) { const bf16_t* kp = kbase + (size_t)(((kt) >> 2) * 128 + ((kt) & 3) * 16) * IN_DIM; \
    k0r = *(const u32x4*)kp; k1r = *(const u32x4*)(kp + 64); v0r = *(const u32x4*)(kp + 384); v1r = *(const u32x4*)(kp + 448); }
#define NA_STS(buf) { bf16_t* sb = st + (buf) * NBUF; *(u32x4*)(sb + kk * 72 + 8 * c8) = k0r; *(u32x4*)(sb + AT64_BUF + kk * 72 + 8 * c8) = k1r; \
    vt_store(sb + 32 * 72, v0r, c8, kk); vt_store(sb + AT64_BUF + 32 * 72, v1r, c8, kk); }
  NA_LDG(0);
  NA_STS(0);
  __syncthreads();
  const float sc2 = 0.125f * LOG2E;
  const int c0 = min(max(c - 8, 0), 48);
  const float* bth = bt + hh * 465;
  for (int kt = 0; kt < 16; ++kt) {
    const int cur = kt & 1;
    if (kt + 1 < 16) NA_LDG(kt + 1);
    const int rp = kt >> 2, cb = kt & 3;
    if (cb >= qh && cb <= qh + 2) {
      const bf16_t* sb = st + cur * NBUF + hh * AT64_BUF;
      const int drb = r0 + 2 * rp - rr + 7;
      const int kcb = 16 * cb;
      attn_tile<64>(sb, sb + 32 * 72, qf, o, m, lsum,
        [&](float sv, int i) { const int kq = (i & 3) + 8 * (i >> 2) + 4 * h; const int kcol = kcb + (kq & 15); const int dr = drb + (kq >> 4);
          const bool ok = (kcol >= c0) && (kcol < c0 + 16); const int bi = dr * 31 + (kcol - c + 15); const float bias = bth[ok ? bi : 0];
          return ok ? sv * sc2 + bias : -INFINITY; }, r, h, lane);
    }
    if (kt + 1 < 16) NA_STS(cur ^ 1);
    __syncthreads();
  }
#undef NA_LDG
#undef NA_STS
  attn_out<2>(o, lsum, ((bf16_t*)(p.ws + OFF_YMIX)) + (tok0 + rr * 64 + c) * DM + head * 64, h, lane);
}

DI void conv_item(const Params& p, int l, int item) {
  const int t = tid();
  const size_t tok = (size_t)item * 8 + (t >> 5);
  const int c8 = t & 31, pos = (int)(tok & (SEQ - 1));
  const bf16_t* zr = ((bf16_t*)(p.ws + OFF_Z)) + tok * IN_DIM + 8 * c8;
  const u32x4 bv = *(const u32x4*)(zr + Z_SCB);
  const u32x4 cc = *(const u32x4*)(zr + Z_SCC), hc = *(const u32x4*)(zr + Z_SCH);
  u32x4 cm = {0, 0, 0, 0}, hm = {0, 0, 0, 0}, cp = {0, 0, 0, 0}, hpv = {0, 0, 0, 0};
  if (pos > 0) { cm = *(const u32x4*)(zr - IN_DIM + Z_SCC); hm = *(const u32x4*)(zr - IN_DIM + Z_SCH); }
  if (pos < SEQ - 1) { cp = *(const u32x4*)(zr + IN_DIM + Z_SCC); hpv = *(const u32x4*)(zr + IN_DIM + Z_SCH); }
  const float* cw = p.conv_w + (size_t)l * 3 * 256 + 8 * c8;
  float y[8];
#pragma unroll
  for (int e = 0; e < 8; ++e) {
    const int wd = e >> 1;
    const float fb = (e & 1) ? bf_hi(bv[wd]) : bf_lo(bv[wd]);
    const float um = ((e & 1) ? bf_hi(cm[wd]) : bf_lo(cm[wd])) * ((e & 1) ? bf_hi(hm[wd]) : bf_lo(hm[wd]));
    const float uc = ((e & 1) ? bf_hi(cc[wd]) : bf_lo(cc[wd])) * ((e & 1) ? bf_hi(hc[wd]) : bf_lo(hc[wd]));
    const float up = ((e & 1) ? bf_hi(cp[wd]) : bf_lo(cp[wd])) * ((e & 1) ? bf_hi(hpv[wd]) : bf_lo(hpv[wd]));
    y[e] = fb * (um * cw[e] + uc * cw[256 + e] + up * cw[512 + e]);
  }
  u32x4 ov = {pk2(y[0], y[1]), pk2(y[2], y[3]), pk2(y[4], y[5]), pk2(y[6], y[7])};
  *(u32x4*)(((bf16_t*)(p.ws + OFF_YMIX)) + tok * DM + 384 + 8 * c8) = ov;
}

constexpr int AT128_BUF = 32 * 136 + 128 * 40;
DI void xattn_item(const Params& p, int l, int item, unsigned char* smem) {
  const int t = tid(), lane = t & 63, w = t >> 6, r = lane & 31, h = lane >> 5;
  const int qt = item & 63, head = (item >> 6) & 3, b = item >> 8;
  bf16_t* st = (bf16_t*)smem;
  const size_t tok = (size_t)b * SEQ + qt * 128 + 32 * w + r;
  bf16x8 qf[8];
  { const bf16_t* qp = ((bf16_t*)(p.ws + OFF_Q)) + tok * 512 + head * 128 + 8 * h;
#pragma unroll
    for (int ks = 0; ks < 8; ++ks) qf[ks] = *(const bf16x8*)(qp + 16 * ks); }
  f32x16 o[4];
#pragma unroll
  for (int dt = 0; dt < 4; ++dt)
#pragma unroll
    for (int i = 0; i < 16; ++i) o[dt][i] = 0.f;
  float m = -1e30f, lsum = 0.f;
  const int kk = t >> 4, c8 = t & 15;
  const bf16_t* kbase = ((bf16_t*)(p.ws + OFF_MEMKV)) + ((size_t)l * 2560 + (size_t)b * 256 + kk) * 1024 + head * 128 + 8 * c8;
  u32x4 k0r, k1r, v0r, v1r;
#define XA_LDG(kt) { const bf16_t* kp = kbase + (size_t)(32 * (kt)) * 1024; \
    k0r = *(const u32x4*)kp; k1r = *(const u32x4*)(kp + 16 * 1024); v0r = *(const u32x4*)(kp + 512); v1r = *(const u32x4*)(kp + 16 * 1024 + 512); }
#define XA_STS(buf) { bf16_t* sb = st + (buf) * AT128_BUF; *(u32x4*)(sb + kk * 136 + 8 * c8) = k0r; *(u32x4*)(sb + (kk + 16) * 136 + 8 * c8) = k1r; \
    vt_store(sb + 32 * 136, v0r, c8, kk); vt_store(sb + 32 * 136, v1r, c8, kk + 16); }
  __syncthreads();
  XA_LDG(0);
  XA_STS(0);
  __syncthreads();
  const float sc2 = 0.08838834764831845f * LOG2E;
  for (int kt = 0; kt < 8; ++kt) {
    const int cur = kt & 1;
    if (kt + 1 < 8) XA_LDG(kt + 1);
    { const bf16_t* sb = st + cur * AT128_BUF;
      attn_tile<128>(sb, sb + 32 * 136, qf, o, m, lsum, [&](float sv, int) { return sv * sc2; }, r, h, lane); }
    if (kt + 1 < 8) XA_STS(cur ^ 1);
    __syncthreads();
  }
#undef XA_LDG
#undef XA_STS
  attn_out<4>(o, lsum, ((bf16_t*)(p.ws + OFF_O)) + tok * 512 + head * 128, h, lane);
}

DI void transpose_job(const float* __restrict__ src, int K, int N, const float* __restrict__ g, bf16_t* __restrict__ dst, unsigned char* smem) {
  float* tl = (float*)smem;
  const int tn = N / 64, ntile = (K / 64) * tn, t = tid();
  for (int tile = VB; tile < ntile; tile += NVB) {
    const int k0 = (tile / tn) * 64, n0 = (tile % tn) * 64;
    __syncthreads();
#pragma unroll 4
    for (int i = 0; i < 16; ++i) { const int kk = (t >> 6) + 4 * i; float v = src[(size_t)(k0 + kk) * N + n0 + (t & 63)]; if (g) v *= g[k0 + kk]; tl[kk * 65 + (t & 63)] = v; }
    __syncthreads();
#pragma unroll 4
    for (int i = 0; i < 16; ++i) { const int nn = (t >> 6) + 4 * i; dst[(size_t)(n0 + nn) * K + k0 + (t & 63)] = bf1(tl[(t & 63) * 65 + nn]); }
  }
}
DI void convert_job(const float* __restrict__ src, bf16_t* __restrict__ dst, size_t n4) {
  for (size_t i = (size_t)VB * 256 + tid(); i < n4; i += (size_t)NVB * 256) {
    const f32x4 v = ((const f32x4*)src)[i];
    u32x2 o = {pk2(v.x, v.y), pk2(v.z, v.w)};
    ((u32x2*)dst)[i] = o;
  }
}

constexpr float F8_SCALE = 64.0f, F8_INV = 1.0f / 64.0f;
DI unsigned pk4_fp8(f32x4 v) {
  int w = 0;
  w = __builtin_amdgcn_cvt_pk_fp8_f32(v.x * F8_SCALE, v.y * F8_SCALE, w, false);
  w = __builtin_amdgcn_cvt_pk_fp8_f32(v.z * F8_SCALE, v.w * F8_SCALE, w, true);
  return (unsigned)w;
}
DI void convert_fp8_job(const float* __restrict__ src, unsigned char* __restrict__ dst, size_t n16) {
  for (size_t i = (size_t)VB * 256 + tid(); i < n16; i += (size_t)NVB * 256) {
    const f32x4* s = (const f32x4*)src + 4 * i;
    u32x4 o = {pk4_fp8(s[0]), pk4_fp8(s[1]), pk4_fp8(s[2]), pk4_fp8(s[3])};
    ((u32x4*)dst)[i] = o;
  }
}

DI void phase_prologue(const Params& p, unsigned char* smem) {
  { const size_t n4p = (size_t)16384 * 256, n4 = (size_t)T * 256;
    for (size_t i = (size_t)VB * 256 + tid(); i < n4; i += (size_t)NVB * 256)
    { const f32x4 v = (i < n4p) ? ((const f32x4*)p.x_prompt)[i] : ((const f32x4*)p.x_sample)[i - n4p];
      ((f32x4*)p.x)[i] = v; u32x2 pk = {pk2(v.x, v.y), pk2(v.z, v.w)}; ((u32x2*)(p.ws + OFF_XB))[i] = pk; } }
  convert_job(p.mem_prompt, (bf16_t*)(p.ws + OFF_MEMB), (size_t)512 * 1024 / 4);
  convert_job(p.mem_sample, (bf16_t*)(p.ws + OFF_MEMB) + (size_t)512 * 1024, (size_t)2048 * 1024 / 4);
  for (int l = 0; l < 2; ++l) {
    transpose_job(p.w_in + (size_t)l * 1024 * 2560, 1024, 2560, p.norm_mix_g + l * 1024, ((bf16_t*)(p.ws + OFF_WIN)) + (size_t)l * 2560 * 1024, smem);
    transpose_job(p.w_out + (size_t)l * 1024 * 1024, 1024, 1024, nullptr, ((bf16_t*)(p.ws + OFF_WOUT)) + (size_t)l * 1024 * 1024, smem);
    transpose_job(p.w_xq + (size_t)l * 1024 * 512, 1024, 512, p.norm_xa_g + l * 1024, ((bf16_t*)(p.ws + OFF_WXQ)) + (size_t)l * 512 * 1024, smem);
    transpose_job(p.w_xk + (size_t)l * 1024 * 512, 1024, 512, p.norm_mem_g + l * 1024, ((bf16_t*)(p.ws + OFF_WXKV)) + (size_t)l * 1024 * 1024, smem);
    transpose_job(p.w_xv + (size_t)l * 1024 * 512, 1024, 512, p.norm_mem_g + l * 1024, ((bf16_t*)(p.ws + OFF_WXKV)) + (size_t)l * 1024 * 1024 + (size_t)512 * 1024, smem);
    transpose_job(p.w_xo + (size_t)l * 512 * 1024, 512, 1024, nullptr, ((bf16_t*)(p.ws + OFF_WXO)) + (size_t)l * 1024 * 512, smem);
    transpose_job(p.peer_wq + (size_t)l * 1024 * 2048, 1024, 2048, p.norm_ffn_g + l * 1024, ((bf16_t*)(p.ws + OFF_WPQ)) + (size_t)l * 2048 * 1024, smem);
  }
  convert_job(p.peer_subkeys, ((bf16_t*)(p.ws + OFF_SUBK)), (size_t)2 * 8 * 2 * 128 * 128 / 4);
  convert_fp8_job(p.peer_u, (unsigned char*)(p.ws + OFF_PU), (size_t)2 * 16384 * 1024 / 16);
  convert_fp8_job(p.peer_v, (unsigned char*)(p.ws + OFF_PV), (size_t)2 * 16384 * 1024 / 16);
}

#define TILE_WALK(NT, MT8) const int nx_ = gridDim.x >> 3, xcd_ = blockIdx.x & 7; \
  for (int j_ = blockIdx.x >> 3; j_ < (MT8) * (NT); j_ += nx_) { const int mt = (j_ / (NT)) * 8 + xcd_, nt = j_ % (NT);

DI void phase_in_gemm(const Params& p, int l, unsigned char* smem) {
  f32x16 acc[4][2];
  { TILE_WALK(10, 40)
    gemm_tile<true>(((bf16_t*)(p.ws + OFF_XB)) + (size_t)mt * 256 * DM, DM, ((bf16_t*)(p.ws + OFF_WIN)) + ((size_t)l * 2560 + nt * 256) * 1024, 1024, smem, acc);
    epi_bf16_scaled<IN_DIM>(acc, smem, ((bf16_t*)(p.ws + OFF_Z)) + (size_t)mt * 256 * IN_DIM + nt * 256);
  } }
  if (l == 0) {
    for (int j = blockIdx.x; j < 10 * 4 * 2; j += gridDim.x) {
      const int ll = j / 40, mt = (j % 40) >> 2, nt = j & 3;
      gemm_tile<true>(((bf16_t*)(p.ws + OFF_MEMB)) + (size_t)mt * 256 * DM, DM, ((bf16_t*)(p.ws + OFF_WXKV)) + ((size_t)ll * 1024 + nt * 256) * 1024, 1024, smem, acc);
      epi_bf16_scaled<1024>(acc, smem, ((bf16_t*)(p.ws + OFF_MEMKV)) + ((size_t)ll * 2560 + mt * 256) * 1024 + nt * 256);
    }
  }
}
DI void phase_out_gemm(const Params& p, int l, unsigned char* smem) {
  f32x16 acc[4][2];
  TILE_WALK(4, 40)
    gemm_tile<false>(((bf16_t*)(p.ws + OFF_YMIX)) + (size_t)mt * 256 * DM, DM, ((bf16_t*)(p.ws + OFF_WOUT)) + ((size_t)l * 1024 + nt * 256) * 1024, 1024, smem, acc);
    epi_resid(acc, smem, p.x + (size_t)mt * 256 * DM + nt * 256, ((bf16_t*)(p.ws + OFF_XB)) + (size_t)mt * 256 * DM + nt * 256);
  }
}
DI void phase_xq_gemm(const Params& p, int l, unsigned char* smem) {
  f32x16 acc[4][2];
  TILE_WALK(2, 40)
    gemm_tile<true>(((bf16_t*)(p.ws + OFF_XB)) + (size_t)mt * 256 * DM, DM, ((bf16_t*)(p.ws + OFF_WXQ)) + ((size_t)l * 512 + nt * 256) * 1024, 1024, smem, acc);
    epi_bf16_scaled<512>(acc, smem, ((bf16_t*)(p.ws + OFF_Q)) + (size_t)mt * 256 * 512 + nt * 256);
  }
}
DI void phase_xo_gemm(const Params& p, int l, unsigned char* smem) {
  f32x16 acc[4][2];
  TILE_WALK(4, 40)
    gemm_tile<false>(((bf16_t*)(p.ws + OFF_O)) + (size_t)mt * 256 * 512, 512, ((bf16_t*)(p.ws + OFF_WXO)) + ((size_t)l * 1024 + nt * 256) * 512, 512, smem, acc);
    epi_resid(acc, smem, p.x + (size_t)mt * 256 * DM + nt * 256, ((bf16_t*)(p.ws + OFF_XB)) + (size_t)mt * 256 * DM + nt * 256);
  }
}
DI void topk16_pair(float (&v)[64], float (&res)[16], int lane) {
#define CE(i, l) { const float a_ = v[i], b_ = v[l]; v[i] = fmaxf(a_, b_); v[l] = fminf(a_, b_); }
  CE(0, 1) CE(3, 2) CE(4, 5) CE(7, 6) CE(8, 9) CE(11, 10) CE(12, 13) CE(15, 14) CE(0, 2) CE(1, 3) CE(6, 4) CE(7, 5) CE(8, 10) CE(9, 11) CE(14, 12) CE(15, 13) CE(0, 1) CE(2, 3)
  CE(5, 4) CE(7, 6) CE(8, 9) CE(10, 11) CE(13, 12) CE(15, 14) CE(0, 4) CE(1, 5) CE(2, 6) CE(3, 7) CE(12, 8) CE(13, 9) CE(14, 10) CE(15, 11) CE(0, 2) CE(1, 3) CE(4, 6) CE(5, 7)
  CE(10, 8) CE(11, 9) CE(14, 12) CE(15, 13) CE(0, 1) CE(2, 3) CE(4, 5) CE(6, 7) CE(9, 8) CE(11, 10) CE(13, 12) CE(15, 14) CE(0, 8) CE(1, 9) CE(2, 10) CE(3, 11) CE(4, 12) CE(5, 13)
  CE(6, 14) CE(7, 15) CE(0, 4) CE(1, 5) CE(2, 6) CE(3, 7) CE(8, 12) CE(9, 13) CE(10, 14) CE(11, 15) CE(0, 2) CE(1, 3) CE(4, 6) CE(5, 7) CE(8, 10) CE(9, 11) CE(12, 14) CE(13, 15)
  CE(0, 1) CE(2, 3) CE(4, 5) CE(6, 7) CE(8, 9) CE(10, 11) CE(12, 13) CE(14, 15) CE(16, 17) CE(19, 18) CE(20, 21) CE(23, 22) CE(24, 25) CE(27, 26) CE(28, 29) CE(31, 30) CE(16, 18)
  CE(17, 19) CE(22, 20) CE(23, 21) CE(24, 26) CE(25, 27) CE(30, 28) CE(31, 29) CE(16, 17) CE(18, 19) CE(21, 20) CE(23, 22) CE(24, 25) CE(26, 27) CE(29, 28) CE(31, 30) CE(16, 20)
  CE(17, 21) CE(18, 22) CE(19, 23) CE(28, 24) CE(29, 25) CE(30, 26) CE(31, 27) CE(16, 18) CE(17, 19) CE(20, 22) CE(21, 23) CE(26, 24) CE(27, 25) CE(30, 28) CE(31, 29) CE(16, 17)
  CE(18, 19) CE(20, 21) CE(22, 23) CE(25, 24) CE(27, 26) CE(29, 28) CE(31, 30) CE(16, 24) CE(17, 25) CE(18, 26) CE(19, 27) CE(20, 28) CE(21, 29) CE(22, 30) CE(23, 31) CE(16, 20)
  CE(17, 21) CE(18, 22) CE(19, 23) CE(24, 28) CE(25, 29) CE(26, 30) CE(27, 31) CE(16, 18) CE(17, 19) CE(20, 22) CE(21, 23) CE(24, 26) CE(25, 27) CE(28, 30) CE(29, 31) CE(16, 17)
  CE(18, 19) CE(20, 21) CE(22, 23) CE(24, 25) CE(26, 27) CE(28, 29) CE(30, 31) CE(32, 33) CE(35, 34) CE(36, 37) CE(39, 38) CE(40, 41) CE(43, 42) CE(44, 45) CE(47, 46) CE(32, 34)
  CE(33, 35) CE(38, 36) CE(39, 37) CE(40, 42) CE(41, 43) CE(46, 44) CE(47, 45) CE(32, 33) CE(34, 35) CE(37, 36) CE(39, 38) CE(40, 41) CE(42, 43) CE(45, 44) CE(47, 46) CE(32, 36)
  CE(33, 37) CE(34, 38) CE(35, 39) CE(44, 40) CE(45, 41) CE(46, 42) CE(47, 43) CE(32, 34) CE(33, 35) CE(36, 38) CE(37, 39) CE(42, 40) CE(43, 41) CE(46, 44) CE(47, 45) CE(32, 33)
  CE(34, 35) CE(36, 37) CE(38, 39) CE(41, 40) CE(43, 42) CE(45, 44) CE(47, 46) CE(32, 40) CE(33, 41) CE(34, 42) CE(35, 43) CE(36, 44) CE(37, 45) CE(38, 46) CE(39, 47) CE(32, 36)
  CE(33, 37) CE(34, 38) CE(35, 39) CE(40, 44) CE(41, 45) CE(42, 46) CE(43, 47) CE(32, 34) CE(33, 35) CE(36, 38) CE(37, 39) CE(40, 42) CE(41, 43) CE(44, 46) CE(45, 47) CE(32, 33)
  CE(34, 35) CE(36, 37) CE(38, 39) CE(40, 41) CE(42, 43) CE(44, 45) CE(46, 47) CE(48, 49) CE(51, 50) CE(52, 53) CE(55, 54) CE(56, 57) CE(59, 58) CE(60, 61) CE(63, 62) CE(48, 50)
  CE(49, 51) CE(54, 52) CE(55, 53) CE(56, 58) CE(57, 59) CE(62, 60) CE(63, 61) CE(48, 49) CE(50, 51) CE(53, 52) CE(55, 54) CE(56, 57) CE(58, 59) CE(61, 60) CE(63, 62) CE(48, 52)
  CE(49, 53) CE(50, 54) CE(51, 55) CE(60, 56) CE(61, 57) CE(62, 58) CE(63, 59) CE(48, 50) CE(49, 51) CE(52, 54) CE(53, 55) CE(58, 56) CE(59, 57) CE(62, 60) CE(63, 61) CE(48, 49)
  CE(50, 51) CE(52, 53) CE(54, 55) CE(57, 56) CE(59, 58) CE(61, 60) CE(63, 62) CE(48, 56) CE(49, 57) CE(50, 58) CE(51, 59) CE(52, 60) CE(53, 61) CE(54, 62) CE(55, 63) CE(48, 52)
  CE(49, 53) CE(50, 54) CE(51, 55) CE(56, 60) CE(57, 61) CE(58, 62) CE(59, 63) CE(48, 50) CE(49, 51) CE(52, 54) CE(53, 55) CE(56, 58) CE(57, 59) CE(60, 62) CE(61, 63) CE(48, 49)
  CE(50, 51) CE(52, 53) CE(54, 55) CE(56, 57) CE(58, 59) CE(60, 61) CE(62, 63) v[0] = fmaxf(v[0], v[31]); v[1] = fmaxf(v[1], v[30]); v[2] = fmaxf(v[2], v[29]);
  v[3] = fmaxf(v[3], v[28]); v[4] = fmaxf(v[4], v[27]); v[5] = fmaxf(v[5], v[26]); v[6] = fmaxf(v[6], v[25]); v[7] = fmaxf(v[7], v[24]); v[8] = fmaxf(v[8], v[23]);
  v[9] = fmaxf(v[9], v[22]); v[10] = fmaxf(v[10], v[21]); v[11] = fmaxf(v[11], v[20]); v[12] = fmaxf(v[12], v[19]); v[13] = fmaxf(v[13], v[18]); v[14] = fmaxf(v[14], v[17]);
  v[15] = fmaxf(v[15], v[16]); CE(0, 8) CE(1, 9) CE(2, 10) CE(3, 11) CE(4, 12) CE(5, 13) CE(6, 14) CE(7, 15) CE(0, 4) CE(1, 5) CE(2, 6) CE(3, 7) CE(8, 12) CE(9, 13) CE(10, 14)
  CE(11, 15) CE(0, 2) CE(1, 3) CE(4, 6) CE(5, 7) CE(8, 10) CE(9, 11) CE(12, 14) CE(13, 15) CE(0, 1) CE(2, 3) CE(4, 5) CE(6, 7) CE(8, 9) CE(10, 11) CE(12, 13) CE(14, 15)
  v[32] = fmaxf(v[32], v[63]); v[33] = fmaxf(v[33], v[62]); v[34] = fmaxf(v[34], v[61]); v[35] = fmaxf(v[35], v[60]); v[36] = fmaxf(v[36], v[59]); v[37] = fmaxf(v[37], v[58]);
  v[38] = fmaxf(v[38], v[57]); v[39] = fmaxf(v[39], v[56]); v[40] = fmaxf(v[40], v[55]); v[41] = fmaxf(v[41], v[54]); v[42] = fmaxf(v[42], v[53]); v[43] = fmaxf(v[43], v[52]);
  v[44] = fmaxf(v[44], v[51]); v[45] = fmaxf(v[45], v[50]); v[46] = fmaxf(v[46], v[49]); v[47] = fmaxf(v[47], v[48]); CE(32, 40) CE(33, 41) CE(34, 42) CE(35, 43) CE(36, 44)
  CE(37, 45) CE(38, 46) CE(39, 47) CE(32, 36) CE(33, 37) CE(34, 38) CE(35, 39) CE(40, 44) CE(41, 45) CE(42, 46) CE(43, 47) CE(32, 34) CE(33, 35) CE(36, 38) CE(37, 39) CE(40, 42)
  CE(41, 43) CE(44, 46) CE(45, 47) CE(32, 33) CE(34, 35) CE(36, 37) CE(38, 39) CE(40, 41) CE(42, 43) CE(44, 45) CE(46, 47) v[0] = fmaxf(v[0], v[47]); v[1] = fmaxf(v[1], v[46]);
  v[2] = fmaxf(v[2], v[45]); v[3] = fmaxf(v[3], v[44]); v[4] = fmaxf(v[4], v[43]); v[5] = fmaxf(v[5], v[42]); v[6] = fmaxf(v[6], v[41]); v[7] = fmaxf(v[7], v[40]);
  v[8] = fmaxf(v[8], v[39]); v[9] = fmaxf(v[9], v[38]); v[10] = fmaxf(v[10], v[37]); v[11] = fmaxf(v[11], v[36]); v[12] = fmaxf(v[12], v[35]); v[13] = fmaxf(v[13], v[34]);
  v[14] = fmaxf(v[14], v[33]); v[15] = fmaxf(v[15], v[32]); CE(0, 8) CE(1, 9) CE(2, 10) CE(3, 11) CE(4, 12) CE(5, 13) CE(6, 14) CE(7, 15) CE(0, 4) CE(1, 5) CE(2, 6) CE(3, 7)
  CE(8, 12) CE(9, 13) CE(10, 14) CE(11, 15) CE(0, 2) CE(1, 3) CE(4, 6) CE(5, 7) CE(8, 10) CE(9, 11) CE(12, 14) CE(13, 15) CE(0, 1) CE(2, 3) CE(4, 5) CE(6, 7) CE(8, 9) CE(10, 11)
  CE(12, 13) CE(14, 15)
  float pq[16];
#pragma unroll
  for (int i = 0; i < 16; ++i) pq[i] = xor32(v[i], lane);
#pragma unroll
  for (int i = 0; i < 16; ++i) res[i] = fmaxf(v[i], pq[15 - i]);
  { const float a_ = res[0], b_ = res[8]; res[0] = fmaxf(a_, b_); res[8] = fminf(a_, b_); }
  { const float a_ = res[1], b_ = res[9]; res[1] = fmaxf(a_, b_); res[9] = fminf(a_, b_); }
  { const float a_ = res[2], b_ = res[10]; res[2] = fmaxf(a_, b_); res[10] = fminf(a_, b_); }
  { const float a_ = res[3], b_ = res[11]; res[3] = fmaxf(a_, b_); res[11] = fminf(a_, b_); }
  { const float a_ = res[4], b_ = res[12]; res[4] = fmaxf(a_, b_); res[12] = fminf(a_, b_); }
  { const float a_ = res[5], b_ = res[13]; res[5] = fmaxf(a_, b_); res[13] = fminf(a_, b_); }
  { const float a_ = res[6], b_ = res[14]; res[6] = fmaxf(a_, b_); res[14] = fminf(a_, b_); }
  { const float a_ = res[7], b_ = res[15]; res[7] = fmaxf(a_, b_); res[15] = fminf(a_, b_); }
  { const float a_ = res[0], b_ = res[4]; res[0] = fmaxf(a_, b_); res[4] = fminf(a_, b_); }
  { const float a_ = res[1], b_ = res[5]; res[1] = fmaxf(a_, b_); res[5] = fminf(a_, b_); }
  { const float a_ = res[2], b_ = res[6]; res[2] = fmaxf(a_, b_); res[6] = fminf(a_, b_); }
  { const float a_ = res[3], b_ = res[7]; res[3] = fmaxf(a_, b_); res[7] = fminf(a_, b_); }
  { const float a_ = res[8], b_ = res[12]; res[8] = fmaxf(a_, b_); res[12] = fminf(a_, b_); }
  { const float a_ = res[9], b_ = res[13]; res[9] = fmaxf(a_, b_); res[13] = fminf(a_, b_); }
  { const float a_ = res[10], b_ = res[14]; res[10] = fmaxf(a_, b_); res[14] = fminf(a_, b_); }
  { const float a_ = res[11], b_ = res[15]; res[11] = fmaxf(a_, b_); res[15] = fminf(a_, b_); }
  { const float a_ = res[0], b_ = res[2]; res[0] = fmaxf(a_, b_); res[2] = fminf(a_, b_); }
  { const float a_ = res[1], b_ = res[3]; res[1] = fmaxf(a_, b_); res[3] = fminf(a_, b_); }
  { const float a_ = res[4], b_ = res[6]; res[4] = fmaxf(a_, b_); res[6] = fminf(a_, b_); }
  { const float a_ = res[5], b_ = res[7]; res[5] = fmaxf(a_, b_); res[7] = fminf(a_, b_); }
  { const float a_ = res[8], b_ = res[10]; res[8] = fmaxf(a_, b_); res[10] = fminf(a_, b_); }
  { const float a_ = res[9], b_ = res[11]; res[9] = fmaxf(a_, b_); res[11] = fminf(a_, b_); }
  { const float a_ = res[12], b_ = res[14]; res[12] = fmaxf(a_, b_); res[14] = fminf(a_, b_); }
  { const float a_ = res[13], b_ = res[15]; res[13] = fmaxf(a_, b_); res[15] = fminf(a_, b_); }
  { const float a_ = res[0], b_ = res[1]; res[0] = fmaxf(a_, b_); res[1] = fminf(a_, b_); }
  { const float a_ = res[2], b_ = res[3]; res[2] = fmaxf(a_, b_); res[3] = fminf(a_, b_); }
  { const float a_ = res[4], b_ = res[5]; res[4] = fmaxf(a_, b_); res[5] = fminf(a_, b_); }
  { const float a_ = res[6], b_ = res[7]; res[6] = fmaxf(a_, b_); res[7] = fminf(a_, b_); }
  { const float a_ = res[8], b_ = res[9]; res[8] = fmaxf(a_, b_); res[9] = fminf(a_, b_); }
  { const float a_ = res[10], b_ = res[11]; res[10] = fmaxf(a_, b_); res[11] = fminf(a_, b_); }
  { const float a_ = res[12], b_ = res[13]; res[12] = fmaxf(a_, b_); res[13] = fminf(a_, b_); }
  { const float a_ = res[14], b_ = res[15]; res[14] = fmaxf(a_, b_); res[15] = fminf(a_, b_); }
#undef CE
}
DI void phase_peer_q(const Params& p, int l, unsigned char* smem) {
  f32x16 acc[4][2];
  const float* rs = (const float*)(smem + SMEM_RSTD);
  bf16_t* Qs = (bf16_t*)smem;
  TILE_WALK(8, 40)
    gemm_tile<true>(((bf16_t*)(p.ws + OFF_XB)) + (size_t)mt * 256 * DM, DM, ((bf16_t*)(p.ws + OFF_WPQ)) + ((size_t)l * 2048 + nt * 256) * 1024, 1024, smem, acc);
    const int t = tid512(), lane = t & 63, wid = t >> 6, wm = wid >> 2, wn = wid & 3, r = lane & 31, h = lane >> 5;
    {
      bf16_t* qw = Qs + (128 * wm + 4 * h) * 264 + 64 * wn + r;
      const float* rsw = rs + 128 * wm + 4 * h;
#pragma unroll
      for (int mi = 0; mi < 4; ++mi)
#pragma unroll
        for (int i = 0; i < 16; ++i) {
          const int rowc = 32 * mi + (i & 3) + 8 * (i >> 2);
          const float sc = rsw[rowc];
#pragma unroll
          for (int ni = 0; ni < 2; ++ni) qw[rowc * 264 + 32 * ni] = bf1(acc[mi][ni][i] * sc);
        }
    }
    __syncthreads();
#pragma unroll 1
    for (int pp = 0; pp < 2; ++pp) {
      const bf16_t* sk = ((bf16_t*)(p.ws + OFF_SUBK)) + ((size_t)(l * 16 + nt * 2 + pp) * 128) * 128 + r * 128 + 8 * h;
      f32x16 sc[4];
#pragma unroll
      for (int n4 = 0; n4 < 4; ++n4)
#pragma unroll
        for (int i = 0; i < 16; ++i) sc[n4][i] = 0.f;
#pragma unroll 2
      for (int ks = 0; ks < 8; ++ks) {
        const bf16x8 bq = *(const bf16x8*)(Qs + (32 * wid + r) * 264 + 128 * pp + 16 * ks + 8 * h);
#pragma unroll
        for (int n4 = 0; n4 < 4; ++n4) { const bf16x8 a = *(const bf16x8*)(sk + (32 * n4) * 128 + 16 * ks); sc[n4] = MFMA32(a, bq, sc[n4]); }
      }
      float v[64], res[16];
#pragma unroll
      for (int n4 = 0; n4 < 4; ++n4)
#pragma unroll
        for (int i = 0; i < 16; ++i) v[16 * n4 + i] = __uint_as_float((__float_as_uint(sc[n4][i]) & ~127u) | (unsigned)(32 * n4 + crow(i, h)));
      topk16_pair(v, res, lane);
      if (h == 0) {
        float* dst = ((float*)(p.ws + OFF_TOPS)) + (((size_t)mt * 256 + 32 * wid + r) * 16 + nt * 2 + pp) * 16;
#pragma unroll
        for (int g = 0; g < 4; ++g) { f32x4 v = {res[4 * g], res[4 * g + 1], res[4 * g + 2], res[4 * g + 3]}; *(f32x4*)(dst + 4 * g) = v; }
      }
    }
  }
}

DI void fp8x16_dot(const u32x4 u, const float (&xn)[16], float& d) {
#pragma unroll
  for (int dw = 0; dw < 4; ++dw) {
    const f32x2 lo = __builtin_amdgcn_cvt_pk_f32_fp8((int)u[dw], false), hi = __builtin_amdgcn_cvt_pk_f32_fp8((int)u[dw], true);
    d += lo.x * xn[4 * dw] + lo.y * xn[4 * dw + 1]; d += hi.x * xn[4 * dw + 2] + hi.y * xn[4 * dw + 3];
  }
}
DI void fp8x16_axpy(const u32x4 u, float w, float (&out)[16]) {
#pragma unroll
  for (int dw = 0; dw < 4; ++dw) {
    const f32x2 lo = __builtin_amdgcn_cvt_pk_f32_fp8((int)u[dw], false), hi = __builtin_amdgcn_cvt_pk_f32_fp8((int)u[dw], true);
    out[4 * dw] += w * lo.x; out[4 * dw + 1] += w * lo.y; out[4 * dw + 2] += w * hi.x; out[4 * dw + 3] += w * hi.y;
  }
}
DI void phase_peer_experts(const Params& p, int l, bool last) {
  const int t = tid(), lane = t & 63, wid = t >> 6;
  const unsigned char* pu = (const unsigned char*)(p.ws + OFF_PU) + (size_t)l * 16384 * 1024 + 16 * lane;
  const unsigned char* pv = (const unsigned char*)(p.ws + OFF_PV) + (size_t)l * 16384 * 1024 + 16 * lane;
  const float* gf = p.norm_ffn_g + l * 1024 + 16 * lane;
  const int pr = PAIRTAB[lane], ci = pr >> 4, cj = pr & 15;
  for (int tok = VB * 4 + wid; tok < T; tok += NVB * 4) {
    float* xr = p.x + (size_t)tok * DM + 16 * lane;
    float xn[16], out[16];
    {
      f32x4 xa[4];
#pragma unroll
      for (int k = 0; k < 4; ++k) xa[k] = *(const f32x4*)(xr + 4 * k);
      float ss = 0.f;
#pragma unroll
      for (int k = 0; k < 4; ++k) ss += xa[k].x * xa[k].x + xa[k].y * xa[k].y + xa[k].z * xa[k].z + xa[k].w * xa[k].w;
      ss = wave_sum(ss, lane);
      const float rstd = rsqrtf(ss * (1.0f / 1024.0f) + RMS_EPS);
#pragma unroll
      for (int k = 0; k < 4; ++k) { const f32x4 g = *(const f32x4*)(gf + 4 * k);
        xn[4 * k] = xa[k].x * rstd * g.x; xn[4 * k + 1] = xa[k].y * rstd * g.y; xn[4 * k + 2] = xa[k].z * rstd * g.z; xn[4 * k + 3] = xa[k].w * rstd * g.w; }
    }
#pragma unroll
    for (int k = 0; k < 16; ++k) out[k] = 0.f;
    const float* ts = ((float*)(p.ws + OFF_TOPS)) + (size_t)tok * 256;
    for (int hd = 0; hd < 8; ++hd) {
      const float sa = ts[hd * 32 + ci], sb = ts[hd * 32 + 16 + cj];
      const float val = (lane < 50) ? sa + sb : -INFINITY;
      const int idx = (int)((__float_as_uint(sa) & 127u) * 128u + (__float_as_uint(sb) & 127u));
      int rank = 0;
#pragma unroll
      for (int c = 0; c < 50; ++c) { const float vc = rdlane_f(val, c); rank += ((vc > val) || (vc == val && c < lane)) ? 1 : 0; }
      const bool selected = (rank < 16) && (lane < 50);
      unsigned long long sel = __ballot(selected);
      const float vmax = rdlane_f(val, 0);
      const float e = selected ? __expf(val - vmax) : 0.f;
      const float esum = wave_sum(e, lane);
      const float gate = e / esum;
      int ce = 0; float cgt = 0.f;
#pragma unroll
      for (int rd = 0; rd < 16; ++rd) {
        const int s = __ffsll((long long)sel) - 1; sel &= sel - 1;
        const int ex = __builtin_amdgcn_readlane(idx, s); const float gg = rdlane_f(gate, s);
        ce = (lane == rd) ? ex : ce; cgt = (lane == rd) ? gg : cgt;
      }
      float myd = 0.f;
      {
        u32x4 u[16];
#pragma unroll
        for (int k = 0; k < 16; ++k) { const int ex = __builtin_amdgcn_readlane(ce, k); u[k] = *(const u32x4*)(pu + (size_t)ex * 1024); }
#pragma unroll
        for (int k = 0; k < 16; ++k) {
          float d = 0.f;
          fp8x16_dot(u[k], xn, d);
          d = wave_sum(d, lane);
          myd = (lane == k) ? d : myd;
        }
      }
      myd *= F8_INV;
      const float wgt = cgt * (0.5f * myd * (1.0f + erff(myd * 0.70710678118654752f))) * F8_INV;
      {
        u32x4 u[16];
#pragma unroll
        for (int k = 0; k < 16; ++k) { const int ex = __builtin_amdgcn_readlane(ce, k); u[k] = *(const u32x4*)(pv + (size_t)ex * 1024); }
#pragma unroll
        for (int k = 0; k < 16; ++k) fp8x16_axpy(u[k], rdlane_f(wgt, k), out);
      }
    }
    f32x4 xo[4];
#pragma unroll
    for (int k = 0; k < 4; ++k) { const f32x4 xa = *(const f32x4*)(xr + 4 * k); xo[k].x = xa.x + out[4 * k]; xo[k].y = xa.y + out[4 * k + 1]; xo[k].z = xa.z + out[4 * k + 2]; xo[k].w = xa.w + out[4 * k + 3]; }
    if (last) {
      float s2 = 0.f;
#pragma unroll
      for (int k = 0; k < 4; ++k) s2 += xo[k].x * xo[k].x + xo[k].y * xo[k].y + xo[k].z * xo[k].z + xo[k].w * xo[k].w;
      s2 = wave_sum(s2, lane);
      const float r2 = rsqrtf(s2 * (1.0f / 1024.0f) + RMS_EPS);
      const float* fg = p.final_g + 16 * lane;
#pragma unroll
      for (int k = 0; k < 4; ++k) xo[k] = xo[k] * r2 * *(const f32x4*)(fg + 4 * k);
    }
#pragma unroll
    for (int k = 0; k < 4; ++k) *(f32x4*)(xr + 4 * k) = xo[k];
    if (!last) {
      bf16_t* xb = (bf16_t*)(p.ws + OFF_XB) + (size_t)tok * DM + 16 * lane;
      u32x4 b0 = {pk2(xo[0].x, xo[0].y), pk2(xo[0].z, xo[0].w), pk2(xo[1].x, xo[1].y), pk2(xo[1].z, xo[1].w)};
      u32x4 b1 = {pk2(xo[2].x, xo[2].y), pk2(xo[2].z, xo[2].w), pk2(xo[3].x, xo[3].y), pk2(xo[3].z, xo[3].w)};
      *(u32x4*)xb = b0; *(u32x4*)(xb + 8) = b1;
    }
  }
}

template <int L>
DI void run_layer(const Params& p, unsigned char* smem, unsigned char* vsm, cg::grid_group& grid) {
  phase_in_gemm(p, L, smem);
  grid.sync();
  for (int it = VB; it < 3840; it += NVB) na_item(p, L, it, vsm);
  for (int it = VB; it < 3840; it += NVB) swa_item(p, L, it, vsm);
  for (int it = VB; it < 10240; it += NVB) conv_item(p, L, it);
  grid.sync();
  phase_out_gemm(p, L, smem); grid.sync();
  phase_xq_gemm(p, L, smem);
  grid.sync();
  for (int it = VB; it < 2560; it += NVB) xattn_item(p, L, it, vsm);
  grid.sync();
  phase_xo_gemm(p, L, smem); grid.sync();
  phase_peer_q(p, L, smem);
  grid.sync();
  phase_peer_experts(p, L, L == 1);
}
__global__ void __launch_bounds__(512, 2) fwd(Params p) {
  __shared__ __attribute__((aligned(16))) unsigned char smem[SMEM_BYTES];
  unsigned char* vsm = smem + VHALF * VSMEM;
  cg::grid_group grid = cg::this_grid();
  phase_prologue(p, vsm);
  grid.sync();
  run_layer<0>(p, smem, vsm, grid); grid.sync();
  run_layer<1>(p, smem, vsm, grid);
}

extern "C" void kernel_launch(void* const* d_in, const int* in_sizes, int n_in, void* d_out, int out_size, void* d_ws, size_t ws_size, hipStream_t stream) {
  static int grid_blocks = 0;
  if (!grid_blocks) {
    int dev = 0, cus = 0, per_cu = 1;
    (void)hipGetDevice(&dev);
    (void)hipDeviceGetAttribute(&cus, hipDeviceAttributeMultiprocessorCount, dev);
    (void)hipOccupancyMaxActiveBlocksPerMultiprocessor(&per_cu, fwd, 512, 0);
    if (per_cu < 1) per_cu = 1;
    grid_blocks = cus;
    grid_blocks -= grid_blocks % 8;
  }
  Params p{};
  const float* const* in = (const float* const*)d_in;
  p.x_prompt = in[0]; p.x_sample = in[1]; p.mem_prompt = in[2]; p.mem_sample = in[3];
  p.norm_mix_g = in[4]; p.w_in = in[5]; p.na_rpb = in[6]; p.conv_w = in[7]; p.swa_sink = in[8]; p.t5_bias = in[9];
  p.w_out = in[10]; p.norm_xa_g = in[11]; p.norm_mem_g = in[12]; p.w_xq = in[13]; p.w_xk = in[14]; p.w_xv = in[15]; p.w_xo = in[16];
  p.norm_ffn_g = in[17]; p.peer_wq = in[18]; p.peer_subkeys = in[19]; p.peer_u = in[20]; p.peer_v = in[21]; p.final_g = in[22];
  p.x = (float*)d_out;
  p.ws = (unsigned char*)d_ws;
  if (WS_NEED > ws_size) { fprintf(stderr, "workspace too small: need %zu have %zu\n", (size_t)WS_NEED, ws_size); return; }
  void* args[] = {&p};
  hipError_t e = hipLaunchCooperativeKernel((void*)fwd, dim3(grid_blocks), dim3(512), args, 0, stream);
  if (e != hipSuccess) fprintf(stderr, "cooperative launch failed: %s (grid %d)\n", hipGetErrorString(e), grid_blocks);
}
```

```cpp
#include <hip/hip_runtime.h>
#include <hip/hip_cooperative_groups.h>
#include <cstdio>
#include <cstdint>
namespace cg = cooperative_groups;


#define DI __device__ __forceinline__
typedef unsigned short bf16_t;
typedef short bf16x8 __attribute__((ext_vector_type(8)));
typedef short s16x4 __attribute__((ext_vector_type(4)));
typedef __attribute__((address_space(3))) s16x4 lds_s16x4;
typedef float f32x16 __attribute__((ext_vector_type(16)));
typedef float f32x4 __attribute__((ext_vector_type(4)));
typedef float f32x2 __attribute__((ext_vector_type(2)));
typedef unsigned u32x4 __attribute__((ext_vector_type(4)));
typedef unsigned u32x2 __attribute__((ext_vector_type(2)));
typedef __bf16 bf2_t __attribute__((ext_vector_type(2)));

constexpr int T = 81920, DM = 1024, SEQ = 8192;
constexpr int IN_DIM = 2560;
constexpr float LOG2E = 1.4426950408889634f;
constexpr float RMS_EPS = 1e-6f;
constexpr int NPHASE = 17;

constexpr int Z_NAQ = 0, Z_NAK = 384, Z_NAV = 768, Z_SCB = 1152, Z_SCC = 1408, Z_SCH = 1664, Z_SWQ = 1920, Z_SWK = 2304, Z_SWV = 2432;

__device__ const unsigned char T5TAB[257] = {
15,15,15,15,15,15,15,15,15,15,15,15,15,15,15,15,15,15,15,15,15,15,15,15,15,15,15,15,15,15,15,15,15,15,15,15,15,15,14,14,14,14,14,14,14,14,14,14,14,14,14,14,14,14,14,14,14,14,14,14,14,14,14,14,14,13,13,13,13,13,13,13,13,13,13,13,13,13,13,13,13,13,13,12,12,12,12,12,12,12,12,12,12,12,12,12,12,11,11,11,11,11,11,11,11,11,10,10,10,10,10,10,10,9,9,9,9,8,8,8,8,7,6,5,4,3,2,1,0,17,18,19,20,21,22,23,24,24,24,24,25,25,25,25,26,26,26,26,26,26,26,27,27,27,27,27,27,27,27,27,28,28,28,28,28,28,28,28,28,28,28,28,28,28,29,29,29,29,29,29,29,29,29,29,29,29,29,29,29,29,29,29,30,30,30,30,30,30,30,30,30,30,30,30,30,30,30,30,30,30,30,30,30,30,30,30,30,30,30,31,31,31,31,31,31,31,31,31,31,31,31,31,31,31,31,31,31,31,31,31,31,31,31,31,31,31,31,31,31,31,31,31,31,31,31,31,31};
__device__ const unsigned char PAIRTAB[64] = {
0x00,0x01,0x02,0x03,0x04,0x05,0x06,0x07,0x08,0x09,0x0a,0x0b,0x0c,0x0d,0x0e,0x0f,
0x10,0x11,0x12,0x13,0x14,0x15,0x16,0x17,
0x20,0x21,0x22,0x23,0x24,
0x30,0x31,0x32,0x33,
0x40,0x41,0x42,
0x50,0x51,0x60,0x61,0x70,0x71,
0x80,0x90,0xa0,0xb0,0xc0,0xd0,0xe0,0xf0,
0,0,0,0,0,0,0,0,0,0,0,0,0,0};

struct Params {
  const float* x_prompt; const float* x_sample; const float* mem_prompt; const float* mem_sample;
  const float* norm_mix_g; const float* w_in; const float* na_rpb; const float* conv_w; const float* swa_sink; const float* t5_bias;
  const float* w_out; const float* norm_xa_g; const float* norm_mem_g; const float* w_xq; const float* w_xk; const float* w_xv; const float* w_xo;
  const float* norm_ffn_g; const float* peer_wq; const float* peer_subkeys; const float* peer_u; const float* peer_v; const float* final_g;
  float* x;
  unsigned char* ws;
};
constexpr size_t OFF_Z = 0;
constexpr size_t OFF_Q = 0;
constexpr size_t OFF_O = (size_t)T * 512 * 2;
constexpr size_t OFF_TOPS = (size_t)T * 1024 * 2;
constexpr size_t OFF_YMIX = OFF_Z + (size_t)T * IN_DIM * 2;
constexpr size_t OFF_WIN = OFF_YMIX + (size_t)T * DM * 2;
constexpr size_t OFF_WOUT = OFF_WIN + (size_t)2 * 2560 * 1024 * 2;
constexpr size_t OFF_WXQ = OFF_WOUT + (size_t)2 * 1024 * 1024 * 2;
constexpr size_t OFF_WXKV = OFF_WXQ + (size_t)2 * 512 * 1024 * 2;
constexpr size_t OFF_WXO = OFF_WXKV + (size_t)2 * 1024 * 1024 * 2;
constexpr size_t OFF_WPQ = OFF_WXO + (size_t)2 * 1024 * 512 * 2;
constexpr size_t OFF_SUBK = OFF_WPQ + (size_t)2 * 2048 * 1024 * 2;
constexpr size_t OFF_PU = OFF_SUBK + (size_t)2 * 8 * 2 * 128 * 128 * 2;
constexpr size_t OFF_PV = OFF_PU + (size_t)2 * 16384 * 1024 * 2;
constexpr size_t OFF_MEMKV = OFF_PV + (size_t)2 * 16384 * 1024 * 2;
constexpr size_t OFF_XB = OFF_MEMKV + (size_t)2 * 2560 * 1024 * 2;
constexpr size_t OFF_MEMB = OFF_XB + (size_t)T * DM * 2;
constexpr size_t OFF_SSP = OFF_MEMB + (size_t)2560 * 1024 * 2;
constexpr size_t OFF_MSS = OFF_SSP + (size_t)T * 16 * 4;
constexpr size_t OFF_BAR = OFF_MSS + (size_t)2560 * 16 * 4;
constexpr size_t WS_NEED = OFF_BAR + 4096;

DI unsigned pk2(float a, float b) { f32x2 v = {a, b}; return __builtin_bit_cast(unsigned, __builtin_convertvector(v, bf2_t)); }
DI bf16_t bf1(float a) { return (bf16_t)(pk2(a, 0.f) & 0xffffu); }
DI float bf_lo(unsigned u) { return __uint_as_float(u << 16); }
DI float bf_hi(unsigned u) { return __uint_as_float(u & 0xffff0000u); }
#define MFMA32(a, b, c) __builtin_amdgcn_mfma_f32_32x32x16_bf16((a), (b), (c), 0, 0, 0)
DI int crow(int i, int h) { return (i & 3) + 8 * (i >> 2) + 4 * h; }
DI int tid() { int t = threadIdx.x & 255; asm volatile("" : "+v"(t)); return t; }
DI int tid512() { int t = threadIdx.x; asm volatile("" : "+v"(t)); return t; }
#define VHALF (__builtin_amdgcn_readfirstlane((int)(threadIdx.x >> 8)))
#define VB ((int)(blockIdx.x * 2) + VHALF)
#define NVB ((int)(gridDim.x * 2))
template <int CTRL> DI float dpp(float v) { return __int_as_float(__builtin_amdgcn_update_dpp(0, __float_as_int(v), CTRL, 0xf, 0xf, true)); }
DI float xor16(float v) { return __int_as_float(__builtin_amdgcn_ds_swizzle(__float_as_int(v), 0x401F)); }
typedef unsigned u32x2s __attribute__((ext_vector_type(2)));
DI float pair_max(float v) { const u32x2s r = __builtin_amdgcn_permlane32_swap(__float_as_uint(v), __float_as_uint(v), false, false); return fmaxf(__uint_as_float(r.x), __uint_as_float(r.y)); }
DI float pair_sum(float v) { const u32x2s r = __builtin_amdgcn_permlane32_swap(__float_as_uint(v), __float_as_uint(v), false, false); return __uint_as_float(r.x) + __uint_as_float(r.y); }
DI float xor32(float v, int) { const unsigned b = __float_as_uint(v); const u32x2s r = __builtin_amdgcn_permlane32_swap(b, b, false, false); return __uint_as_float(r.x ^ r.y ^ b); }
DI float row_sum(float v) { v += dpp<0xB1>(v); v += dpp<0x4E>(v); v += dpp<0x141>(v); v += dpp<0x140>(v); return v; }
DI float wave_sum(float v, int) { v = row_sum(v); v += xor16(v); return pair_sum(v); }
DI float rdlane_f(float v, int l) { return __int_as_float(__builtin_amdgcn_readlane(__float_as_int(v), l)); }

DI float rstd_from_ssq(const float* ssq16);
constexpr int VSMEM = 74240;
constexpr int SMEM_BYTES = 2 * VSMEM;

template <int D, class F>
DI void attn_tile(const bf16_t* Ks, const bf16_t* Vs, const bf16x8 (&qf)[D / 16], f32x16 (&o)[D / 32], float& m, float& l, F fn, int r, int h, int lane) {
  f32x16 s;
#pragma unroll
  for (int i = 0; i < 16; ++i) s[i] = 0.f;
#pragma unroll
  for (int ks = 0; ks < D / 16; ++ks) { const bf16x8 a = *(const bf16x8*)(Ks + r * (D + 8) + 16 * ks + 8 * h); s = MFMA32(a, qf[ks], s); }
  float mx = -INFINITY;
#pragma unroll
  for (int i = 0; i < 16; ++i) { s[i] = fn(s[i], i); mx = fmaxf(mx, s[i]); }
  mx = pair_max(mx);
  const float mn = fmaxf(m, mx);
  const float alpha = __builtin_amdgcn_exp2f(m - mn);
  m = mn;
  float sum = 0.f;
#pragma unroll
  for (int i = 0; i < 16; ++i) { s[i] = __builtin_amdgcn_exp2f(s[i] - mn); sum += s[i]; }
  l = l * alpha + sum;
  if (__builtin_amdgcn_ballot_w64(alpha != 1.0f)) {
#pragma unroll
    for (int dt = 0; dt < D / 32; ++dt)
#pragma unroll
      for (int i = 0; i < 16; ++i) o[dt][i] *= alpha;
  }
  bf16x8 pf[2];
#pragma unroll
  for (int s2 = 0; s2 < 2; ++s2) {
    u32x4 pk = {pk2(s[8 * s2], s[8 * s2 + 1]), pk2(s[8 * s2 + 2], s[8 * s2 + 3]), pk2(s[8 * s2 + 4], s[8 * s2 + 5]), pk2(s[8 * s2 + 6], s[8 * s2 + 7])};
    pf[s2] = __builtin_bit_cast(bf16x8, pk);
  }
  constexpr int VP = (D == 64) ? 96 : 160;
  const int gi = lane & 15;
  const bf16_t* vbase = Vs + (4 * h + (gi >> 2)) * VP + 16 * ((lane >> 4) & 1) + 4 * (gi & 3);
#pragma unroll
  for (int dt = 0; dt < D / 32; ++dt)
#pragma unroll
    for (int s2 = 0; s2 < 2; ++s2) {
      const s16x4 lo = __builtin_amdgcn_ds_read_tr16_b64_v4i16((lds_s16x4*)(vbase + (16 * s2) * VP + 32 * dt));
      const s16x4 hi = __builtin_amdgcn_ds_read_tr16_b64_v4i16((lds_s16x4*)(vbase + (16 * s2 + 8) * VP + 32 * dt));
      const bf16x8 a = __builtin_shufflevector(lo, hi, 0, 1, 2, 3, 4, 5, 6, 7);
      o[dt] = MFMA32(a, pf[s2], o[dt]);
    }
}
template <int ND>
DI void attn_out(const f32x16 (&o)[ND], float l, bf16_t* yp, int h, int lane) {
  const float lt = pair_sum(l);
  const float inv = 1.0f / lt;
#pragma unroll
  for (int dt = 0; dt < ND; ++dt)
#pragma unroll
    for (int g = 0; g < 4; ++g) {
      u32x2 v = {pk2(o[dt][4 * g] * inv, o[dt][4 * g + 1] * inv), pk2(o[dt][4 * g + 2] * inv, o[dt][4 * g + 3] * inv)};
      *(u32x2*)(yp + 32 * dt + 8 * g + 4 * h) = v;
    }
}

constexpr int AT64_BUF = 32 * 72 + 32 * 96;
DI void swa_item(const Params& p, int l, int item, unsigned char* smem) {
  const int t = tid(), lane = t & 63, w = t >> 6, r = lane & 31, h = lane >> 5;
  const int head = item % 6, n = (item / 6) & 63, b = item / 384, hkv = head / 3;
  bf16_t* st = (bf16_t*)smem;
  float* bt = (float*)(smem + 2 * AT64_BUF * 2);
  __syncthreads();
  for (int i = t; i < 321; i += 256) { const int o = i - 32; bt[i] = (o >= 0 && o <= 256) ? p.t5_bias[T5TAB[o] * 6 + head] * LOG2E : -INFINITY; }
  const size_t tok0 = (size_t)b * SEQ;
  const int q0 = n * 128 + 32 * w;
  bf16x8 qf[4];
  { const bf16_t* qp = ((bf16_t*)(p.ws + OFF_Z)) + (tok0 + q0 + r) * IN_DIM + Z_SWQ + head * 64 + 8 * h;
#pragma unroll
    for (int ks = 0; ks < 4; ++ks) qf[ks] = *(const bf16x8*)(qp + 16 * ks); }
  f32x16 o[2];
#pragma unroll
  for (int dt = 0; dt < 2; ++dt)
#pragma unroll
    for (int i = 0; i < 16; ++i) o[dt][i] = 0.f;
  float m = p.swa_sink[l * 6 + head] * LOG2E, lsum = (h == 0) ? 1.f : 0.f;
  const int kt_lo = (n == 0) ? 4 : 0, kt_hi = (n == 63) ? 8 : 12;
  const int kk = t >> 3, c8 = t & 7;
  const bf16_t* kbase = ((bf16_t*)(p.ws + OFF_Z)) + (tok0 + (size_t)(n * 128 + kk)) * IN_DIM + Z_SWK + hkv * 64 + 8 * c8;
  u32x4 kr = {0, 0, 0, 0}, vr = {0, 0, 0, 0};
  if (kt_lo == 0) { const bf16_t* kp = kbase + (ptrdiff_t)(-128) * IN_DIM; kr = *(const u32x4*)kp; vr = *(const u32x4*)(kp + 128);
    *(u32x4*)(st + kk * 72 + 8 * c8) = kr; *(u32x4*)(st + 32 * 72 + kk * 96 + 8 * c8) = vr; }
  __syncthreads();
  const float sc2 = 0.125f * LOG2E;
  for (int kt = 0; kt < 12; ++kt) {
    const int cur = kt & 1;
    const bool nxt = (kt + 1 >= kt_lo) && (kt + 1 < kt_hi);
    if (nxt) { const bf16_t* kp = kbase + (ptrdiff_t)(32 * (kt + 1) - 128) * IN_DIM; kr = *(const u32x4*)kp; vr = *(const u32x4*)(kp + 128); }
    if (kt >= kt_lo && kt < kt_hi && kt >= w && kt <= w + 8) {
      const float* bp = bt + 32 + 128 + (32 * kt - 128 - 32 * w - r + 4 * h);
      attn_tile<64>(st + cur * AT64_BUF, st + cur * AT64_BUF + 32 * 72, qf, o, m, lsum,
        [&](float sv, int i) { return sv * sc2 + bp[(i & 3) + 8 * (i >> 2)]; }, r, h, lane);
    }
    if (nxt) { bf16_t* sb = st + (cur ^ 1) * AT64_BUF; *(u32x4*)(sb + kk * 72 + 8 * c8) = kr; *(u32x4*)(sb + 32 * 72 + kk * 96 + 8 * c8) = vr; }
    __syncthreads();
  }
  attn_out<2>(o, lsum, ((bf16_t*)(p.ws + OFF_YMIX)) + (tok0 + q0 + r) * DM + 640 + head * 64, h, lane);
}

DI void na_item(const Params& p, int l, int item, unsigned char* smem) {
  const int t = tid(), lane = t & 63, w = t >> 6, r = lane & 31, h = lane >> 5;
  const int hp = item % 3, rr = (item / 3) & 127, b = item / 384;
  const int hh = w >> 1, qh = w & 1, head = 2 * hp + hh;
  bf16_t* st = (bf16_t*)smem;
  constexpr int NBUF = 2 * AT64_BUF;
  float* bt = (float*)(smem + 2 * NBUF * 2);
  __syncthreads();
  for (int i = t; i < 930; i += 256) { const int e = i % 465, hsel = i / 465; bt[hsel * 576 + 40 + e] = p.na_rpb[((size_t)l * 465 + e) * 6 + 2 * hp + hsel] * LOG2E; }
  const size_t tok0 = (size_t)b * SEQ;
  const int r0 = min(max(rr - 4, 0), 120);
  const int c = 32 * qh + r;
  bf16x8 qf[4];
  { const bf16_t* qp = ((bf16_t*)(p.ws + OFF_Z)) + (tok0 + rr * 64 + c) * IN_DIM + Z_NAQ + head * 64 + 8 * h;
#pragma unroll
    for (int ks = 0; ks < 4; ++ks) qf[ks] = *(const bf16x8*)(qp + 16 * ks); }
  f32x16 o[2];
#pragma unroll
  for (int dt = 0; dt < 2; ++dt)
#pragma unroll
    for (int i = 0; i < 16; ++i) o[dt][i] = 0.f;
  float m = -1e30f, lsum = 0.f;
  const int kk = t >> 3, c8 = t & 7;
  const bf16_t* kbase = ((bf16_t*)(p.ws + OFF_Z)) + (tok0 + (size_t)((r0 + (kk >> 4)) * 64 + (kk & 15))) * IN_DIM + Z_NAK + (2 * hp) * 64 + 8 * c8;
  u32x4 k0r, k1r, v0r, v1r;
#define NA_LDG(kt) { const bf16_t* kp = kbase + (size_t)(((kt) >> 2) * 128 + ((kt) & 3) * 16) * IN_DIM; \
    k0r = *(const u32x4*)kp; k1r = *(const u32x4*)(kp + 64); v0r = *(const u32x4*)(kp + 384); v1r = *(const u32x4*)(kp + 448); }
#define NA_STS(buf) { bf16_t* sb = st + (buf) * NBUF; *(u32x4*)(sb + kk * 72 + 8 * c8) = k0r; *(u32x4*)(sb + AT64_BUF + kk * 72 + 8 * c8) = k1r; \
    *(u32x4*)(sb + 32 * 72 + kk * 96 + 8 * c8) = v0r; *(u32x4*)(sb + AT64_BUF + 32 * 72 + kk * 96 + 8 * c8) = v1r; }
  NA_LDG(0);
  NA_STS(0);
  __syncthreads();
  const float sc2 = 0.125f * LOG2E;
  const int c0 = min(max(c - 8, 0), 48);
  const float* bth = bt + hh * 576 + 40;
  for (int kt = 0; kt < 16; ++kt) {
    const int cur = kt & 1;
    if (kt + 1 < 16) NA_LDG(kt + 1);
    const int rp = kt >> 2, cb = kt & 3;
    if (cb >= qh && cb <= qh + 2) {
      const bf16_t* sb = st + cur * NBUF + hh * AT64_BUF;
      const float* bp = bth + (r0 + 2 * rp - rr + 7) * 31 + (16 * cb + 4 * h - c + 15);
      const int vb = 16 * cb + 4 * h - c0;
      attn_tile<64>(sb, sb + 32 * 72, qf, o, m, lsum,
        [&](float sv, int i) { const int cc = (i & 3) + 8 * ((i >> 2) & 1); const bool ok = (unsigned)(vb + cc) < 16u;
          const float lg = sv * sc2 + bp[(i >> 3) * 31 + cc]; return ok ? lg : -INFINITY; }, r, h, lane);
    }
    if (kt + 1 < 16) NA_STS(cur ^ 1);
    __syncthreads();
  }
#undef NA_LDG
#undef NA_STS
  attn_out<2>(o, lsum, ((bf16_t*)(p.ws + OFF_YMIX)) + (tok0 + rr * 64 + c) * DM + head * 64, h, lane);
}

DI void conv_item(const Params& p, int l, int item) {
  const int t = tid();
  const size_t tok = (size_t)item * 8 + (t >> 5);
  const int c8 = t & 31, pos = (int)(tok & (SEQ - 1));
  const bf16_t* zr = ((bf16_t*)(p.ws + OFF_Z)) + tok * IN_DIM + 8 * c8;
  const u32x4 bv = *(const u32x4*)(zr + Z_SCB);
  const u32x4 cc = *(const u32x4*)(zr + Z_SCC), hc = *(const u32x4*)(zr + Z_SCH);
  u32x4 cm = {0, 0, 0, 0}, hm = {0, 0, 0, 0}, cp = {0, 0, 0, 0}, hpv = {0, 0, 0, 0};
  if (pos > 0) { cm = *(const u32x4*)(zr - IN_DIM + Z_SCC); hm = *(const u32x4*)(zr - IN_DIM + Z_SCH); }
  if (pos < SEQ - 1) { cp = *(const u32x4*)(zr + IN_DIM + Z_SCC); hpv = *(const u32x4*)(zr + IN_DIM + Z_SCH); }
  const float* cw = p.conv_w + (size_t)l * 3 * 256 + 8 * c8;
  float y[8];
#pragma unroll
  for (int e = 0; e < 8; ++e) {
    const int wd = e >> 1;
    const float fb = (e & 1) ? bf_hi(bv[wd]) : bf_lo(bv[wd]);
    const float um = ((e & 1) ? bf_hi(cm[wd]) : bf_lo(cm[wd])) * ((e & 1) ? bf_hi(hm[wd]) : bf_lo(hm[wd]));
    const float uc = ((e & 1) ? bf_hi(cc[wd]) : bf_lo(cc[wd])) * ((e & 1) ? bf_hi(hc[wd]) : bf_lo(hc[wd]));
    const float up = ((e & 1) ? bf_hi(cp[wd]) : bf_lo(cp[wd])) * ((e & 1) ? bf_hi(hpv[wd]) : bf_lo(hpv[wd]));
    y[e] = fb * (um * cw[e] + uc * cw[256 + e] + up * cw[512 + e]);
  }
  u32x4 ov = {pk2(y[0], y[1]), pk2(y[2], y[3]), pk2(y[4], y[5]), pk2(y[6], y[7])};
  *(u32x4*)(((bf16_t*)(p.ws + OFF_YMIX)) + tok * DM + 384 + 8 * c8) = ov;
}

constexpr int AT128_BUF = 32 * 136 + 32 * 160;
DI void xattn_item(const Params& p, int l, int item, unsigned char* smem) {
  const int t = tid(), lane = t & 63, w = t >> 6, r = lane & 31, h = lane >> 5;
  const int qt = item & 63, head = (item >> 6) & 3, b = item >> 8;
  bf16_t* st = (bf16_t*)smem;
  const size_t tok = (size_t)b * SEQ + qt * 128 + 32 * w + r;
  bf16x8 qf[8];
  { const bf16_t* qp = ((bf16_t*)(p.ws + OFF_Q)) + tok * 512 + head * 128 + 8 * h;
#pragma unroll
    for (int ks = 0; ks < 8; ++ks) qf[ks] = *(const bf16x8*)(qp + 16 * ks); }
  f32x16 o[4];
#pragma unroll
  for (int dt = 0; dt < 4; ++dt)
#pragma unroll
    for (int i = 0; i < 16; ++i) o[dt][i] = 0.f;
  float m = -1e30f, lsum = 0.f;
  const int kk = t >> 4, c8 = t & 15;
  const bf16_t* kbase = ((bf16_t*)(p.ws + OFF_MEMKV)) + ((size_t)b * 256 + kk) * 2048 + (size_t)l * 1024 + head * 128 + 8 * c8;
  u32x4 k0r, k1r, v0r, v1r;
#define XA_LDG(kt) { const bf16_t* kp = kbase + (size_t)(32 * (kt)) * 2048; \
    k0r = *(const u32x4*)kp; k1r = *(const u32x4*)(kp + 16 * 2048); v0r = *(const u32x4*)(kp + 512); v1r = *(const u32x4*)(kp + 16 * 2048 + 512); }
#define XA_STS(buf) { bf16_t* sb = st + (buf) * AT128_BUF; *(u32x4*)(sb + kk * 136 + 8 * c8) = k0r; *(u32x4*)(sb + (kk + 16) * 136 + 8 * c8) = k1r; \
    *(u32x4*)(sb + 32 * 136 + kk * 160 + 8 * c8) = v0r; *(u32x4*)(sb + 32 * 136 + (kk + 16) * 160 + 8 * c8) = v1r; }
  __syncthreads();
  XA_LDG(0);
  XA_STS(0);
  __syncthreads();
  const float sc2 = 0.08838834764831845f * LOG2E;
  for (int kt = 0; kt < 8; ++kt) {
    const int cur = kt & 1;
    if (kt + 1 < 8) XA_LDG(kt + 1);
    { const bf16_t* sb = st + cur * AT128_BUF;
      attn_tile<128>(sb, sb + 32 * 136, qf, o, m, lsum, [&](float sv, int) { return sv * sc2; }, r, h, lane); }
    if (kt + 1 < 8) XA_STS(cur ^ 1);
    __syncthreads();
  }
#undef XA_LDG
#undef XA_STS
  attn_out<4>(o, lsum, ((bf16_t*)(p.ws + OFF_O)) + tok * 512 + head * 128, h, lane);
}

template <bool REV>
DI void transpose_job(const float* __restrict__ src, int K, int N, const float* __restrict__ g, bf16_t* __restrict__ dst, unsigned char* smem) {
  float* tl = (float*)smem;
  const int tn = N / 64, ntile = (K / 64) * tn, t = tid();
  for (int tile = REV ? NVB - 1 - VB : VB; tile < ntile; tile += NVB) {
    const int k0 = (tile / tn) * 64, n0 = (tile % tn) * 64;
    __syncthreads();
#pragma unroll 4
    for (int i = 0; i < 16; ++i) { const int kk = (t >> 6) + 4 * i; float v = src[(size_t)(k0 + kk) * N + n0 + (t & 63)]; if (g) v *= g[k0 + kk]; tl[kk * 65 + (t & 63)] = v; }
    __syncthreads();
#pragma unroll 4
    for (int i = 0; i < 16; ++i) { const int nn = (t >> 6) + 4 * i; dst[(size_t)(n0 + nn) * K + k0 + (t & 63)] = bf1(tl[(t & 63) * 65 + nn]); }
  }
}
DI void convert_job(const float* __restrict__ src, bf16_t* __restrict__ dst, size_t n4) {
  for (size_t i = (size_t)VB * 256 + tid(); i < n4; i += (size_t)NVB * 256) {
    const f32x4 v = ((const f32x4*)src)[i];
    u32x2 o = {pk2(v.x, v.y), pk2(v.z, v.w)};
    ((u32x2*)dst)[i] = o;
  }
}

constexpr float F8_SCALE = 64.0f, F8_INV = 1.0f / 64.0f;
DI unsigned pk4_fp8(f32x4 v) {
  int w = 0;
  w = __builtin_amdgcn_cvt_pk_fp8_f32(v.x * F8_SCALE, v.y * F8_SCALE, w, false);
  w = __builtin_amdgcn_cvt_pk_fp8_f32(v.z * F8_SCALE, v.w * F8_SCALE, w, true);
  return (unsigned)w;
}
DI void convert_fp8_job(const float* __restrict__ src, unsigned char* __restrict__ dst, size_t n16) {
  const size_t st = (size_t)NVB * 256;
  for (size_t i0 = (size_t)VB * 256 + tid(); i0 < n16; i0 += 4 * st) {
    f32x4 v[4][4];
#pragma unroll
    for (int q = 0; q < 4; ++q) { const size_t i = i0 + q * st; if (i < n16) { const f32x4* s = (const f32x4*)src + 4 * i;
#pragma unroll
        for (int k = 0; k < 4; ++k) v[q][k] = s[k]; } }
#pragma unroll
    for (int q = 0; q < 4; ++q) { const size_t i = i0 + q * st; if (i < n16) { u32x4 o = {pk4_fp8(v[q][0]), pk4_fp8(v[q][1]), pk4_fp8(v[q][2]), pk4_fp8(v[q][3])}; ((u32x4*)dst)[i] = o; } }
  }
}

DI void phase_prologue(const Params& p, unsigned char* smem) {
  { const int t = tid(), lane = t & 63, wid = t >> 6;
    const int NR = T + 2560, rst = NVB * 4;
    for (int row0 = VB * 4 + wid; row0 < NR; row0 += 2 * rst) {
      f32x4 v[2][4];
#pragma unroll
      for (int q = 0; q < 2; ++q) {
        const int row = row0 + q * rst;
        if (row < NR) {
          const int mr = row - T;
          const float* s = (row < T) ? ((row < 16384) ? p.x_prompt + (size_t)row * DM : p.x_sample + (size_t)(row - 16384) * DM)
                                     : ((mr < 512) ? p.mem_prompt + (size_t)mr * DM : p.mem_sample + (size_t)(mr - 512) * DM);
#pragma unroll
          for (int k = 0; k < 4; ++k) v[q][k] = *(const f32x4*)(s + 16 * lane + 4 * k);
        }
      }
#pragma unroll
      for (int q = 0; q < 2; ++q) {
        const int row = row0 + q * rst;
        if (row < NR) {
          const bool isx = row < T;
          const int mr = row - T;
          float ss = 0.f;
#pragma unroll
          for (int k = 0; k < 4; ++k) ss += (v[q][k].x * v[q][k].x + v[q][k].y * v[q][k].y) + (v[q][k].z * v[q][k].z + v[q][k].w * v[q][k].w);
          ss = wave_sum(ss, lane);
          u32x4 b0 = {pk2(v[q][0].x, v[q][0].y), pk2(v[q][0].z, v[q][0].w), pk2(v[q][1].x, v[q][1].y), pk2(v[q][1].z, v[q][1].w)};
          u32x4 b1 = {pk2(v[q][2].x, v[q][2].y), pk2(v[q][2].z, v[q][2].w), pk2(v[q][3].x, v[q][3].y), pk2(v[q][3].z, v[q][3].w)};
          bf16_t* bd = (isx ? (bf16_t*)(p.ws + OFF_XB) + (size_t)row * DM : (bf16_t*)(p.ws + OFF_MEMB) + (size_t)mr * DM) + 16 * lane;
          *(u32x4*)bd = b0; *(u32x4*)(bd + 8) = b1;
          if (lane < 4) { f32x4 sv = {lane == 0 ? ss : 0.f, 0.f, 0.f, 0.f}; *(f32x4*)((isx ? (float*)(p.ws + OFF_SSP) + (size_t)row * 16 : (float*)(p.ws + OFF_MSS) + (size_t)mr * 16) + 4 * lane) = sv; }
        }
      }
    } }
  for (int l = 0; l < 2; ++l) {
    transpose_job<false>(p.w_in + (size_t)l * 1024 * 2560, 1024, 2560, p.norm_mix_g + l * 1024, ((bf16_t*)(p.ws + OFF_WIN)) + (size_t)l * 2560 * 1024, smem);
    transpose_job<true>(p.w_out + (size_t)l * 1024 * 1024, 1024, 1024, nullptr, ((bf16_t*)(p.ws + OFF_WOUT)) + (size_t)l * 1024 * 1024, smem);
    transpose_job<false>(p.w_xq + (size_t)l * 1024 * 512, 1024, 512, p.norm_xa_g + l * 1024, ((bf16_t*)(p.ws + OFF_WXQ)) + (size_t)l * 512 * 1024, smem);
    transpose_job<true>(p.w_xk + (size_t)l * 1024 * 512, 1024, 512, p.norm_mem_g + l * 1024, ((bf16_t*)(p.ws + OFF_WXKV)) + (size_t)l * 1024 * 1024, smem);
    transpose_job<false>(p.w_xv + (size_t)l * 1024 * 512, 1024, 512, p.norm_mem_g + l * 1024, ((bf16_t*)(p.ws + OFF_WXKV)) + (size_t)l * 1024 * 1024 + (size_t)512 * 1024, smem);
    transpose_job<true>(p.w_xo + (size_t)l * 512 * 1024, 512, 1024, nullptr, ((bf16_t*)(p.ws + OFF_WXO)) + (size_t)l * 1024 * 512, smem);
    transpose_job<false>(p.peer_wq + (size_t)l * 1024 * 2048, 1024, 2048, p.norm_ffn_g + l * 1024, ((bf16_t*)(p.ws + OFF_WPQ)) + (size_t)l * 2048 * 1024, smem);
  }
  convert_job(p.peer_subkeys, ((bf16_t*)(p.ws + OFF_SUBK)), (size_t)2 * 8 * 2 * 128 * 128 / 4);
  convert_fp8_job(p.peer_u, (unsigned char*)(p.ws + OFF_PU), (size_t)2 * 16384 * 1024 / 16);
  convert_fp8_job(p.peer_v, (unsigned char*)(p.ws + OFF_PV), (size_t)2 * 16384 * 1024 / 16);
}

namespace pg8 {
#define PG8_LAS __attribute__((address_space(3)))
typedef unsigned short bf16_t;
typedef short bf16x8 __attribute__((ext_vector_type(8)));
typedef float f32x4 __attribute__((ext_vector_type(4)));
typedef unsigned u32x4 __attribute__((ext_vector_type(4)));
constexpr int BM = 256, BK = 64, HALF = 128, HTB = HALF * BK * 2  , STAGE_BYTES = 8 * HTB, NXCD = 8, WGM = 8;

__host__ __device__ __forceinline__ int lds_byte(int r, int c) { const int st = (r >> 4) * 2 + (c >> 5), rr = r & 15, cc = c & 31, ob = rr * 64 + cc * 2; return st * 1024 + (ob ^ (((ob >> 9) & 1) << 5)); }
__host__ __device__ __forceinline__ void stage_rc(int b, int& R, int& C) { const int st = b / 1024, sb = b % 1024, swz = sb ^ (((sb >> 9) & 1) << 5); R = (st >> 1) * 16 + swz / 64; C = (st & 1) * 32 + (swz % 64) / 2; }
__host__ __device__ __forceinline__ int perm32(int rho) { const int n = rho >> 4, i = rho & 15; return 8 * (i >> 2) + 4 * n + (i & 3); }

struct Unit { int pm, pn; };
struct Gemm { const bf16_t* A; const bf16_t* Bt; int M, N, K; };

struct StaticOrder {
    int nM, nN, nwg, G, c;
    __host__ __device__ void init(int M, int N, int G_, int c_) { nM = M / BM; nN = N / BM; nwg = nM * nN; G = G_; c = c_; }
    __host__ __device__ bool next(int i, Unit& u) const {
        const long L = (long)i * G + c; if (L >= nwg) return false;
        int wgid = (int)L; { const int q = nwg / NXCD, r = nwg % NXCD, xcd = wgid % NXCD, off = wgid / NXCD; wgid = (xcd < r ? xcd * (q + 1) : r * (q + 1) + (xcd - r) * q) + off; }
        const int nig = WGM * nN, gid = wgid / nig, fm = gid * WGM, gsz = (nM - fm) < WGM ? (nM - fm) : WGM;
        u.pm = fm + ((wgid % nig) % gsz); u.pn = (wgid % nig) / gsz; return true;
    }
    __device__ __forceinline__ void a_ready(const Unit&) const {}
    __device__ __forceinline__ void done(const Unit&) const {}
};

template <class Epi, class Sched, bool STAMP = false>
__device__ __forceinline__ void gemm_phase(PG8_LAS unsigned char* lds, const Gemm g, const Sched& S, const Epi& E, unsigned long long* stamps) {
    const int tid = ::tid512(), wid = __builtin_amdgcn_readfirstlane(tid >> 6), lane = tid & 63, wr = wid >> 2, wc = wid & 3, fr = lane & 15, fq = lane >> 4;
    const int K = g.K, nt = K / BK;
    int ts_lo = 0, ts_hi = 0, nts = 0; const unsigned long long rt_entry = STAMP ? (unsigned long long)wall_clock64() : 0ull;
#define PG8_STAMP() do { if (STAMP && wid == 0 && nts < 64) { const unsigned long long _c = (unsigned long long)clock64(); \
        ts_lo = (lane == nts) ? (int)(unsigned)_c : ts_lo; ts_hi = (lane == nts) ? (int)(unsigned)(_c >> 32) : ts_hi; ++nts; } } while (0)
    PG8_STAMP();
    unsigned voffA[2], voffB[2];
#pragma unroll
    for (int i = 0; i < 2; ++i) { int R, C; stage_rc(tid * 16 + i * 8192, R, C); const int Rb = Epi::PERM ? ((R & ~31) + perm32(R & 31)) : R;
        voffA[i] = (unsigned)(R * K + C) * 2u; voffB[i] = (unsigned)(Rb * K + C) * 2u; }
    const size_t kstep = (size_t)(BK * 2);
    const size_t hstep = (size_t)HALF * K * 2;
    const size_t tstep = 2 * hstep;
    const unsigned ldsw = (unsigned)wid * 1024u;
    const int aoff = lds_byte(wr * 64 + fr, fq * 8), boff = lds_byte(wc * 32 + fr, fq * 8);
#define PG8_SA(b, h) (((b) * 2 + (h)) * HTB)
#define PG8_SB(b, h) ((4 + (b) * 2 + (h)) * HTB)
#define PG8_STAGE(bufoff, gbase, voff) do { _Pragma("unroll") for (int _i = 0; _i < 2; ++_i) \
        __builtin_amdgcn_global_load_lds((const unsigned*)((const char*)(gbase) + (voff)[_i]), (PG8_LAS unsigned*)(lds + (bufoff) + ldsw + _i * 8192), 16, 0, 0); } while (0)
#define PG8_LDA(dst, b, h) do { _Pragma("unroll") for (int m = 0; m < 4; ++m) _Pragma("unroll") for (int k = 0; k < 2; ++k) dst[m][k] = *(const PG8_LAS bf16x8*)(lds + PG8_SA(b, h) + aoff + m * 2048 + k * 1024); } while (0)
#define PG8_LDB(dst, b, h) do { _Pragma("unroll") for (int n = 0; n < 2; ++n) _Pragma("unroll") for (int k = 0; k < 2; ++k) dst[n][k] = *(const PG8_LAS bf16x8*)(lds + PG8_SB(b, h) + boff + n * 2048 + k * 1024); } while (0)
#define PG8_MMA(ai, bj, At, Bt) do { __builtin_amdgcn_s_setprio(1); _Pragma("unroll") for (int m = 0; m < 4; ++m) _Pragma("unroll") for (int n = 0; n < 2; ++n) _Pragma("unroll") for (int k = 0; k < 2; ++k) \
        acc[ai][bj][m][n] = __builtin_amdgcn_mfma_f32_16x16x32_bf16(Bt[n][k], At[m][k], acc[ai][bj][m][n], 0, 0, 0); __builtin_amdgcn_s_setprio(0); } while (0)
#define PG8_WAIT_V(n) asm volatile("s_waitcnt vmcnt(" #n ")" ::: "memory")
#define PG8_WAIT_L(n) asm volatile("s_waitcnt lgkmcnt(" #n ")" ::: "memory")
#define PG8_BAR __builtin_amdgcn_s_barrier()
#define PG8_SCHED __builtin_amdgcn_sched_barrier(0)
    Unit cur, nxt; int ui = 0;
    if (!S.next(0, cur)) return;
    f32x4 acc[2][2][4][2];
#pragma unroll
    for (int a = 0; a < 2; ++a)
#pragma unroll
        for (int b = 0; b < 2; ++b)
#pragma unroll
            for (int m = 0; m < 4; ++m)
#pragma unroll
                for (int n = 0; n < 2; ++n) acc[a][b][m][n] = (f32x4){0.f, 0.f, 0.f, 0.f};
    bf16x8 At[4][2], B0[2][2], B1[2][2];
    const char* cA = (const char*)g.A + (size_t)cur.pm * tstep; const char* cB = (const char*)g.Bt + (size_t)cur.pn * tstep;
    S.a_ready(cur);
    PG8_STAGE(PG8_SB(0, 0), cB, voffB); PG8_STAGE(PG8_SA(0, 0), cA, voffA); PG8_STAGE(PG8_SB(0, 1), cB + hstep, voffB); PG8_STAGE(PG8_SA(0, 1), cA + hstep, voffA);
    if (wr == 1) PG8_BAR;
    PG8_WAIT_V(4); PG8_BAR;
    PG8_STAGE(PG8_SB(1, 0), cB + kstep, voffB); PG8_STAGE(PG8_SA(1, 0), cA + kstep, voffA); PG8_STAGE(PG8_SB(1, 1), cB + hstep + kstep, voffB);
    PG8_WAIT_V(6); PG8_BAR;
    PG8_STAMP();
    for (;;) {
        const bool has_next = S.next(ui + 1, nxt);
        const char* nA = has_next ? (const char*)g.A + (size_t)nxt.pm * tstep : cA; const char* nB = has_next ? (const char*)g.Bt + (size_t)nxt.pn * tstep : cB;
        for (int t = 0; t < nt; t += 2) {
            const bool last = (t == nt - 2);
            const char* a1 = cA + (size_t)(t + 1) * kstep;
            const char* a2 = last ? nA : cA + (size_t)(t + 2) * kstep; const char* b2 = last ? nB : cB + (size_t)(t + 2) * kstep;
            const char* a3 = a2 + kstep; const char* b3 = b2 + kstep;
            if (last && has_next) S.a_ready(nxt);
            PG8_LDB(B0, 0, 0); PG8_SCHED; PG8_LDA(At, 0, 0); PG8_STAGE(PG8_SA(1, 1), a1 + hstep, voffA);
            PG8_WAIT_L(8); PG8_BAR; PG8_WAIT_L(0); PG8_MMA(0, 0, At, B0); PG8_BAR; PG8_SCHED;
            PG8_LDB(B1, 0, 1); PG8_STAGE(PG8_SB(0, 0), b2, voffB);
            PG8_BAR; PG8_WAIT_L(0); PG8_MMA(0, 1, At, B1); PG8_BAR;
            PG8_LDA(At, 0, 1); PG8_STAGE(PG8_SA(0, 0), a2, voffA);
            PG8_BAR; PG8_WAIT_L(0); PG8_MMA(1, 0, At, B0); PG8_BAR; PG8_SCHED;
            PG8_STAGE(PG8_SB(0, 1), b2 + hstep, voffB);
            PG8_WAIT_V(6); PG8_BAR; PG8_MMA(1, 1, At, B1); PG8_BAR;
            PG8_LDB(B0, 1, 0); PG8_SCHED; PG8_LDA(At, 1, 0); PG8_STAGE(PG8_SA(0, 1), a2 + hstep, voffA);
            PG8_WAIT_L(8); PG8_BAR; PG8_WAIT_L(0); PG8_MMA(0, 0, At, B0); PG8_BAR; PG8_SCHED;
            PG8_LDB(B1, 1, 1); PG8_STAGE(PG8_SB(1, 0), b3, voffB);
            PG8_BAR; PG8_WAIT_L(0); PG8_MMA(0, 1, At, B1); PG8_BAR;
            PG8_LDA(At, 1, 1); PG8_STAGE(PG8_SA(1, 0), a3, voffA);
            PG8_BAR; PG8_WAIT_L(0); PG8_MMA(1, 0, At, B0); PG8_BAR; PG8_SCHED;
            PG8_STAGE(PG8_SB(1, 1), b3 + hstep, voffB);
            PG8_WAIT_V(6); PG8_BAR; PG8_MMA(1, 1, At, B1); PG8_BAR;
        }
        PG8_STAMP();
        if constexpr (!Epi::AFTER_DRAIN) { E(acc, cur, wr, wc, fr, fq); S.done(cur); }
        PG8_STAMP();
        if (!has_next) break;
#pragma unroll
        for (int a = 0; a < 2; ++a)
#pragma unroll
            for (int b = 0; b < 2; ++b)
#pragma unroll
                for (int m = 0; m < 4; ++m)
#pragma unroll
                    for (int n = 0; n < 2; ++n) acc[a][b][m][n] = (f32x4){0.f, 0.f, 0.f, 0.f};
        cur = nxt; cA = nA; cB = nB; ++ui;
    }
    PG8_WAIT_V(0);
    if (wr == 0) PG8_BAR;
    PG8_BAR;
    if constexpr (Epi::AFTER_DRAIN) { E.fused(acc, cur, wr, wc, fr, fq, lds, wid, lane); S.done(cur); }
    PG8_STAMP();
    if (STAMP && wid == 0) { stamps[lane] = lane < nts ? (((unsigned long long)(unsigned)ts_hi << 32) | (unsigned)ts_lo) : 0ull;
        if (lane == 62) stamps[62] = rt_entry; if (lane == 63) stamps[63] = (unsigned long long)wall_clock64(); }
#undef PG8_STAMP
#undef PG8_SA
#undef PG8_SB
#undef PG8_STAGE
#undef PG8_LDA
#undef PG8_LDB
#undef PG8_MMA
#undef PG8_WAIT_V
#undef PG8_WAIT_L
#undef PG8_BAR
#undef PG8_SCHED
}
}

DI float rstd_from_ssq(const float* ssq16) {
  const f32x4* sp = (const f32x4*)ssq16; const f32x4 a = sp[0], b = sp[1], c = sp[2], d = sp[3];
  const float s = ((a.x + a.y) + (a.z + a.w)) + ((b.x + b.y) + (b.z + b.w)) + ((c.x + c.y) + (c.z + c.w)) + ((d.x + d.y) + (d.z + d.w));
  return rsqrtf(s * (1.0f / 1024.0f) + RMS_EPS);
}
struct EpiScaledBf16 {
  static constexpr bool PERM = true, AFTER_DRAIN = false;
  bf16_t* O; int ldc; const float* ssq;
  __device__ __forceinline__ void operator()(const f32x4 (&acc)[2][2][4][2], const pg8::Unit& u, int wr, int wc, int fr, int fq) const {
    const int row0 = u.pm * 256 + wr * 64 + fr, col0 = u.pn * 256 + wc * 32 + 8 * fq;
    float rsv[2][4];
#pragma unroll
    for (int ai = 0; ai < 2; ++ai)
#pragma unroll
      for (int m = 0; m < 4; ++m) rsv[ai][m] = rstd_from_ssq(ssq + (size_t)(row0 + ai * 128 + m * 16) * 16);
#pragma unroll
    for (int ai = 0; ai < 2; ++ai)
#pragma unroll
      for (int m = 0; m < 4; ++m) {
        const int row = row0 + ai * 128 + m * 16;
        const float rs = rsv[ai][m];
        bf16_t* rowp = O + (size_t)row * ldc + col0;
#pragma unroll
        for (int bj = 0; bj < 2; ++bj) {
          const f32x4 v0 = acc[ai][bj][m][0] * rs, v1 = acc[ai][bj][m][1] * rs;
          u32x4 w = {pk2(v0[0], v0[1]), pk2(v0[2], v0[3]), pk2(v1[0], v1[1]), pk2(v1[2], v1[3])};
          *(u32x4*)(rowp + bj * 128) = w;
        }
      }
  }
};
struct EpiResid {
  static constexpr bool PERM = true, AFTER_DRAIN = false;
  float* X; bf16_t* XB; float* ssq; const float* Xs0; const float* Xs1;
  __device__ __forceinline__ void operator()(const f32x4 (&acc)[2][2][4][2], const pg8::Unit& u, int wr, int wc, int fr, int fq) const {
    const int row0 = u.pm * 256 + wr * 64 + fr, col0 = u.pn * 256 + wc * 32 + 8 * fq;
    const int lane = fr + 16 * fq;
    const float* Xs = (u.pm < 64) ? Xs0 : Xs1;
#pragma unroll
    for (int am = 0; am < 4; ++am) {
      const int ai = am >> 1;
      f32x4 oo[2][2][2];
#pragma unroll
      for (int mm = 0; mm < 2; ++mm) { const float* xs = Xs + (size_t)(row0 + ai * 128 + (2 * (am & 1) + mm) * 16) * DM + col0;
#pragma unroll
        for (int bj = 0; bj < 2; ++bj)
#pragma unroll
          for (int n = 0; n < 2; ++n) oo[mm][bj][n] = *(const f32x4*)(xs + bj * 128 + 4 * n); }
#pragma unroll
      for (int mm = 0; mm < 2; ++mm) {
        const int m = 2 * (am & 1) + mm;
        const int row = row0 + ai * 128 + m * 16;
        float* xr = X + (size_t)row * DM + col0; bf16_t* br = XB + (size_t)row * DM + col0;
        const f32x4 (&o)[2][2] = oo[mm];
        float ss = 0.f;
#pragma unroll
        for (int bj = 0; bj < 2; ++bj) {
          const f32x4 v0 = o[bj][0] + acc[ai][bj][m][0], v1 = o[bj][1] + acc[ai][bj][m][1];
          *(f32x4*)(xr + bj * 128) = v0; *(f32x4*)(xr + bj * 128 + 4) = v1;
          ss += ((v0.x * v0.x + v0.y * v0.y) + (v0.z * v0.z + v0.w * v0.w)) + ((v1.x * v1.x + v1.y * v1.y) + (v1.z * v1.z + v1.w * v1.w));
          u32x4 pk = {pk2(v0.x, v0.y), pk2(v0.z, v0.w), pk2(v1.x, v1.y), pk2(v1.z, v1.w)};
          *(u32x4*)(br + bj * 128) = pk;
        }
        ss += xor16(ss); ss = pair_sum(ss);
        if (fq == 0) ssq[(size_t)row * 16 + 4 * u.pn + wc] = ss;
      }
    }
  }
};
#define TILE_WALK(NT, MT8) const int nx_ = gridDim.x >> 3, xcd_ = blockIdx.x & 7; \
  for (int j_ = blockIdx.x >> 3; j_ < (MT8) * (NT); j_ += nx_) { const int mt = (j_ / (NT)) * 8 + xcd_, nt = j_ % (NT);

DI void run_gemm_scaled(unsigned char* smem, const bf16_t* A, const bf16_t* Bt, int M, int N, int K, bf16_t* O, int ldc, const float* ssq, int crot = 0) {
  pg8::Gemm g{A, Bt, M, N, K};
  pg8::StaticOrder S; S.init(M, N, (int)gridDim.x, (int)((blockIdx.x + crot) % gridDim.x));
  EpiScaledBf16 E{O, ldc, ssq};
  pg8::gemm_phase<EpiScaledBf16, pg8::StaticOrder, false>((PG8_LAS unsigned char*)smem, g, S, E, nullptr);
}
DI void run_gemm_resid(unsigned char* smem, const bf16_t* A, const bf16_t* Bt, int M, int N, int K, float* X, bf16_t* XB, float* ssq, const float* Xs0, const float* Xs1) {
  pg8::Gemm g{A, Bt, M, N, K};
  pg8::StaticOrder S; S.init(M, N, (int)gridDim.x, (int)blockIdx.x);
  EpiResid E{X, XB, ssq, Xs0, Xs1};
  pg8::gemm_phase<EpiResid, pg8::StaticOrder, false>((PG8_LAS unsigned char*)smem, g, S, E, nullptr);
}
DI void phase_in_gemm(const Params& p, int l, unsigned char* smem) {
  run_gemm_scaled(smem, (const bf16_t*)(p.ws + OFF_XB), (const bf16_t*)(p.ws + OFF_WIN) + (size_t)l * 2560 * 1024, T, 2560, 1024, (bf16_t*)(p.ws + OFF_Z), IN_DIM, (const float*)(p.ws + OFF_SSP));
  if (l == 0)
    run_gemm_scaled(smem, (const bf16_t*)(p.ws + OFF_MEMB), (const bf16_t*)(p.ws + OFF_WXKV), 2560, 2048, 1024, (bf16_t*)(p.ws + OFF_MEMKV), 2048, (const float*)(p.ws + OFF_MSS),
                    (int)gridDim.x - (int)(3200u % gridDim.x));
}
DI void phase_out_gemm(const Params& p, int l, unsigned char* smem) {
  run_gemm_resid(smem, (const bf16_t*)(p.ws + OFF_YMIX), (const bf16_t*)(p.ws + OFF_WOUT) + (size_t)l * 1024 * 1024, T, 1024, 1024, p.x, (bf16_t*)(p.ws + OFF_XB), (float*)(p.ws + OFF_SSP),
                 l == 0 ? p.x_prompt : (const float*)p.x, l == 0 ? p.x_sample - (size_t)16384 * DM : (const float*)p.x);
}
DI void phase_xq_gemm(const Params& p, int l, unsigned char* smem) {
  run_gemm_scaled(smem, (const bf16_t*)(p.ws + OFF_XB), (const bf16_t*)(p.ws + OFF_WXQ) + (size_t)l * 512 * 1024, T, 512, 1024, (bf16_t*)(p.ws + OFF_Q), 512, (const float*)(p.ws + OFF_SSP));
}
DI void phase_xo_gemm(const Params& p, int l, unsigned char* smem) {
  run_gemm_resid(smem, (const bf16_t*)(p.ws + OFF_O), (const bf16_t*)(p.ws + OFF_WXO) + (size_t)l * 1024 * 512, T, 1024, 512, p.x, (bf16_t*)(p.ws + OFF_XB), (float*)(p.ws + OFF_SSP), p.x, p.x);
}
DI void topk16_pair(float (&v)[64], float (&res)[16], int lane) {
#define CE(i, l) { const float a_ = v[i], b_ = v[l]; v[i] = fmaxf(a_, b_); v[l] = fminf(a_, b_); }
  CE(0, 1) CE(3, 2) CE(4, 5) CE(7, 6) CE(8, 9) CE(11, 10) CE(12, 13) CE(15, 14) CE(0, 2) CE(1, 3) CE(6, 4) CE(7, 5) CE(8, 10) CE(9, 11) CE(14, 12) CE(15, 13) CE(0, 1) CE(2, 3)
  CE(5, 4) CE(7, 6) CE(8, 9) CE(10, 11) CE(13, 12) CE(15, 14) CE(0, 4) CE(1, 5) CE(2, 6) CE(3, 7) CE(12, 8) CE(13, 9) CE(14, 10) CE(15, 11) CE(0, 2) CE(1, 3) CE(4, 6) CE(5, 7)
  CE(10, 8) CE(11, 9) CE(14, 12) CE(15, 13) CE(0, 1) CE(2, 3) CE(4, 5) CE(6, 7) CE(9, 8) CE(11, 10) CE(13, 12) CE(15, 14) CE(0, 8) CE(1, 9) CE(2, 10) CE(3, 11) CE(4, 12) CE(5, 13)
  CE(6, 14) CE(7, 15) CE(0, 4) CE(1, 5) CE(2, 6) CE(3, 7) CE(8, 12) CE(9, 13) CE(10, 14) CE(11, 15) CE(0, 2) CE(1, 3) CE(4, 6) CE(5, 7) CE(8, 10) CE(9, 11) CE(12, 14) CE(13, 15)
  CE(0, 1) CE(2, 3) CE(4, 5) CE(6, 7) CE(8, 9) CE(10, 11) CE(12, 13) CE(14, 15) CE(16, 17) CE(19, 18) CE(20, 21) CE(23, 22) CE(24, 25) CE(27, 26) CE(28, 29) CE(31, 30) CE(16, 18)
  CE(17, 19) CE(22, 20) CE(23, 21) CE(24, 26) CE(25, 27) CE(30, 28) CE(31, 29) CE(16, 17) CE(18, 19) CE(21, 20) CE(23, 22) CE(24, 25) CE(26, 27) CE(29, 28) CE(31, 30) CE(16, 20)
  CE(17, 21) CE(18, 22) CE(19, 23) CE(28, 24) CE(29, 25) CE(30, 26) CE(31, 27) CE(16, 18) CE(17, 19) CE(20, 22) CE(21, 23) CE(26, 24) CE(27, 25) CE(30, 28) CE(31, 29) CE(16, 17)
  CE(18, 19) CE(20, 21) CE(22, 23) CE(25, 24) CE(27, 26) CE(29, 28) CE(31, 30) CE(16, 24) CE(17, 25) CE(18, 26) CE(19, 27) CE(20, 28) CE(21, 29) CE(22, 30) CE(23, 31) CE(16, 20)
  CE(17, 21) CE(18, 22) CE(19, 23) CE(24, 28) CE(25, 29) CE(26, 30) CE(27, 31) CE(16, 18) CE(17, 19) CE(20, 22) CE(21, 23) CE(24, 26) CE(25, 27) CE(28, 30) CE(29, 31) CE(16, 17)
  CE(18, 19) CE(20, 21) CE(22, 23) CE(24, 25) CE(26, 27) CE(28, 29) CE(30, 31) CE(32, 33) CE(35, 34) CE(36, 37) CE(39, 38) CE(40, 41) CE(43, 42) CE(44, 45) CE(47, 46) CE(32, 34)
  CE(33, 35) CE(38, 36) CE(39, 37) CE(40, 42) CE(41, 43) CE(46, 44) CE(47, 45) CE(32, 33) CE(34, 35) CE(37, 36) CE(39, 38) CE(40, 41) CE(42, 43) CE(45, 44) CE(47, 46) CE(32, 36)
  CE(33, 37) CE(34, 38) CE(35, 39) CE(44, 40) CE(45, 41) CE(46, 42) CE(47, 43) CE(32, 34) CE(33, 35) CE(36, 38) CE(37, 39) CE(42, 40) CE(43, 41) CE(46, 44) CE(47, 45) CE(32, 33)
  CE(34, 35) CE(36, 37) CE(38, 39) CE(41, 40) CE(43, 42) CE(45, 44) CE(47, 46) CE(32, 40) CE(33, 41) CE(34, 42) CE(35, 43) CE(36, 44) CE(37, 45) CE(38, 46) CE(39, 47) CE(32, 36)
  CE(33, 37) CE(34, 38) CE(35, 39) CE(40, 44) CE(41, 45) CE(42, 46) CE(43, 47) CE(32, 34) CE(33, 35) CE(36, 38) CE(37, 39) CE(40, 42) CE(41, 43) CE(44, 46) CE(45, 47) CE(32, 33)
  CE(34, 35) CE(36, 37) CE(38, 39) CE(40, 41) CE(42, 43) CE(44, 45) CE(46, 47) CE(48, 49) CE(51, 50) CE(52, 53) CE(55, 54) CE(56, 57) CE(59, 58) CE(60, 61) CE(63, 62) CE(48, 50)
  CE(49, 51) CE(54, 52) CE(55, 53) CE(56, 58) CE(57, 59) CE(62, 60) CE(63, 61) CE(48, 49) CE(50, 51) CE(53, 52) CE(55, 54) CE(56, 57) CE(58, 59) CE(61, 60) CE(63, 62) CE(48, 52)
  CE(49, 53) CE(50, 54) CE(51, 55) CE(60, 56) CE(61, 57) CE(62, 58) CE(63, 59) CE(48, 50) CE(49, 51) CE(52, 54) CE(53, 55) CE(58, 56) CE(59, 57) CE(62, 60) CE(63, 61) CE(48, 49)
  CE(50, 51) CE(52, 53) CE(54, 55) CE(57, 56) CE(59, 58) CE(61, 60) CE(63, 62) CE(48, 56) CE(49, 57) CE(50, 58) CE(51, 59) CE(52, 60) CE(53, 61) CE(54, 62) CE(55, 63) CE(48, 52)
  CE(49, 53) CE(50, 54) CE(51, 55) CE(56, 60) CE(57, 61) CE(58, 62) CE(59, 63) CE(48, 50) CE(49, 51) CE(52, 54) CE(53, 55) CE(56, 58) CE(57, 59) CE(60, 62) CE(61, 63) CE(48, 49)
  CE(50, 51) CE(52, 53) CE(54, 55) CE(56, 57) CE(58, 59) CE(60, 61) CE(62, 63) v[0] = fmaxf(v[0], v[31]); v[1] = fmaxf(v[1], v[30]); v[2] = fmaxf(v[2], v[29]);
  v[3] = fmaxf(v[3], v[28]); v[4] = fmaxf(v[4], v[27]); v[5] = fmaxf(v[5], v[26]); v[6] = fmaxf(v[6], v[25]); v[7] = fmaxf(v[7], v[24]); v[8] = fmaxf(v[8], v[23]);
  v[9] = fmaxf(v[9], v[22]); v[10] = fmaxf(v[10], v[21]); v[11] = fmaxf(v[11], v[20]); v[12] = fmaxf(v[12], v[19]); v[13] = fmaxf(v[13], v[18]); v[14] = fmaxf(v[14], v[17]);
  v[15] = fmaxf(v[15], v[16]); CE(0, 8) CE(1, 9) CE(2, 10) CE(3, 11) CE(4, 12) CE(5, 13) CE(6, 14) CE(7, 15) CE(0, 4) CE(1, 5) CE(2, 6) CE(3, 7) CE(8, 12) CE(9, 13) CE(10, 14)
  CE(11, 15) CE(0, 2) CE(1, 3) CE(4, 6) CE(5, 7) CE(8, 10) CE(9, 11) CE(12, 14) CE(13, 15) CE(0, 1) CE(2, 3) CE(4, 5) CE(6, 7) CE(8, 9) CE(10, 11) CE(12, 13) CE(14, 15)
  v[32] = fmaxf(v[32], v[63]); v[33] = fmaxf(v[33], v[62]); v[34] = fmaxf(v[34], v[61]); v[35] = fmaxf(v[35], v[60]); v[36] = fmaxf(v[36], v[59]); v[37] = fmaxf(v[37], v[58]);
  v[38] = fmaxf(v[38], v[57]); v[39] = fmaxf(v[39], v[56]); v[40] = fmaxf(v[40], v[55]); v[41] = fmaxf(v[41], v[54]); v[42] = fmaxf(v[42], v[53]); v[43] = fmaxf(v[43], v[52]);
  v[44] = fmaxf(v[44], v[51]); v[45] = fmaxf(v[45], v[50]); v[46] = fmaxf(v[46], v[49]); v[47] = fmaxf(v[47], v[48]); CE(32, 40) CE(33, 41) CE(34, 42) CE(35, 43) CE(36, 44)
  CE(37, 45) CE(38, 46) CE(39, 47) CE(32, 36) CE(33, 37) CE(34, 38) CE(35, 39) CE(40, 44) CE(41, 45) CE(42, 46) CE(43, 47) CE(32, 34) CE(33, 35) CE(36, 38) CE(37, 39) CE(40, 42)
  CE(41, 43) CE(44, 46) CE(45, 47) CE(32, 33) CE(34, 35) CE(36, 37) CE(38, 39) CE(40, 41) CE(42, 43) CE(44, 45) CE(46, 47) v[0] = fmaxf(v[0], v[47]); v[1] = fmaxf(v[1], v[46]);
  v[2] = fmaxf(v[2], v[45]); v[3] = fmaxf(v[3], v[44]); v[4] = fmaxf(v[4], v[43]); v[5] = fmaxf(v[5], v[42]); v[6] = fmaxf(v[6], v[41]); v[7] = fmaxf(v[7], v[40]);
  v[8] = fmaxf(v[8], v[39]); v[9] = fmaxf(v[9], v[38]); v[10] = fmaxf(v[10], v[37]); v[11] = fmaxf(v[11], v[36]); v[12] = fmaxf(v[12], v[35]); v[13] = fmaxf(v[13], v[34]);
  v[14] = fmaxf(v[14], v[33]); v[15] = fmaxf(v[15], v[32]); CE(0, 8) CE(1, 9) CE(2, 10) CE(3, 11) CE(4, 12) CE(5, 13) CE(6, 14) CE(7, 15) CE(0, 4) CE(1, 5) CE(2, 6) CE(3, 7)
  CE(8, 12) CE(9, 13) CE(10, 14) CE(11, 15) CE(0, 2) CE(1, 3) CE(4, 6) CE(5, 7) CE(8, 10) CE(9, 11) CE(12, 14) CE(13, 15) CE(0, 1) CE(2, 3) CE(4, 5) CE(6, 7) CE(8, 9) CE(10, 11)
  CE(12, 13) CE(14, 15)
  float pq[16];
#pragma unroll
  for (int i = 0; i < 16; ++i) pq[i] = xor32(v[i], lane);
#pragma unroll
  for (int i = 0; i < 16; ++i) res[i] = fmaxf(v[i], pq[15 - i]);
  { const float a_ = res[0], b_ = res[8]; res[0] = fmaxf(a_, b_); res[8] = fminf(a_, b_); }
  { const float a_ = res[1], b_ = res[9]; res[1] = fmaxf(a_, b_); res[9] = fminf(a_, b_); }
  { const float a_ = res[2], b_ = res[10]; res[2] = fmaxf(a_, b_); res[10] = fminf(a_, b_); }
  { const float a_ = res[3], b_ = res[11]; res[3] = fmaxf(a_, b_); res[11] = fminf(a_, b_); }
  { const float a_ = res[4], b_ = res[12]; res[4] = fmaxf(a_, b_); res[12] = fminf(a_, b_); }
  { const float a_ = res[5], b_ = res[13]; res[5] = fmaxf(a_, b_); res[13] = fminf(a_, b_); }
  { const float a_ = res[6], b_ = res[14]; res[6] = fmaxf(a_, b_); res[14] = fminf(a_, b_); }
  { const float a_ = res[7], b_ = res[15]; res[7] = fmaxf(a_, b_); res[15] = fminf(a_, b_); }
  { const float a_ = res[0], b_ = res[4]; res[0] = fmaxf(a_, b_); res[4] = fminf(a_, b_); }
  { const float a_ = res[1], b_ = res[5]; res[1] = fmaxf(a_, b_); res[5] = fminf(a_, b_); }
  { const float a_ = res[2], b_ = res[6]; res[2] = fmaxf(a_, b_); res[6] = fminf(a_, b_); }
  { const float a_ = res[3], b_ = res[7]; res[3] = fmaxf(a_, b_); res[7] = fminf(a_, b_); }
  { const float a_ = res[8], b_ = res[12]; res[8] = fmaxf(a_, b_); res[12] = fminf(a_, b_); }
  { const float a_ = res[9], b_ = res[13]; res[9] = fmaxf(a_, b_); res[13] = fminf(a_, b_); }
  { const float a_ = res[10], b_ = res[14]; res[10] = fmaxf(a_, b_); res[14] = fminf(a_, b_); }
  { const float a_ = res[11], b_ = res[15]; res[11] = fmaxf(a_, b_); res[15] = fminf(a_, b_); }
  { const float a_ = res[0], b_ = res[2]; res[0] = fmaxf(a_, b_); res[2] = fminf(a_, b_); }
  { const float a_ = res[1], b_ = res[3]; res[1] = fmaxf(a_, b_); res[3] = fminf(a_, b_); }
  { const float a_ = res[4], b_ = res[6]; res[4] = fmaxf(a_, b_); res[6] = fminf(a_, b_); }
  { const float a_ = res[5], b_ = res[7]; res[5] = fmaxf(a_, b_); res[7] = fminf(a_, b_); }
  { const float a_ = res[8], b_ = res[10]; res[8] = fmaxf(a_, b_); res[10] = fminf(a_, b_); }
  { const float a_ = res[9], b_ = res[11]; res[9] = fmaxf(a_, b_); res[11] = fminf(a_, b_); }
  { const float a_ = res[12], b_ = res[14]; res[12] = fmaxf(a_, b_); res[14] = fminf(a_, b_); }
  { const float a_ = res[13], b_ = res[15]; res[13] = fmaxf(a_, b_); res[15] = fminf(a_, b_); }
  { const float a_ = res[0], b_ = res[1]; res[0] = fmaxf(a_, b_); res[1] = fminf(a_, b_); }
  { const float a_ = res[2], b_ = res[3]; res[2] = fmaxf(a_, b_); res[3] = fminf(a_, b_); }
  { const float a_ = res[4], b_ = res[5]; res[4] = fmaxf(a_, b_); res[5] = fminf(a_, b_); }
  { const float a_ = res[6], b_ = res[7]; res[6] = fmaxf(a_, b_); res[7] = fminf(a_, b_); }
  { const float a_ = res[8], b_ = res[9]; res[8] = fmaxf(a_, b_); res[9] = fminf(a_, b_); }
  { const float a_ = res[10], b_ = res[11]; res[10] = fmaxf(a_, b_); res[11] = fminf(a_, b_); }
  { const float a_ = res[12], b_ = res[13]; res[12] = fmaxf(a_, b_); res[13] = fminf(a_, b_); }
  { const float a_ = res[14], b_ = res[15]; res[14] = fmaxf(a_, b_); res[15] = fminf(a_, b_); }
#undef CE
}
struct OneUnit {
  pg8::Unit u;
  __device__ __forceinline__ bool next(int i, pg8::Unit& o) const { if (i) return false; o = u; return true; }
  __device__ __forceinline__ void a_ready(const pg8::Unit&) const {}
  __device__ __forceinline__ void done(const pg8::Unit&) const {}
};
struct EpiPeerQ {
  static constexpr bool PERM = true, AFTER_DRAIN = true;
  const float* ssq; const bf16_t* subk_l; float* topS; unsigned char* smem;
  __device__ __forceinline__ void operator()(const f32x4 (&)[2][2][4][2], const pg8::Unit&, int, int, int, int) const {}
  __device__ __forceinline__ void fused(const f32x4 (&acc)[2][2][4][2], const pg8::Unit& u, int wr, int wc, int fr, int fq, PG8_LAS unsigned char*, int wid, int lane) const {
    bf16_t* Qs = (bf16_t*)smem;
    float rsv[2][4];
#pragma unroll
    for (int ai = 0; ai < 2; ++ai)
#pragma unroll
      for (int m = 0; m < 4; ++m) rsv[ai][m] = rstd_from_ssq(ssq + ((size_t)u.pm * 256 + 128 * ai + 64 * wr + 16 * m + fr) * 16);
#pragma unroll
    for (int ai = 0; ai < 2; ++ai)
#pragma unroll
      for (int m = 0; m < 4; ++m) {
        const int rowl = 128 * ai + 64 * wr + 16 * m + fr;
        const float rs = rsv[ai][m];
#pragma unroll
        for (int bj = 0; bj < 2; ++bj) {
          const f32x4 v0 = acc[ai][bj][m][0] * rs, v1 = acc[ai][bj][m][1] * rs;
          u32x4 w = {pk2(v0[0], v0[1]), pk2(v0[2], v0[3]), pk2(v1[0], v1[1]), pk2(v1[2], v1[3])};
          *(u32x4*)(Qs + rowl * 264 + 128 * bj + 32 * wc + 8 * fq) = w;
        }
      }
    __syncthreads();
    const int r = lane & 31, h = lane >> 5;
#pragma unroll 1
    for (int pp = 0; pp < 2; ++pp) {
      const bf16_t* sk = subk_l + ((size_t)(u.pn * 2 + pp) * 128) * 128 + r * 128 + 8 * h;
      f32x16 sc[4];
#pragma unroll
      for (int n4 = 0; n4 < 4; ++n4)
#pragma unroll
        for (int i = 0; i < 16; ++i) sc[n4][i] = 0.f;
#pragma unroll 2
      for (int ks = 0; ks < 8; ++ks) {
        const bf16x8 bq = *(const bf16x8*)(Qs + (32 * wid + r) * 264 + 128 * pp + 16 * ks + 8 * h);
#pragma unroll
        for (int n4 = 0; n4 < 4; ++n4) { const bf16x8 a = *(const bf16x8*)(sk + (32 * n4) * 128 + 16 * ks); sc[n4] = MFMA32(a, bq, sc[n4]); }
      }
      float v[64], res[16];
#pragma unroll
      for (int n4 = 0; n4 < 4; ++n4)
#pragma unroll
        for (int i = 0; i < 16; ++i) v[16 * n4 + i] = __uint_as_float((__float_as_uint(sc[n4][i]) & ~127u) | (unsigned)(32 * n4 + crow(i, h)));
      topk16_pair(v, res, lane);
      if (h == 0) {
        float* dst = topS + (((size_t)u.pm * 256 + 32 * wid + r) * 16 + u.pn * 2 + pp) * 16;
#pragma unroll
        for (int g = 0; g < 4; ++g) { f32x4 vv = {res[4 * g], res[4 * g + 1], res[4 * g + 2], res[4 * g + 3]}; *(f32x4*)(dst + 4 * g) = vv; }
      }
    }
    __syncthreads();
  }
};
DI void phase_peer_q(const Params& p, int l, unsigned char* smem) {
  const pg8::Gemm g{(const bf16_t*)(p.ws + OFF_XB), (const bf16_t*)(p.ws + OFF_WPQ) + (size_t)l * 2048 * 1024, T, 2048, 1024};
  const EpiPeerQ E{(const float*)(p.ws + OFF_SSP), (const bf16_t*)(p.ws + OFF_SUBK) + (size_t)l * 16 * 128 * 128, (float*)(p.ws + OFF_TOPS), smem};
  TILE_WALK(8, 40)
    const OneUnit S{{mt, nt}};
    pg8::gemm_phase<EpiPeerQ, OneUnit, false>((PG8_LAS unsigned char*)smem, g, S, E, nullptr);
  }
}

DI void fp8x16_dot(const u32x4 u, const float (&xn)[16], float& d) {
#pragma unroll
  for (int dw = 0; dw < 4; ++dw) {
    const f32x2 lo = __builtin_amdgcn_cvt_pk_f32_fp8((int)u[dw], false), hi = __builtin_amdgcn_cvt_pk_f32_fp8((int)u[dw], true);
    d += lo.x * xn[4 * dw] + lo.y * xn[4 * dw + 1]; d += hi.x * xn[4 * dw + 2] + hi.y * xn[4 * dw + 3];
  }
}
DI void fp8x16_axpy(const u32x4 u, float w, float (&out)[16]) {
#pragma unroll
  for (int dw = 0; dw < 4; ++dw) {
    const f32x2 lo = __builtin_amdgcn_cvt_pk_f32_fp8((int)u[dw], false), hi = __builtin_amdgcn_cvt_pk_f32_fp8((int)u[dw], true);
    out[4 * dw] += w * lo.x; out[4 * dw + 1] += w * lo.y; out[4 * dw + 2] += w * hi.x; out[4 * dw + 3] += w * hi.y;
  }
}
DI void phase_peer_experts(const Params& p, int l, bool last) {
  const int t = tid(), lane = t & 63, wid = t >> 6;
  const unsigned char* pu = (const unsigned char*)(p.ws + OFF_PU) + (size_t)l * 16384 * 1024 + 16 * lane;
  const unsigned char* pv = (const unsigned char*)(p.ws + OFF_PV) + (size_t)l * 16384 * 1024 + 16 * lane;
  const float* gf = p.norm_ffn_g + l * 1024 + 16 * lane;
  const int pr = PAIRTAB[lane], ci = pr >> 4, cj = pr & 15;
  for (int tok = VB * 4 + wid; tok < T; tok += NVB * 4) {
    float* xr = p.x + (size_t)tok * DM + 16 * lane;
    float xn[16], out[16];
    {
      f32x4 xa[4];
#pragma unroll
      for (int k = 0; k < 4; ++k) xa[k] = *(const f32x4*)(xr + 4 * k);
      float ss = 0.f;
#pragma unroll
      for (int k = 0; k < 4; ++k) ss += xa[k].x * xa[k].x + xa[k].y * xa[k].y + xa[k].z * xa[k].z + xa[k].w * xa[k].w;
      ss = wave_sum(ss, lane);
      const float rstd = rsqrtf(ss * (1.0f / 1024.0f) + RMS_EPS);
#pragma unroll
      for (int k = 0; k < 4; ++k) { const f32x4 g = *(const f32x4*)(gf + 4 * k);
        xn[4 * k] = xa[k].x * rstd * g.x; xn[4 * k + 1] = xa[k].y * rstd * g.y; xn[4 * k + 2] = xa[k].z * rstd * g.z; xn[4 * k + 3] = xa[k].w * rstd * g.w; }
    }
#pragma unroll
    for (int k = 0; k < 16; ++k) out[k] = 0.f;
    const float* ts = ((float*)(p.ws + OFF_TOPS)) + (size_t)tok * 256;
    for (int hd = 0; hd < 8; ++hd) {
      const float sa = ts[hd * 32 + ci], sb = ts[hd * 32 + 16 + cj];
      const float val = (lane < 50) ? sa + sb : -INFINITY;
      const int idx = (int)((__float_as_uint(sa) & 127u) * 128u + (__float_as_uint(sb) & 127u));
      int rank = 0;
#pragma unroll
      for (int c = 0; c < 50; ++c) { const float vc = rdlane_f(val, c); rank += ((vc > val) || (vc == val && c < lane)) ? 1 : 0; }
      const bool selected = (rank < 16) && (lane < 50);
      unsigned long long sel = __ballot(selected);
      const float vmax = rdlane_f(val, 0);
      const float e = selected ? __expf(val - vmax) : 0.f;
      const float esum = wave_sum(e, lane);
      const float gate = e / esum;
      int ce = 0; float cgt = 0.f;
#pragma unroll
      for (int rd = 0; rd < 16; ++rd) {
        const int s = __ffsll((long long)sel) - 1; sel &= sel - 1;
        const int ex = __builtin_amdgcn_readlane(idx, s); const float gg = rdlane_f(gate, s);
        ce = (lane == rd) ? ex : ce; cgt = (lane == rd) ? gg : cgt;
      }
      float myd = 0.f;
      {
        u32x4 u[16], v[16];
#pragma unroll
        for (int k = 0; k < 16; ++k) { const int ex = __builtin_amdgcn_readlane(ce, k); u[k] = *(const u32x4*)(pu + (size_t)ex * 1024); v[k] = *(const u32x4*)(pv + (size_t)ex * 1024); }
#pragma unroll
        for (int k = 0; k < 16; ++k) {
          float d = 0.f;
          fp8x16_dot(u[k], xn, d);
          d = wave_sum(d, lane);
          myd = (lane == k) ? d : myd;
        }
        myd *= F8_INV;
        const float wgt = cgt * (0.5f * myd * (1.0f + erff(myd * 0.70710678118654752f))) * F8_INV;
#pragma unroll
        for (int k = 0; k < 16; ++k) fp8x16_axpy(v[k], rdlane_f(wgt, k), out);
      }
    }
    f32x4 xo[4];
#pragma unroll
    for (int k = 0; k < 4; ++k) { const f32x4 xa = *(const f32x4*)(xr + 4 * k); xo[k].x = xa.x + out[4 * k]; xo[k].y = xa.y + out[4 * k + 1]; xo[k].z = xa.z + out[4 * k + 2]; xo[k].w = xa.w + out[4 * k + 3]; }
    float s2 = 0.f;
#pragma unroll
    for (int k = 0; k < 4; ++k) s2 += xo[k].x * xo[k].x + xo[k].y * xo[k].y + xo[k].z * xo[k].z + xo[k].w * xo[k].w;
    s2 = wave_sum(s2, lane);
    if (!last && lane < 4) { f32x4 sv = {lane == 0 ? s2 : 0.f, 0.f, 0.f, 0.f}; *(f32x4*)((float*)(p.ws + OFF_SSP) + (size_t)tok * 16 + 4 * lane) = sv; }
    if (last) {
      const float r2 = rsqrtf(s2 * (1.0f / 1024.0f) + RMS_EPS);
      const float* fg = p.final_g + 16 * lane;
#pragma unroll
      for (int k = 0; k < 4; ++k) xo[k] = xo[k] * r2 * *(const f32x4*)(fg + 4 * k);
    }
#pragma unroll
    for (int k = 0; k < 4; ++k) *(f32x4*)(xr + 4 * k) = xo[k];
    if (!last) {
      bf16_t* xb = (bf16_t*)(p.ws + OFF_XB) + (size_t)tok * DM + 16 * lane;
      u32x4 b0 = {pk2(xo[0].x, xo[0].y), pk2(xo[0].z, xo[0].w), pk2(xo[1].x, xo[1].y), pk2(xo[1].z, xo[1].w)};
      u32x4 b1 = {pk2(xo[2].x, xo[2].y), pk2(xo[2].z, xo[2].w), pk2(xo[3].x, xo[3].y), pk2(xo[3].z, xo[3].w)};
      *(u32x4*)xb = b0; *(u32x4*)(xb + 8) = b1;
    }
  }
}

DI void gsync(unsigned* bar, unsigned& epoch) {
  __syncthreads();
  ++epoch;
  if (threadIdx.x == 0) {
    __builtin_amdgcn_fence(__ATOMIC_RELEASE, "agent");
    const unsigned grp = blockIdx.x & 7u, ng = gridDim.x >> 3;
    const unsigned a = __hip_atomic_fetch_add(bar + 64 * grp, 1u, __ATOMIC_RELAXED, __HIP_MEMORY_SCOPE_AGENT);
    if (a + 1u == epoch * ng) {
      __builtin_amdgcn_fence(__ATOMIC_ACQ_REL, "agent"); asm volatile("s_waitcnt vmcnt(0)" ::: "memory");
      const unsigned b = __hip_atomic_fetch_add(bar + 64 * 8, 1u, __ATOMIC_RELAXED, __HIP_MEMORY_SCOPE_AGENT);
      if (b + 1u == epoch * 8u) { __builtin_amdgcn_fence(__ATOMIC_ACQ_REL, "agent"); asm volatile("s_waitcnt vmcnt(0)" ::: "memory"); __hip_atomic_store(bar + 64 * 9, epoch, __ATOMIC_RELAXED, __HIP_MEMORY_SCOPE_AGENT); }
    }
    while (__hip_atomic_load(bar + 64 * 9, __ATOMIC_RELAXED, __HIP_MEMORY_SCOPE_AGENT) < epoch) { }
    __builtin_amdgcn_fence(__ATOMIC_ACQUIRE, "agent");
    asm volatile("s_waitcnt vmcnt(0)" ::: "memory");
  }
  __syncthreads();
}
template <int L>
DI void run_layer(const Params& p, unsigned char* smem, unsigned char* vsm, unsigned* bar, unsigned& epoch) {
  phase_in_gemm(p, L, smem);
  gsync(bar, epoch);
  for (int it = VB; it < 7680; it += NVB) {
    if (it < 3840) na_item(p, L, it, vsm); else swa_item(p, L, it - 3840, vsm);
  }
  for (int it = VB; it < 10240; it += NVB) conv_item(p, L, it);
  gsync(bar, epoch);
  phase_out_gemm(p, L, smem); gsync(bar, epoch);
  phase_xq_gemm(p, L, smem);
  gsync(bar, epoch);
  for (int it = VB; it < 2560; it += NVB) xattn_item(p, L, it, vsm);
  gsync(bar, epoch);
  phase_xo_gemm(p, L, smem); gsync(bar, epoch);
  phase_peer_q(p, L, smem);
  gsync(bar, epoch);
  phase_peer_experts(p, L, L == 1);
}
__global__ void __launch_bounds__(512, 2) fwd(Params p) {
  __shared__ __attribute__((aligned(16))) unsigned char smem[SMEM_BYTES];
  unsigned char* vsm = smem + VHALF * VSMEM;
  cg::grid_group grid = cg::this_grid();
  unsigned* bar = (unsigned*)(p.ws + OFF_BAR); unsigned epoch = 0;
  if (blockIdx.x == 0 && threadIdx.x < 10) bar[64 * threadIdx.x] = 0u;
  phase_prologue(p, vsm);
  grid.sync();
  run_layer<0>(p, smem, vsm, bar, epoch); gsync(bar, epoch);
  run_layer<1>(p, smem, vsm, bar, epoch);
}

extern "C" void kernel_launch(void* const* d_in, const int* in_sizes, int n_in, void* d_out, int out_size, void* d_ws, size_t ws_size, hipStream_t stream) {
  static int grid_blocks = 0;
  if (!grid_blocks) {
    int dev = 0, cus = 0, per_cu = 1;
    (void)hipGetDevice(&dev);
    (void)hipDeviceGetAttribute(&cus, hipDeviceAttributeMultiprocessorCount, dev);
    (void)hipOccupancyMaxActiveBlocksPerMultiprocessor(&per_cu, fwd, 512, 0);
    if (per_cu < 1) per_cu = 1;
    grid_blocks = cus;
    grid_blocks -= grid_blocks % 8;
  }
  Params p{};
  const float* const* in = (const float* const*)d_in;
  p.x_prompt = in[0]; p.x_sample = in[1]; p.mem_prompt = in[2]; p.mem_sample = in[3];
  p.norm_mix_g = in[4]; p.w_in = in[5]; p.na_rpb = in[6]; p.conv_w = in[7]; p.swa_sink = in[8]; p.t5_bias = in[9];
  p.w_out = in[10]; p.norm_xa_g = in[11]; p.norm_mem_g = in[12]; p.w_xq = in[13]; p.w_xk = in[14]; p.w_xv = in[15]; p.w_xo = in[16];
  p.norm_ffn_g = in[17]; p.peer_wq = in[18]; p.peer_subkeys = in[19]; p.peer_u = in[20]; p.peer_v = in[21]; p.final_g = in[22];
  p.x = (float*)d_out;
  p.ws = (unsigned char*)d_ws;
  if (WS_NEED > ws_size) { fprintf(stderr, "workspace too small: need %zu have %zu\n", (size_t)WS_NEED, ws_size); return; }
  void* args[] = {&p};
  hipError_t e = hipLaunchCooperativeKernel((void*)fwd, dim3(grid_blocks), dim3(512), args, 0, stream);
  if (e != hipSuccess) fprintf(stderr, "cooperative launch failed: %s (grid %d)\n", hipGetErrorString(e), grid_blocks);
}
```

```cpp
#include <hip/hip_runtime.h>
#include <hip/hip_cooperative_groups.h>
#include <cstdio>
#include <cstdint>
namespace cg = cooperative_groups;


#define DI __device__ __forceinline__
typedef unsigned short bf16_t;
typedef short bf16x8 __attribute__((ext_vector_type(8)));
typedef short s16x4 __attribute__((ext_vector_type(4)));
typedef __attribute__((address_space(3))) s16x4 lds_s16x4;
typedef float f32x16 __attribute__((ext_vector_type(16)));
typedef float f32x4 __attribute__((ext_vector_type(4)));
typedef float f32x2 __attribute__((ext_vector_type(2)));
typedef unsigned u32x4 __attribute__((ext_vector_type(4)));
typedef unsigned u32x2 __attribute__((ext_vector_type(2)));
typedef __bf16 bf2_t __attribute__((ext_vector_type(2)));

constexpr int T = 81920, DM = 1024, SEQ = 8192;
constexpr int IN_DIM = 2560;
constexpr float LOG2E = 1.4426950408889634f;
constexpr float RMS_EPS = 1e-6f;
constexpr int NPHASE = 17;

constexpr int Z_NAQ = 0, Z_NAK = 384, Z_NAV = 768, Z_SCB = 1152, Z_SCC = 1408, Z_SCH = 1664, Z_SWQ = 1920, Z_SWK = 2304, Z_SWV = 2432;

__device__ const unsigned char T5TAB[257] = {
15,15,15,15,15,15,15,15,15,15,15,15,15,15,15,15,15,15,15,15,15,15,15,15,15,15,15,15,15,15,15,15,15,15,15,15,15,15,14,14,14,14,14,14,14,14,14,14,14,14,14,14,14,14,14,14,14,14,14,14,14,14,14,14,14,13,13,13,13,13,13,13,13,13,13,13,13,13,13,13,13,13,13,12,12,12,12,12,12,12,12,12,12,12,12,12,12,11,11,11,11,11,11,11,11,11,10,10,10,10,10,10,10,9,9,9,9,8,8,8,8,7,6,5,4,3,2,1,0,17,18,19,20,21,22,23,24,24,24,24,25,25,25,25,26,26,26,26,26,26,26,27,27,27,27,27,27,27,27,27,28,28,28,28,28,28,28,28,28,28,28,28,28,28,29,29,29,29,29,29,29,29,29,29,29,29,29,29,29,29,29,29,30,30,30,30,30,30,30,30,30,30,30,30,30,30,30,30,30,30,30,30,30,30,30,30,30,30,30,31,31,31,31,31,31,31,31,31,31,31,31,31,31,31,31,31,31,31,31,31,31,31,31,31,31,31,31,31,31,31,31,31,31,31,31,31,31};
__device__ const unsigned char PAIRTAB[64] = {
0x00,0x01,0x02,0x03,0x04,0x05,0x06,0x07,0x08,0x09,0x0a,0x0b,0x0c,0x0d,0x0e,0x0f,
0x10,0x11,0x12,0x13,0x14,0x15,0x16,0x17,
0x20,0x21,0x22,0x23,0x24,
0x30,0x31,0x32,0x33,
0x40,0x41,0x42,
0x50,0x51,0x60,0x61,0x70,0x71,
0x80,0x90,0xa0,0xb0,0xc0,0xd0,0xe0,0xf0,
0,0,0,0,0,0,0,0,0,0,0,0,0,0};

struct Params {
  const float* x_prompt; const float* x_sample; const float* mem_prompt; const float* mem_sample;
  const float* norm_mix_g; const float* w_in; const float* na_rpb; const float* conv_w; const float* swa_sink; const float* t5_bias;
  const float* w_out; const float* norm_xa_g; const float* norm_mem_g; const float* w_xq; const float* w_xk; const float* w_xv; const float* w_xo;
  const float* norm_ffn_g; const float* peer_wq; const float* peer_subkeys; const float* peer_u; const float* peer_v; const float* final_g;
  float* x;
  unsigned char* ws;
};
constexpr size_t OFF_Z = 0;
constexpr size_t OFF_Q = 0;
constexpr size_t OFF_O = (size_t)T * 512 * 2;
constexpr size_t OFF_TOPS = (size_t)T * 1024 * 2;
constexpr size_t OFF_YMIX = OFF_Z + (size_t)T * IN_DIM * 2;
constexpr size_t OFF_WIN = OFF_YMIX + (size_t)T * DM * 2;
constexpr size_t OFF_WOUT = OFF_WIN + (size_t)2 * 2560 * 1024 * 2;
constexpr size_t OFF_WXQ = OFF_WOUT + (size_t)2 * 1024 * 1024 * 2;
constexpr size_t OFF_WXKV = OFF_WXQ + (size_t)2 * 512 * 1024 * 2;
constexpr size_t OFF_WXO = OFF_WXKV + (size_t)2 * 1024 * 1024 * 2;
constexpr size_t OFF_WPQ = OFF_WXO + (size_t)2 * 1024 * 512 * 2;
constexpr size_t OFF_SUBK = OFF_WPQ + (size_t)2 * 2048 * 1024 * 2;
constexpr size_t OFF_PU = OFF_SUBK + (size_t)2 * 8 * 2 * 128 * 128 * 2;
constexpr size_t OFF_PV = OFF_PU + (size_t)2 * 16384 * 1024 * 2;
constexpr size_t OFF_MEMKV = OFF_PV + (size_t)2 * 16384 * 1024 * 2;
constexpr size_t OFF_XB = OFF_MEMKV + (size_t)2 * 2560 * 1024 * 2;
constexpr size_t OFF_MEMB = OFF_XB + (size_t)T * DM * 2;
constexpr size_t OFF_SSP = OFF_MEMB + (size_t)2560 * 1024 * 2;
constexpr size_t OFF_MSS = OFF_SSP + (size_t)T * 16 * 4;
constexpr size_t OFF_BAR = OFF_MSS + (size_t)2560 * 16 * 4;
constexpr size_t WS_NEED = OFF_BAR + 4096;

DI unsigned pk2(float a, float b) { f32x2 v = {a, b}; return __builtin_bit_cast(unsigned, __builtin_convertvector(v, bf2_t)); }
DI bf16_t bf1(float a) { return (bf16_t)(pk2(a, 0.f) & 0xffffu); }
DI float bf_lo(unsigned u) { return __uint_as_float(u << 16); }
DI float bf_hi(unsigned u) { return __uint_as_float(u & 0xffff0000u); }
#define MFMA32(a, b, c) __builtin_amdgcn_mfma_f32_32x32x16_bf16((a), (b), (c), 0, 0, 0)
DI int crow(int i, int h) { return (i & 3) + 8 * (i >> 2) + 4 * h; }
DI int tid() { int t = threadIdx.x & 255; asm volatile("" : "+v"(t)); return t; }
DI int tid512() { int t = threadIdx.x; asm volatile("" : "+v"(t)); return t; }
#define VHALF (__builtin_amdgcn_readfirstlane((int)(threadIdx.x >> 8)))
#define VB ((int)(blockIdx.x * 2) + VHALF)
#define NVB ((int)(gridDim.x * 2))
template <int CTRL> DI float dpp(float v) { return __int_as_float(__builtin_amdgcn_update_dpp(0, __float_as_int(v), CTRL, 0xf, 0xf, true)); }
DI float xor16(float v) { return __int_as_float(__builtin_amdgcn_ds_swizzle(__float_as_int(v), 0x401F)); }
typedef unsigned u32x2s __attribute__((ext_vector_type(2)));
DI float pair_max(float v) { const u32x2s r = __builtin_amdgcn_permlane32_swap(__float_as_uint(v), __float_as_uint(v), false, false); return fmaxf(__uint_as_float(r.x), __uint_as_float(r.y)); }
DI float pair_sum(float v) { const u32x2s r = __builtin_amdgcn_permlane32_swap(__float_as_uint(v), __float_as_uint(v), false, false); return __uint_as_float(r.x) + __uint_as_float(r.y); }
DI float xor32(float v, int) { const unsigned b = __float_as_uint(v); const u32x2s r = __builtin_amdgcn_permlane32_swap(b, b, false, false); return __uint_as_float(r.x ^ r.y ^ b); }
DI float row_sum(float v) { v += dpp<0xB1>(v); v += dpp<0x4E>(v); v += dpp<0x141>(v); v += dpp<0x140>(v); return v; }
DI float wave_sum(float v, int) { v = row_sum(v); v += xor16(v); return pair_sum(v); }
DI float rdlane_f(float v, int l) { return __int_as_float(__builtin_amdgcn_readlane(__float_as_int(v), l)); }

DI float rstd_from_ssq(const float* ssq16);
constexpr int VSMEM = 74240;
constexpr int SMEM_BYTES = 2 * VSMEM;

template <int D, class F>
DI void attn_tile(const bf16_t* Ks, const bf16_t* Vs, const bf16x8 (&qf)[D / 16], f32x16 (&o)[D / 32], float& m, float& l, F fn, int r, int h, int lane) {
  f32x16 s;
#pragma unroll
  for (int i = 0; i < 16; ++i) s[i] = 0.f;
#pragma unroll
  for (int ks = 0; ks < D / 16; ++ks) { const bf16x8 a = *(const bf16x8*)(Ks + r * (D + 8) + 16 * ks + 8 * h); s = MFMA32(a, qf[ks], s); }
  float mx = -INFINITY;
#pragma unroll
  for (int i = 0; i < 16; ++i) { s[i] = fn(s[i], i); mx = fmaxf(mx, s[i]); }
  mx = pair_max(mx);
  const float mn = fmaxf(m, mx);
  const float alpha = __builtin_amdgcn_exp2f(m - mn);
  m = mn;
  float sum = 0.f;
#pragma unroll
  for (int i = 0; i < 16; ++i) { s[i] = __builtin_amdgcn_exp2f(s[i] - mn); sum += s[i]; }
  l = l * alpha + sum;
  if (__builtin_amdgcn_ballot_w64(alpha != 1.0f)) {
#pragma unroll
    for (int dt = 0; dt < D / 32; ++dt)
#pragma unroll
      for (int i = 0; i < 16; ++i) o[dt][i] *= alpha;
  }
  bf16x8 pf[2];
#pragma unroll
  for (int s2 = 0; s2 < 2; ++s2) {
    u32x4 pk = {pk2(s[8 * s2], s[8 * s2 + 1]), pk2(s[8 * s2 + 2], s[8 * s2 + 3]), pk2(s[8 * s2 + 4], s[8 * s2 + 5]), pk2(s[8 * s2 + 6], s[8 * s2 + 7])};
    pf[s2] = __builtin_bit_cast(bf16x8, pk);
  }
  constexpr int VP = (D == 64) ? 96 : 160;
  const int gi = lane & 15;
  const bf16_t* vbase = Vs + (4 * h + (gi >> 2)) * VP + 16 * ((lane >> 4) & 1) + 4 * (gi & 3);
#pragma unroll
  for (int dt = 0; dt < D / 32; ++dt)
#pragma unroll
    for (int s2 = 0; s2 < 2; ++s2) {
      const s16x4 lo = __builtin_amdgcn_ds_read_tr16_b64_v4i16((lds_s16x4*)(vbase + (16 * s2) * VP + 32 * dt));
      const s16x4 hi = __builtin_amdgcn_ds_read_tr16_b64_v4i16((lds_s16x4*)(vbase + (16 * s2 + 8) * VP + 32 * dt));
      const bf16x8 a = __builtin_shufflevector(lo, hi, 0, 1, 2, 3, 4, 5, 6, 7);
      o[dt] = MFMA32(a, pf[s2], o[dt]);
    }
}
template <int ND>
DI void attn_out(const f32x16 (&o)[ND], float l, bf16_t* yp, int h, int lane) {
  const float lt = pair_sum(l);
  const float inv = 1.0f / lt;
#pragma unroll
  for (int dt = 0; dt < ND; ++dt)
#pragma unroll
    for (int g = 0; g < 4; ++g) {
      u32x2 v = {pk2(o[dt][4 * g] * inv, o[dt][4 * g + 1] * inv), pk2(o[dt][4 * g + 2] * inv, o[dt][4 * g + 3] * inv)};
      *(u32x2*)(yp + 32 * dt + 8 * g + 4 * h) = v;
    }
}

constexpr int AT64_BUF = 32 * 72 + 32 * 96;
DI void swa_item(const Params& p, int l, int item, unsigned char* smem) {
  const int t = tid(), lane = t & 63, w = t >> 6, r = lane & 31, h = lane >> 5;
  const int head = item % 6, n = (item / 6) & 63, b = item / 384, hkv = head / 3;
  bf16_t* st = (bf16_t*)smem;
  float* bt = (float*)(smem + 2 * AT64_BUF * 2);
  __syncthreads();
  for (int i = t; i < 321; i += 256) { const int o = i - 32; bt[i] = (o >= 0 && o <= 256) ? p.t5_bias[T5TAB[o] * 6 + head] * LOG2E : -INFINITY; }
  const size_t tok0 = (size_t)b * SEQ;
  const int q0 = n * 128 + 32 * w;
  bf16x8 qf[4];
  { const bf16_t* qp = ((bf16_t*)(p.ws + OFF_Z)) + (tok0 + q0 + r) * IN_DIM + Z_SWQ + head * 64 + 8 * h;
#pragma unroll
    for (int ks = 0; ks < 4; ++ks) qf[ks] = *(const bf16x8*)(qp + 16 * ks); }
  f32x16 o[2];
#pragma unroll
  for (int dt = 0; dt < 2; ++dt)
#pragma unroll
    for (int i = 0; i < 16; ++i) o[dt][i] = 0.f;
  float m = p.swa_sink[l * 6 + head] * LOG2E, lsum = (h == 0) ? 1.f : 0.f;
  const int kt_lo = (n == 0) ? 4 : 0, kt_hi = (n == 63) ? 8 : 12;
  const int kk = t >> 3, c8 = t & 7;
  const bf16_t* kbase = ((bf16_t*)(p.ws + OFF_Z)) + (tok0 + (size_t)(n * 128 + kk)) * IN_DIM + Z_SWK + hkv * 64 + 8 * c8;
  u32x4 kr = {0, 0, 0, 0}, vr = {0, 0, 0, 0};
  if (kt_lo == 0) { const bf16_t* kp = kbase + (ptrdiff_t)(-128) * IN_DIM; kr = *(const u32x4*)kp; vr = *(const u32x4*)(kp + 128);
    *(u32x4*)(st + kk * 72 + 8 * c8) = kr; *(u32x4*)(st + 32 * 72 + kk * 96 + 8 * c8) = vr; }
  __syncthreads();
  const float sc2 = 0.125f * LOG2E;
  for (int kt = 0; kt < 12; ++kt) {
    const int cur = kt & 1;
    const bool nxt = (kt + 1 >= kt_lo) && (kt + 1 < kt_hi);
    if (nxt) { const bf16_t* kp = kbase + (ptrdiff_t)(32 * (kt + 1) - 128) * IN_DIM; kr = *(const u32x4*)kp; vr = *(const u32x4*)(kp + 128); }
    if (kt >= kt_lo && kt < kt_hi && kt >= w && kt <= w + 8) {
      const float* bp = bt + 32 + 128 + (32 * kt - 128 - 32 * w - r + 4 * h);
      attn_tile<64>(st + cur * AT64_BUF, st + cur * AT64_BUF + 32 * 72, qf, o, m, lsum,
        [&](float sv, int i) { return sv * sc2 + bp[(i & 3) + 8 * (i >> 2)]; }, r, h, lane);
    }
    if (nxt) { bf16_t* sb = st + (cur ^ 1) * AT64_BUF; *(u32x4*)(sb + kk * 72 + 8 * c8) = kr; *(u32x4*)(sb + 32 * 72 + kk * 96 + 8 * c8) = vr; }
    __syncthreads();
  }
  attn_out<2>(o, lsum, ((bf16_t*)(p.ws + OFF_YMIX)) + (tok0 + q0 + r) * DM + 640 + head * 64, h, lane);
}

DI void na_item(const Params& p, int l, int item, unsigned char* smem) {
  const int t = tid(), lane = t & 63, w = t >> 6, r = lane & 31, h = lane >> 5;
  const int hp = item % 3, rr = (item / 3) & 127, b = item / 384;
  const int hh = w >> 1, qh = w & 1, head = 2 * hp + hh;
  bf16_t* st = (bf16_t*)smem;
  constexpr int NBUF = 2 * AT64_BUF;
  float* bt = (float*)(smem + 2 * NBUF * 2);
  __syncthreads();
  for (int i = t; i < 930; i += 256) { const int e = i % 465, hsel = i / 465; bt[hsel * 576 + 40 + e] = p.na_rpb[((size_t)l * 465 + e) * 6 + 2 * hp + hsel] * LOG2E; }
  const size_t tok0 = (size_t)b * SEQ;
  const int r0 = min(max(rr - 4, 0), 120);
  const int c = 32 * qh + r;
  bf16x8 qf[4];
  { const bf16_t* qp = ((bf16_t*)(p.ws + OFF_Z)) + (tok0 + rr * 64 + c) * IN_DIM + Z_NAQ + head * 64 + 8 * h;
#pragma unroll
    for (int ks = 0; ks < 4; ++ks) qf[ks] = *(const bf16x8*)(qp + 16 * ks); }
  f32x16 o[2];
#pragma unroll
  for (int dt = 0; dt < 2; ++dt)
#pragma unroll
    for (int i = 0; i < 16; ++i) o[dt][i] = 0.f;
  float m = -1e30f, lsum = 0.f;
  const int kk = t >> 3, c8 = t & 7;
  const bf16_t* kbase = ((bf16_t*)(p.ws + OFF_Z)) + (tok0 + (size_t)((r0 + (kk >> 4)) * 64 + (kk & 15))) * IN_DIM + Z_NAK + (2 * hp) * 64 + 8 * c8;
  u32x4 k0r, k1r, v0r, v1r;
#define NA_LDG(kt) { const bf16_t* kp = kbase + (size_t)(((kt) >> 2) * 128 + ((kt) & 3) * 16) * IN_DIM; \
    k0r = *(const u32x4*)kp; k1r = *(const u32x4*)(kp + 64); v0r = *(const u32x4*)(kp + 384); v1r = *(const u32x4*)(kp + 448); }
#define NA_STS(buf) { bf16_t* sb = st + (buf) * NBUF; *(u32x4*)(sb + kk * 72 + 8 * c8) = k0r; *(u32x4*)(sb + AT64_BUF + kk * 72 + 8 * c8) = k1r; \
    *(u32x4*)(sb + 32 * 72 + kk * 96 + 8 * c8) = v0r; *(u32x4*)(sb + AT64_BUF + 32 * 72 + kk * 96 + 8 * c8) = v1r; }
  NA_LDG(0);
  NA_STS(0);
  __syncthreads();
  const float sc2 = 0.125f * LOG2E;
  const int c0 = min(max(c - 8, 0), 48);
  const float* bth = bt + hh * 576 + 40;
  for (int kt = 0; kt < 16; ++kt) {
    const int cur = kt & 1;
    if (kt + 1 < 16) NA_LDG(kt + 1);
    const int rp = kt >> 2, cb = kt & 3;
    if (cb >= qh && cb <= qh + 2) {
      const bf16_t* sb = st + cur * NBUF + hh * AT64_BUF;
      const float* bp = bth + (r0 + 2 * rp - rr + 7) * 31 + (16 * cb + 4 * h - c + 15);
      const int vb = 16 * cb + 4 * h - c0;
      attn_tile<64>(sb, sb + 32 * 72, qf, o, m, lsum,
        [&](float sv, int i) { const int cc = (i & 3) + 8 * ((i >> 2) & 1); const bool ok = (unsigned)(vb + cc) < 16u;
          const float lg = sv * sc2 + bp[(i >> 3) * 31 + cc]; return ok ? lg : -INFINITY; }, r, h, lane);
    }
    if (kt + 1 < 16) NA_STS(cur ^ 1);
    __syncthreads();
  }
#undef NA_LDG
#undef NA_STS
  attn_out<2>(o, lsum, ((bf16_t*)(p.ws + OFF_YMIX)) + (tok0 + rr * 64 + c) * DM + head * 64, h, lane);
}

DI void conv_item(const Params& p, int l, int item) {
  const int t = tid();
  const size_t tok = (size_t)item * 8 + (t >> 5);
  const int c8 = t & 31, pos = (int)(tok & (SEQ - 1));
  const bf16_t* zr = ((bf16_t*)(p.ws + OFF_Z)) + tok * IN_DIM + 8 * c8;
  const u32x4 bv = *(const u32x4*)(zr + Z_SCB);
  const u32x4 cc = *(const u32x4*)(zr + Z_SCC), hc = *(const u32x4*)(zr + Z_SCH);
  u32x4 cm = {0, 0, 0, 0}, hm = {0, 0, 0, 0}, cp = {0, 0, 0, 0}, hpv = {0, 0, 0, 0};
  if (pos > 0) { cm = *(const u32x4*)(zr - IN_DIM + Z_SCC); hm = *(const u32x4*)(zr - IN_DIM + Z_SCH); }
  if (pos < SEQ - 1) { cp = *(const u32x4*)(zr + IN_DIM + Z_SCC); hpv = *(const u32x4*)(zr + IN_DIM + Z_SCH); }
  const float* cw = p.conv_w + (size_t)l * 3 * 256 + 8 * c8;
  float y[8];
#pragma unroll
  for (int e = 0; e < 8; ++e) {
    const int wd = e >> 1;
    const float fb = (e & 1) ? bf_hi(bv[wd]) : bf_lo(bv[wd]);
    const float um = ((e & 1) ? bf_hi(cm[wd]) : bf_lo(cm[wd])) * ((e & 1) ? bf_hi(hm[wd]) : bf_lo(hm[wd]));
    const float uc = ((e & 1) ? bf_hi(cc[wd]) : bf_lo(cc[wd])) * ((e & 1) ? bf_hi(hc[wd]) : bf_lo(hc[wd]));
    const float up = ((e & 1) ? bf_hi(cp[wd]) : bf_lo(cp[wd])) * ((e & 1) ? bf_hi(hpv[wd]) : bf_lo(hpv[wd]));
    y[e] = fb * (um * cw[e] + uc * cw[256 + e] + up * cw[512 + e]);
  }
  u32x4 ov = {pk2(y[0], y[1]), pk2(y[2], y[3]), pk2(y[4], y[5]), pk2(y[6], y[7])};
  *(u32x4*)(((bf16_t*)(p.ws + OFF_YMIX)) + tok * DM + 384 + 8 * c8) = ov;
}

constexpr int AT128_BUF = 32 * 136 + 32 * 160;
DI void xattn_item(const Params& p, int l, int item, unsigned char* smem) {
  const int t = tid(), lane = t & 63, w = t >> 6, r = lane & 31, h = lane >> 5;
  const int qt = item & 63, head = (item >> 6) & 3, b = item >> 8;
  bf16_t* st = (bf16_t*)smem;
  const size_t tok = (size_t)b * SEQ + qt * 128 + 32 * w + r;
  bf16x8 qf[8];
  { const bf16_t* qp = ((bf16_t*)(p.ws + OFF_Q)) + tok * 512 + head * 128 + 8 * h;
#pragma unroll
    for (int ks = 0; ks < 8; ++ks) qf[ks] = *(const bf16x8*)(qp + 16 * ks); }
  f32x16 o[4];
#pragma unroll
  for (int dt = 0; dt < 4; ++dt)
#pragma unroll
    for (int i = 0; i < 16; ++i) o[dt][i] = 0.f;
  float m = -1e30f, lsum = 0.f;
  const int kk = t >> 4, c8 = t & 15;
  const bf16_t* kbase = ((bf16_t*)(p.ws + OFF_MEMKV)) + ((size_t)b * 256 + kk) * 2048 + (size_t)l * 1024 + head * 128 + 8 * c8;
  u32x4 k0r, k1r, v0r, v1r;
#define XA_LDG(kt) { const bf16_t* kp = kbase + (size_t)(32 * (kt)) * 2048; \
    k0r = *(const u32x4*)kp; k1r = *(const u32x4*)(kp + 16 * 2048); v0r = *(const u32x4*)(kp + 512); v1r = *(const u32x4*)(kp + 16 * 2048 + 512); }
#define XA_STS(buf) { bf16_t* sb = st + (buf) * AT128_BUF; *(u32x4*)(sb + kk * 136 + 8 * c8) = k0r; *(u32x4*)(sb + (kk + 16) * 136 + 8 * c8) = k1r; \
    *(u32x4*)(sb + 32 * 136 + kk * 160 + 8 * c8) = v0r; *(u32x4*)(sb + 32 * 136 + (kk + 16) * 160 + 8 * c8) = v1r; }
  __syncthreads();
  XA_LDG(0);
  XA_STS(0);
  __syncthreads();
  const float sc2 = 0.08838834764831845f * LOG2E;
  for (int kt = 0; kt < 8; ++kt) {
    const int cur = kt & 1;
    if (kt + 1 < 8) XA_LDG(kt + 1);
    { const bf16_t* sb = st + cur * AT128_BUF;
      attn_tile<128>(sb, sb + 32 * 136, qf, o, m, lsum, [&](float sv, int) { return sv * sc2; }, r, h, lane); }
    if (kt + 1 < 8) XA_STS(cur ^ 1);
    __syncthreads();
  }
#undef XA_LDG
#undef XA_STS
  attn_out<4>(o, lsum, ((bf16_t*)(p.ws + OFF_O)) + tok * 512 + head * 128, h, lane);
}

template <bool REV>
DI void transpose_job(const float* __restrict__ src, int K, int N, const float* __restrict__ g, bf16_t* __restrict__ dst, unsigned char* smem) {
  float* tl = (float*)smem;
  const int tn = N / 64, ntile = (K / 64) * tn, t = tid();
  for (int tile = REV ? NVB - 1 - VB : VB; tile < ntile; tile += NVB) {
    const int k0 = (tile / tn) * 64, n0 = (tile % tn) * 64;
    __syncthreads();
#pragma unroll 4
    for (int i = 0; i < 16; ++i) { const int kk = (t >> 6) + 4 * i; float v = src[(size_t)(k0 + kk) * N + n0 + (t & 63)]; if (g) v *= g[k0 + kk]; tl[kk * 65 + (t & 63)] = v; }
    __syncthreads();
#pragma unroll 4
    for (int i = 0; i < 16; ++i) { const int nn = (t >> 6) + 4 * i; dst[(size_t)(n0 + nn) * K + k0 + (t & 63)] = bf1(tl[(t & 63) * 65 + nn]); }
  }
}
DI void convert_job(const float* __restrict__ src, bf16_t* __restrict__ dst, size_t n4) {
  for (size_t i = (size_t)VB * 256 + tid(); i < n4; i += (size_t)NVB * 256) {
    const f32x4 v = ((const f32x4*)src)[i];
    u32x2 o = {pk2(v.x, v.y), pk2(v.z, v.w)};
    ((u32x2*)dst)[i] = o;
  }
}

constexpr float F8_SCALE = 64.0f, F8_INV = 1.0f / 64.0f;
DI unsigned pk4_fp8(f32x4 v) {
  int w = 0;
  w = __builtin_amdgcn_cvt_pk_fp8_f32(v.x * F8_SCALE, v.y * F8_SCALE, w, false);
  w = __builtin_amdgcn_cvt_pk_fp8_f32(v.z * F8_SCALE, v.w * F8_SCALE, w, true);
  return (unsigned)w;
}
DI void convert_fp8_job(const float* __restrict__ src, unsigned char* __restrict__ dst, size_t n16) {
  const size_t st = (size_t)NVB * 256;
  for (size_t i0 = (size_t)VB * 256 + tid(); i0 < n16; i0 += 4 * st) {
    f32x4 v[4][4];
#pragma unroll
    for (int q = 0; q < 4; ++q) { const size_t i = i0 + q * st; if (i < n16) { const f32x4* s = (const f32x4*)src + 4 * i;
#pragma unroll
        for (int k = 0; k < 4; ++k) v[q][k] = s[k]; } }
#pragma unroll
    for (int q = 0; q < 4; ++q) { const size_t i = i0 + q * st; if (i < n16) { u32x4 o = {pk4_fp8(v[q][0]), pk4_fp8(v[q][1]), pk4_fp8(v[q][2]), pk4_fp8(v[q][3])}; ((u32x4*)dst)[i] = o; } }
  }
}

DI void phase_prologue(const Params& p, unsigned char* smem) {
  { const int t = tid(), lane = t & 63, wid = t >> 6;
    const int NR = T + 2560, rst = NVB * 4;
    for (int row0 = VB * 4 + wid; row0 < NR; row0 += 2 * rst) {
      f32x4 v[2][4];
#pragma unroll
      for (int q = 0; q < 2; ++q) {
        const int row = row0 + q * rst;
        if (row < NR) {
          const int mr = row - T;
          const float* s = (row < T) ? ((row < 16384) ? p.x_prompt + (size_t)row * DM : p.x_sample + (size_t)(row - 16384) * DM)
                                     : ((mr < 512) ? p.mem_prompt + (size_t)mr * DM : p.mem_sample + (size_t)(mr - 512) * DM);
#pragma unroll
          for (int k = 0; k < 4; ++k) v[q][k] = *(const f32x4*)(s + 16 * lane + 4 * k);
        }
      }
#pragma unroll
      for (int q = 0; q < 2; ++q) {
        const int row = row0 + q * rst;
        if (row < NR) {
          const bool isx = row < T;
          const int mr = row - T;
          float ss = 0.f;
#pragma unroll
          for (int k = 0; k < 4; ++k) ss += (v[q][k].x * v[q][k].x + v[q][k].y * v[q][k].y) + (v[q][k].z * v[q][k].z + v[q][k].w * v[q][k].w);
          ss = wave_sum(ss, lane);
          u32x4 b0 = {pk2(v[q][0].x, v[q][0].y), pk2(v[q][0].z, v[q][0].w), pk2(v[q][1].x, v[q][1].y), pk2(v[q][1].z, v[q][1].w)};
          u32x4 b1 = {pk2(v[q][2].x, v[q][2].y), pk2(v[q][2].z, v[q][2].w), pk2(v[q][3].x, v[q][3].y), pk2(v[q][3].z, v[q][3].w)};
          bf16_t* bd = (isx ? (bf16_t*)(p.ws + OFF_XB) + (size_t)row * DM : (bf16_t*)(p.ws + OFF_MEMB) + (size_t)mr * DM) + 16 * lane;
          *(u32x4*)bd = b0; *(u32x4*)(bd + 8) = b1;
          if (lane < 4) { f32x4 sv = {lane == 0 ? ss : 0.f, 0.f, 0.f, 0.f}; *(f32x4*)((isx ? (float*)(p.ws + OFF_SSP) + (size_t)row * 16 : (float*)(p.ws + OFF_MSS) + (size_t)mr * 16) + 4 * lane) = sv; }
        }
      }
    } }
  for (int l = 0; l < 2; ++l) {
    transpose_job<false>(p.w_in + (size_t)l * 1024 * 2560, 1024, 2560, p.norm_mix_g + l * 1024, ((bf16_t*)(p.ws + OFF_WIN)) + (size_t)l * 2560 * 1024, smem);
    transpose_job<true>(p.w_out + (size_t)l * 1024 * 1024, 1024, 1024, nullptr, ((bf16_t*)(p.ws + OFF_WOUT)) + (size_t)l * 1024 * 1024, smem);
    transpose_job<false>(p.w_xq + (size_t)l * 1024 * 512, 1024, 512, p.norm_xa_g + l * 1024, ((bf16_t*)(p.ws + OFF_WXQ)) + (size_t)l * 512 * 1024, smem);
    transpose_job<true>(p.w_xk + (size_t)l * 1024 * 512, 1024, 512, p.norm_mem_g + l * 1024, ((bf16_t*)(p.ws + OFF_WXKV)) + (size_t)l * 1024 * 1024, smem);
    transpose_job<false>(p.w_xv + (size_t)l * 1024 * 512, 1024, 512, p.norm_mem_g + l * 1024, ((bf16_t*)(p.ws + OFF_WXKV)) + (size_t)l * 1024 * 1024 + (size_t)512 * 1024, smem);
    transpose_job<true>(p.w_xo + (size_t)l * 512 * 1024, 512, 1024, nullptr, ((bf16_t*)(p.ws + OFF_WXO)) + (size_t)l * 1024 * 512, smem);
    transpose_job<false>(p.peer_wq + (size_t)l * 1024 * 2048, 1024, 2048, p.norm_ffn_g + l * 1024, ((bf16_t*)(p.ws + OFF_WPQ)) + (size_t)l * 2048 * 1024, smem);
  }
  convert_job(p.peer_subkeys, ((bf16_t*)(p.ws + OFF_SUBK)), (size_t)2 * 8 * 2 * 128 * 128 / 4);
  convert_fp8_job(p.peer_u, (unsigned char*)(p.ws + OFF_PU), (size_t)2 * 16384 * 1024 / 16);
  convert_fp8_job(p.peer_v, (unsigned char*)(p.ws + OFF_PV), (size_t)2 * 16384 * 1024 / 16);
}

namespace pg8 {
#define PG8_LAS __attribute__((address_space(3)))
typedef unsigned short bf16_t;
typedef short bf16x8 __attribute__((ext_vector_type(8)));
typedef float f32x4 __attribute__((ext_vector_type(4)));
typedef unsigned u32x4 __attribute__((ext_vector_type(4)));
constexpr int BM = 256, BK = 64, HALF = 128, HTB = HALF * BK * 2  , STAGE_BYTES = 8 * HTB, NXCD = 8, WGM = 8;

__host__ __device__ __forceinline__ int lds_byte(int r, int c) { const int st = (r >> 4) * 2 + (c >> 5), rr = r & 15, cc = c & 31, ob = rr * 64 + cc * 2; return st * 1024 + (ob ^ (((ob >> 9) & 1) << 5)); }
__host__ __device__ __forceinline__ void stage_rc(int b, int& R, int& C) { const int st = b / 1024, sb = b % 1024, swz = sb ^ (((sb >> 9) & 1) << 5); R = (st >> 1) * 16 + swz / 64; C = (st & 1) * 32 + (swz % 64) / 2; }
__host__ __device__ __forceinline__ int perm32(int rho) { const int n = rho >> 4, i = rho & 15; return 8 * (i >> 2) + 4 * n + (i & 3); }

struct Unit { int pm, pn; };
struct Gemm { const bf16_t* A; const bf16_t* Bt; int M, N, K; };

struct StaticOrder {
    int nM, nN, nwg, G, c;
    __host__ __device__ void init(int M, int N, int G_, int c_) { nM = M / BM; nN = N / BM; nwg = nM * nN; G = G_; c = c_; }
    __host__ __device__ bool next(int i, Unit& u) const {
        const long L = (long)i * G + c; if (L >= nwg) return false;
        int wgid = (int)L; { const int q = nwg / NXCD, r = nwg % NXCD, xcd = wgid % NXCD, off = wgid / NXCD; wgid = (xcd < r ? xcd * (q + 1) : r * (q + 1) + (xcd - r) * q) + off; }
        const int nig = WGM * nN, gid = wgid / nig, fm = gid * WGM, gsz = (nM - fm) < WGM ? (nM - fm) : WGM;
        u.pm = fm + ((wgid % nig) % gsz); u.pn = (wgid % nig) / gsz; return true;
    }
    __device__ __forceinline__ void a_ready(const Unit&) const {}
    __device__ __forceinline__ void done(const Unit&) const {}
};

template <class Epi, class Sched, bool STAMP = false>
__device__ __forceinline__ void gemm_phase(PG8_LAS unsigned char* lds, const Gemm g, const Sched& S, const Epi& E, unsigned long long* stamps) {
    const int tid = ::tid512(), wid = __builtin_amdgcn_readfirstlane(tid >> 6), lane = tid & 63, wr = wid >> 2, wc = wid & 3, fr = lane & 15, fq = lane >> 4;
    const int K = g.K, nt = K / BK;
    int ts_lo = 0, ts_hi = 0, nts = 0; const unsigned long long rt_entry = STAMP ? (unsigned long long)wall_clock64() : 0ull;
#define PG8_STAMP() do { if (STAMP && wid == 0 && nts < 64) { const unsigned long long _c = (unsigned long long)clock64(); \
        ts_lo = (lane == nts) ? (int)(unsigned)_c : ts_lo; ts_hi = (lane == nts) ? (int)(unsigned)(_c >> 32) : ts_hi; ++nts; } } while (0)
    PG8_STAMP();
    unsigned voffA[2], voffB[2];
#pragma unroll
    for (int i = 0; i < 2; ++i) { int R, C; stage_rc(tid * 16 + i * 8192, R, C); const int Rb = Epi::PERM ? ((R & ~31) + perm32(R & 31)) : R;
        voffA[i] = (unsigned)(R * K + C) * 2u; voffB[i] = (unsigned)(Rb * K + C) * 2u; }
    const size_t kstep = (size_t)(BK * 2);
    const size_t hstep = (size_t)HALF * K * 2;
    const size_t tstep = 2 * hstep;
    const unsigned ldsw = (unsigned)wid * 1024u;
    const int aoff = lds_byte(wr * 64 + fr, fq * 8), boff = lds_byte(wc * 32 + fr, fq * 8);
#define PG8_SA(b, h) (((b) * 2 + (h)) * HTB)
#define PG8_SB(b, h) ((4 + (b) * 2 + (h)) * HTB)
#define PG8_STAGE(bufoff, gbase, voff) do { _Pragma("unroll") for (int _i = 0; _i < 2; ++_i) \
        __builtin_amdgcn_global_load_lds((const unsigned*)((const char*)(gbase) + (voff)[_i]), (PG8_LAS unsigned*)(lds + (bufoff) + ldsw + _i * 8192), 16, 0, 0); } while (0)
#define PG8_LDA(dst, b, h) do { _Pragma("unroll") for (int m = 0; m < 4; ++m) _Pragma("unroll") for (int k = 0; k < 2; ++k) dst[m][k] = *(const PG8_LAS bf16x8*)(lds + PG8_SA(b, h) + aoff + m * 2048 + k * 1024); } while (0)
#define PG8_LDB(dst, b, h) do { _Pragma("unroll") for (int n = 0; n < 2; ++n) _Pragma("unroll") for (int k = 0; k < 2; ++k) dst[n][k] = *(const PG8_LAS bf16x8*)(lds + PG8_SB(b, h) + boff + n * 2048 + k * 1024); } while (0)
#define PG8_MMA(ai, bj, At, Bt) do { __builtin_amdgcn_s_setprio(1); _Pragma("unroll") for (int m = 0; m < 4; ++m) _Pragma("unroll") for (int n = 0; n < 2; ++n) _Pragma("unroll") for (int k = 0; k < 2; ++k) \
        acc[ai][bj][m][n] = __builtin_amdgcn_mfma_f32_16x16x32_bf16(Bt[n][k], At[m][k], acc[ai][bj][m][n], 0, 0, 0); __builtin_amdgcn_s_setprio(0); } while (0)
#define PG8_WAIT_V(n) asm volatile("s_waitcnt vmcnt(" #n ")" ::: "memory")
#define PG8_WAIT_L(n) asm volatile("s_waitcnt lgkmcnt(" #n ")" ::: "memory")
#define PG8_BAR __builtin_amdgcn_s_barrier()
#define PG8_SCHED __builtin_amdgcn_sched_barrier(0)
    Unit cur, nxt; int ui = 0;
    if (!S.next(0, cur)) return;
    f32x4 acc[2][2][4][2];
#pragma unroll
    for (int a = 0; a < 2; ++a)
#pragma unroll
        for (int b = 0; b < 2; ++b)
#pragma unroll
            for (int m = 0; m < 4; ++m)
#pragma unroll
                for (int n = 0; n < 2; ++n) acc[a][b][m][n] = (f32x4){0.f, 0.f, 0.f, 0.f};
    bf16x8 At[4][2], B0[2][2], B1[2][2];
    const char* cA = (const char*)g.A + (size_t)cur.pm * tstep; const char* cB = (const char*)g.Bt + (size_t)cur.pn * tstep;
    S.a_ready(cur);
    PG8_STAGE(PG8_SB(0, 0), cB, voffB); PG8_STAGE(PG8_SA(0, 0), cA, voffA); PG8_STAGE(PG8_SB(0, 1), cB + hstep, voffB); PG8_STAGE(PG8_SA(0, 1), cA + hstep, voffA);
    if (wr == 1) PG8_BAR;
    PG8_WAIT_V(4); PG8_BAR;
    PG8_STAGE(PG8_SB(1, 0), cB + kstep, voffB); PG8_STAGE(PG8_SA(1, 0), cA + kstep, voffA); PG8_STAGE(PG8_SB(1, 1), cB + hstep + kstep, voffB);
    PG8_WAIT_V(6); PG8_BAR;
    PG8_STAMP();
    for (;;) {
        const bool has_next = S.next(ui + 1, nxt);
        const char* nA = has_next ? (const char*)g.A + (size_t)nxt.pm * tstep : cA; const char* nB = has_next ? (const char*)g.Bt + (size_t)nxt.pn * tstep : cB;
        for (int t = 0; t < nt; t += 2) {
            const bool last = (t == nt - 2);
            const char* a1 = cA + (size_t)(t + 1) * kstep;
            const char* a2 = last ? nA : cA + (size_t)(t + 2) * kstep; const char* b2 = last ? nB : cB + (size_t)(t + 2) * kstep;
            const char* a3 = a2 + kstep; const char* b3 = b2 + kstep;
            if (last && has_next) S.a_ready(nxt);
            PG8_LDB(B0, 0, 0); PG8_SCHED; PG8_LDA(At, 0, 0); PG8_STAGE(PG8_SA(1, 1), a1 + hstep, voffA);
            PG8_WAIT_L(8); PG8_BAR; PG8_WAIT_L(0); PG8_MMA(0, 0, At, B0); PG8_BAR; PG8_SCHED;
            PG8_LDB(B1, 0, 1); PG8_STAGE(PG8_SB(0, 0), b2, voffB);
            PG8_BAR; PG8_WAIT_L(0); PG8_MMA(0, 1, At, B1); PG8_BAR;
            PG8_LDA(At, 0, 1); PG8_STAGE(PG8_SA(0, 0), a2, voffA);
            PG8_BAR; PG8_WAIT_L(0); PG8_MMA(1, 0, At, B0); PG8_BAR; PG8_SCHED;
            PG8_STAGE(PG8_SB(0, 1), b2 + hstep, voffB);
            PG8_WAIT_V(6); PG8_BAR; PG8_MMA(1, 1, At, B1); PG8_BAR;
            PG8_LDB(B0, 1, 0); PG8_SCHED; PG8_LDA(At, 1, 0); PG8_STAGE(PG8_SA(0, 1), a2 + hstep, voffA);
            PG8_WAIT_L(8); PG8_BAR; PG8_WAIT_L(0); PG8_MMA(0, 0, At, B0); PG8_BAR; PG8_SCHED;
            PG8_LDB(B1, 1, 1); PG8_STAGE(PG8_SB(1, 0), b3, voffB);
            PG8_BAR; PG8_WAIT_L(0); PG8_MMA(0, 1, At, B1); PG8_BAR;
            PG8_LDA(At, 1, 1); PG8_STAGE(PG8_SA(1, 0), a3, voffA);
            PG8_BAR; PG8_WAIT_L(0); PG8_MMA(1, 0, At, B0); PG8_BAR; PG8_SCHED;
            PG8_STAGE(PG8_SB(1, 1), b3 + hstep, voffB);
            PG8_WAIT_V(6); PG8_BAR; PG8_MMA(1, 1, At, B1); PG8_BAR;
        }
        PG8_STAMP();
        if constexpr (!Epi::AFTER_DRAIN) { E(acc, cur, wr, wc, fr, fq); S.done(cur); }
        PG8_STAMP();
        if (!has_next) break;
#pragma unroll
        for (int a = 0; a < 2; ++a)
#pragma unroll
            for (int b = 0; b < 2; ++b)
#pragma unroll
                for (int m = 0; m < 4; ++m)
#pragma unroll
                    for (int n = 0; n < 2; ++n) acc[a][b][m][n] = (f32x4){0.f, 0.f, 0.f, 0.f};
        cur = nxt; cA = nA; cB = nB; ++ui;
    }
    PG8_WAIT_V(0);
    if (wr == 0) PG8_BAR;
    PG8_BAR;
    if constexpr (Epi::AFTER_DRAIN) { E.fused(acc, cur, wr, wc, fr, fq, lds, wid, lane); S.done(cur); }
    PG8_STAMP();
    if (STAMP && wid == 0) { stamps[lane] = lane < nts ? (((unsigned long long)(unsigned)ts_hi << 32) | (unsigned)ts_lo) : 0ull;
        if (lane == 62) stamps[62] = rt_entry; if (lane == 63) stamps[63] = (unsigned long long)wall_clock64(); }
#undef PG8_STAMP
#undef PG8_SA
#undef PG8_SB
#undef PG8_STAGE
#undef PG8_LDA
#undef PG8_LDB
#undef PG8_MMA
#undef PG8_WAIT_V
#undef PG8_WAIT_L
#undef PG8_BAR
#undef PG8_SCHED
}
}

DI float rstd_from_ssq(const float* ssq16) {
  const f32x4* sp = (const f32x4*)ssq16; const f32x4 a = sp[0], b = sp[1], c = sp[2], d = sp[3];
  const float s = ((a.x + a.y) + (a.z + a.w)) + ((b.x + b.y) + (b.z + b.w)) + ((c.x + c.y) + (c.z + c.w)) + ((d.x + d.y) + (d.z + d.w));
  return rsqrtf(s * (1.0f / 1024.0f) + RMS_EPS);
}
struct EpiScaledBf16 {
  static constexpr bool PERM = true, AFTER_DRAIN = false;
  bf16_t* O; int ldc; const float* ssq;
  __device__ __forceinline__ void operator()(const f32x4 (&acc)[2][2][4][2], const pg8::Unit& u, int wr, int wc, int fr, int fq) const {
    const int row0 = u.pm * 256 + wr * 64 + fr, col0 = u.pn * 256 + wc * 32 + 8 * fq;
    float rsv[2][4];
#pragma unroll
    for (int ai = 0; ai < 2; ++ai)
#pragma unroll
      for (int m = 0; m < 4; ++m) rsv[ai][m] = rstd_from_ssq(ssq + (size_t)(row0 + ai * 128 + m * 16) * 16);
#pragma unroll
    for (int ai = 0; ai < 2; ++ai)
#pragma unroll
      for (int m = 0; m < 4; ++m) {
        const int row = row0 + ai * 128 + m * 16;
        const float rs = rsv[ai][m];
        bf16_t* rowp = O + (size_t)row * ldc + col0;
#pragma unroll
        for (int bj = 0; bj < 2; ++bj) {
          const f32x4 v0 = acc[ai][bj][m][0] * rs, v1 = acc[ai][bj][m][1] * rs;
          u32x4 w = {pk2(v0[0], v0[1]), pk2(v0[2], v0[3]), pk2(v1[0], v1[1]), pk2(v1[2], v1[3])};
          *(u32x4*)(rowp + bj * 128) = w;
        }
      }
  }
};
struct EpiResid {
  static constexpr bool PERM = true, AFTER_DRAIN = false;
  float* X; bf16_t* XB; float* ssq; const float* Xs0; const float* Xs1;
  __device__ __forceinline__ void operator()(const f32x4 (&acc)[2][2][4][2], const pg8::Unit& u, int wr, int wc, int fr, int fq) const {
    const int row0 = u.pm * 256 + wr * 64 + fr, col0 = u.pn * 256 + wc * 32 + 8 * fq;
    const int lane = fr + 16 * fq;
    const float* Xs = (u.pm < 64) ? Xs0 : Xs1;
#pragma unroll
    for (int am = 0; am < 4; ++am) {
      const int ai = am >> 1;
      f32x4 oo[2][2][2];
#pragma unroll
      for (int mm = 0; mm < 2; ++mm) { const float* xs = Xs + (size_t)(row0 + ai * 128 + (2 * (am & 1) + mm) * 16) * DM + col0;
#pragma unroll
        for (int bj = 0; bj < 2; ++bj)
#pragma unroll
          for (int n = 0; n < 2; ++n) oo[mm][bj][n] = *(const f32x4*)(xs + bj * 128 + 4 * n); }
#pragma unroll
      for (int mm = 0; mm < 2; ++mm) {
        const int m = 2 * (am & 1) + mm;
        const int row = row0 + ai * 128 + m * 16;
        float* xr = X + (size_t)row * DM + col0; bf16_t* br = XB + (size_t)row * DM + col0;
        const f32x4 (&o)[2][2] = oo[mm];
        float ss = 0.f;
#pragma unroll
        for (int bj = 0; bj < 2; ++bj) {
          const f32x4 v0 = o[bj][0] + acc[ai][bj][m][0], v1 = o[bj][1] + acc[ai][bj][m][1];
          *(f32x4*)(xr + bj * 128) = v0; *(f32x4*)(xr + bj * 128 + 4) = v1;
          ss += ((v0.x * v0.x + v0.y * v0.y) + (v0.z * v0.z + v0.w * v0.w)) + ((v1.x * v1.x + v1.y * v1.y) + (v1.z * v1.z + v1.w * v1.w));
          u32x4 pk = {pk2(v0.x, v0.y), pk2(v0.z, v0.w), pk2(v1.x, v1.y), pk2(v1.z, v1.w)};
          *(u32x4*)(br + bj * 128) = pk;
        }
        ss += xor16(ss); ss = pair_sum(ss);
        if (fq == 0) ssq[(size_t)row * 16 + 4 * u.pn + wc] = ss;
      }
    }
  }
};
#define TILE_WALK(NT, MT8) const int nx_ = gridDim.x >> 3, xcd_ = blockIdx.x & 7; \
  for (int j_ = blockIdx.x >> 3; j_ < (MT8) * (NT); j_ += nx_) { const int mt = (j_ / (NT)) * 8 + xcd_, nt = j_ % (NT);

DI void run_gemm_scaled(unsigned char* smem, const bf16_t* A, const bf16_t* Bt, int M, int N, int K, bf16_t* O, int ldc, const float* ssq, int crot = 0) {
  pg8::Gemm g{A, Bt, M, N, K};
  pg8::StaticOrder S; S.init(M, N, (int)gridDim.x, (int)((blockIdx.x + crot) % gridDim.x));
  EpiScaledBf16 E{O, ldc, ssq};
  pg8::gemm_phase<EpiScaledBf16, pg8::StaticOrder, false>((PG8_LAS unsigned char*)smem, g, S, E, nullptr);
}
DI void run_gemm_resid(unsigned char* smem, const bf16_t* A, const bf16_t* Bt, int M, int N, int K, float* X, bf16_t* XB, float* ssq, const float* Xs0, const float* Xs1) {
  pg8::Gemm g{A, Bt, M, N, K};
  pg8::StaticOrder S; S.init(M, N, (int)gridDim.x, (int)blockIdx.x);
  EpiResid E{X, XB, ssq, Xs0, Xs1};
  pg8::gemm_phase<EpiResid, pg8::StaticOrder, false>((PG8_LAS unsigned char*)smem, g, S, E, nullptr);
}
DI void phase_in_gemm(const Params& p, int l, unsigned char* smem) {
  run_gemm_scaled(smem, (const bf16_t*)(p.ws + OFF_XB), (const bf16_t*)(p.ws + OFF_WIN) + (size_t)l * 2560 * 1024, T, 2560, 1024, (bf16_t*)(p.ws + OFF_Z), IN_DIM, (const float*)(p.ws + OFF_SSP));
  if (l == 0)
    run_gemm_scaled(smem, (const bf16_t*)(p.ws + OFF_MEMB), (const bf16_t*)(p.ws + OFF_WXKV), 2560, 2048, 1024, (bf16_t*)(p.ws + OFF_MEMKV), 2048, (const float*)(p.ws + OFF_MSS),
                    (int)gridDim.x - (int)(3200u % gridDim.x));
}
DI void phase_out_gemm(const Params& p, int l, unsigned char* smem) {
  run_gemm_resid(smem, (const bf16_t*)(p.ws + OFF_YMIX), (const bf16_t*)(p.ws + OFF_WOUT) + (size_t)l * 1024 * 1024, T, 1024, 1024, p.x, (bf16_t*)(p.ws + OFF_XB), (float*)(p.ws + OFF_SSP),
                 l == 0 ? p.x_prompt : (const float*)p.x, l == 0 ? p.x_sample - (size_t)16384 * DM : (const float*)p.x);
}
DI void phase_xq_gemm(const Params& p, int l, unsigned char* smem) {
  run_gemm_scaled(smem, (const bf16_t*)(p.ws + OFF_XB), (const bf16_t*)(p.ws + OFF_WXQ) + (size_t)l * 512 * 1024, T, 512, 1024, (bf16_t*)(p.ws + OFF_Q), 512, (const float*)(p.ws + OFF_SSP));
}
DI void phase_xo_gemm(const Params& p, int l, unsigned char* smem) {
  run_gemm_resid(smem, (const bf16_t*)(p.ws + OFF_O), (const bf16_t*)(p.ws + OFF_WXO) + (size_t)l * 1024 * 512, T, 1024, 512, p.x, (bf16_t*)(p.ws + OFF_XB), (float*)(p.ws + OFF_SSP), p.x, p.x);
}
DI void topk16_pair(float (&v)[64], float (&res)[16], int lane) {
#define CE(i, l) { const float a_ = v[i], b_ = v[l]; v[i] = fmaxf(a_, b_); v[l] = fminf(a_, b_); }
  CE(0, 1) CE(3, 2) CE(4, 5) CE(7, 6) CE(8, 9) CE(11, 10) CE(12, 13) CE(15, 14) CE(0, 2) CE(1, 3) CE(6, 4) CE(7, 5) CE(8, 10) CE(9, 11) CE(14, 12) CE(15, 13) CE(0, 1) CE(2, 3)
  CE(5, 4) CE(7, 6) CE(8, 9) CE(10, 11) CE(13, 12) CE(15, 14) CE(0, 4) CE(1, 5) CE(2, 6) CE(3, 7) CE(12, 8) CE(13, 9) CE(14, 10) CE(15, 11) CE(0, 2) CE(1, 3) CE(4, 6) CE(5, 7)
  CE(10, 8) CE(11, 9) CE(14, 12) CE(15, 13) CE(0, 1) CE(2, 3) CE(4, 5) CE(6, 7) CE(9, 8) CE(11, 10) CE(13, 12) CE(15, 14) CE(0, 8) CE(1, 9) CE(2, 10) CE(3, 11) CE(4, 12) CE(5, 13)
  CE(6, 14) CE(7, 15) CE(0, 4) CE(1, 5) CE(2, 6) CE(3, 7) CE(8, 12) CE(9, 13) CE(10, 14) CE(11, 15) CE(0, 2) CE(1, 3) CE(4, 6) CE(5, 7) CE(8, 10) CE(9, 11) CE(12, 14) CE(13, 15)
  CE(0, 1) CE(2, 3) CE(4, 5) CE(6, 7) CE(8, 9) CE(10, 11) CE(12, 13) CE(14, 15) CE(16, 17) CE(19, 18) CE(20, 21) CE(23, 22) CE(24, 25) CE(27, 26) CE(28, 29) CE(31, 30) CE(16, 18)
  CE(17, 19) CE(22, 20) CE(23, 21) CE(24, 26) CE(25, 27) CE(30, 28) CE(31, 29) CE(16, 17) CE(18, 19) CE(21, 20) CE(23, 22) CE(24, 25) CE(26, 27) CE(29, 28) CE(31, 30) CE(16, 20)
  CE(17, 21) CE(18, 22) CE(19, 23) CE(28, 24) CE(29, 25) CE(30, 26) CE(31, 27) CE(16, 18) CE(17, 19) CE(20, 22) CE(21, 23) CE(26, 24) CE(27, 25) CE(30, 28) CE(31, 29) CE(16, 17)
  CE(18, 19) CE(20, 21) CE(22, 23) CE(25, 24) CE(27, 26) CE(29, 28) CE(31, 30) CE(16, 24) CE(17, 25) CE(18, 26) CE(19, 27) CE(20, 28) CE(21, 29) CE(22, 30) CE(23, 31) CE(16, 20)
  CE(17, 21) CE(18, 22) CE(19, 23) CE(24, 28) CE(25, 29) CE(26, 30) CE(27, 31) CE(16, 18) CE(17, 19) CE(20, 22) CE(21, 23) CE(24, 26) CE(25, 27) CE(28, 30) CE(29, 31) CE(16, 17)
  CE(18, 19) CE(20, 21) CE(22, 23) CE(24, 25) CE(26, 27) CE(28, 29) CE(30, 31) CE(32, 33) CE(35, 34) CE(36, 37) CE(39, 38) CE(40, 41) CE(43, 42) CE(44, 45) CE(47, 46) CE(32, 34)
  CE(33, 35) CE(38, 36) CE(39, 37) CE(40, 42) CE(41, 43) CE(46, 44) CE(47, 45) CE(32, 33) CE(34, 35) CE(37, 36) CE(39, 38) CE(40, 41) CE(42, 43) CE(45, 44) CE(47, 46) CE(32, 36)
  CE(33, 37) CE(34, 38) CE(35, 39) CE(44, 40) CE(45, 41) CE(46, 42) CE(47, 43) CE(32, 34) CE(33, 35) CE(36, 38) CE(37, 39) CE(42, 40) CE(43, 41) CE(46, 44) CE(47, 45) CE(32, 33)
  CE(34, 35) CE(36, 37) CE(38, 39) CE(41, 40) CE(43, 42) CE(45, 44) CE(47, 46) CE(32, 40) CE(33, 41) CE(34, 42) CE(35, 43) CE(36, 44) CE(37, 45) CE(38, 46) CE(39, 47) CE(32, 36)
  CE(33, 37) CE(34, 38) CE(35, 39) CE(40, 44) CE(41, 45) CE(42, 46) CE(43, 47) CE(32, 34) CE(33, 35) CE(36, 38) CE(37, 39) CE(40, 42) CE(41, 43) CE(44, 46) CE(45, 47) CE(32, 33)
  CE(34, 35) CE(36, 37) CE(38, 39) CE(40, 41) CE(42, 43) CE(44, 45) CE(46, 47) CE(48, 49) CE(51, 50) CE(52, 53) CE(55, 54) CE(56, 57) CE(59, 58) CE(60, 61) CE(63, 62) CE(48, 50)
  CE(49, 51) CE(54, 52) CE(55, 53) CE(56, 58) CE(57, 59) CE(62, 60) CE(63, 61) CE(48, 49) CE(50, 51) CE(53, 52) CE(55, 54) CE(56, 57) CE(58, 59) CE(61, 60) CE(63, 62) CE(48, 52)
  CE(49, 53) CE(50, 54) CE(51, 55) CE(60, 56) CE(61, 57) CE(62, 58) CE(63, 59) CE(48, 50) CE(49, 51) CE(52, 54) CE(53, 55) CE(58, 56) CE(59, 57) CE(62, 60) CE(63, 61) CE(48, 49)
  CE(50, 51) CE(52, 53) CE(54, 55) CE(57, 56) CE(59, 58) CE(61, 60) CE(63, 62) CE(48, 56) CE(49, 57) CE(50, 58) CE(51, 59) CE(52, 60) CE(53, 61) CE(54, 62) CE(55, 63) CE(48, 52)
  CE(49, 53) CE(50, 54) CE(51, 55) CE(56, 60) CE(57, 61) CE(58, 62) CE(59, 63) CE(48, 50) CE(49, 51) CE(52, 54) CE(53, 55) CE(56, 58) CE(57, 59) CE(60, 62) CE(61, 63) CE(48, 49)
  CE(50, 51) CE(52, 53) CE(54, 55) CE(56, 57) CE(58, 59) CE(60, 61) CE(62, 63) v[0] = fmaxf(v[0], v[31]); v[1] = fmaxf(v[1], v[30]); v[2] = fmaxf(v[2], v[29]);
  v[3] = fmaxf(v[3], v[28]); v[4] = fmaxf(v[4], v[27]); v[5] = fmaxf(v[5], v[26]); v[6] = fmaxf(v[6], v[25]); v[7] = fmaxf(v[7], v[24]); v[8] = fmaxf(v[8], v[23]);
  v[9] = fmaxf(v[9], v[22]); v[10] = fmaxf(v[10], v[21]); v[11] = fmaxf(v[11], v[20]); v[12] = fmaxf(v[12], v[19]); v[13] = fmaxf(v[13], v[18]); v[14] = fmaxf(v[14], v[17]);
  v[15] = fmaxf(v[15], v[16]); CE(0, 8) CE(1, 9) CE(2, 10) CE(3, 11) CE(4, 12) CE(5, 13) CE(6, 14) CE(7, 15) CE(0, 4) CE(1, 5) CE(2, 6) CE(3, 7) CE(8, 12) CE(9, 13) CE(10, 14)
  CE(11, 15) CE(0, 2) CE(1, 3) CE(4, 6) CE(5, 7) CE(8, 10) CE(9, 11) CE(12, 14) CE(13, 15) CE(0, 1) CE(2, 3) CE(4, 5) CE(6, 7) CE(8, 9) CE(10, 11) CE(12, 13) CE(14, 15)
  v[32] = fmaxf(v[32], v[63]); v[33] = fmaxf(v[33], v[62]); v[34] = fmaxf(v[34], v[61]); v[35] = fmaxf(v[35], v[60]); v[36] = fmaxf(v[36], v[59]); v[37] = fmaxf(v[37], v[58]);
  v[38] = fmaxf(v[38], v[57]); v[39] = fmaxf(v[39], v[56]); v[40] = fmaxf(v[40], v[55]); v[41] = fmaxf(v[41], v[54]); v[42] = fmaxf(v[42], v[53]); v[43] = fmaxf(v[43], v[52]);
  v[44] = fmaxf(v[44], v[51]); v[45] = fmaxf(v[45], v[50]); v[46] = fmaxf(v[46], v[49]); v[47] = fmaxf(v[47], v[48]); CE(32, 40) CE(33, 41) CE(34, 42) CE(35, 43) CE(36, 44)
  CE(37, 45) CE(38, 46) CE(39, 47) CE(32, 36) CE(33, 37) CE(34, 38) CE(35, 39) CE(40, 44) CE(41, 45) CE(42, 46) CE(43, 47) CE(32, 34) CE(33, 35) CE(36, 38) CE(37, 39) CE(40, 42)
  CE(41, 43) CE(44, 46) CE(45, 47) CE(32, 33) CE(34, 35) CE(36, 37) CE(38, 39) CE(40, 41) CE(42, 43) CE(44, 45) CE(46, 47) v[0] = fmaxf(v[0], v[47]); v[1] = fmaxf(v[1], v[46]);
  v[2] = fmaxf(v[2], v[45]); v[3] = fmaxf(v[3], v[44]); v[4] = fmaxf(v[4], v[43]); v[5] = fmaxf(v[5], v[42]); v[6] = fmaxf(v[6], v[41]); v[7] = fmaxf(v[7], v[40]);
  v[8] = fmaxf(v[8], v[39]); v[9] = fmaxf(v[9], v[38]); v[10] = fmaxf(v[10], v[37]); v[11] = fmaxf(v[11], v[36]); v[12] = fmaxf(v[12], v[35]); v[13] = fmaxf(v[13], v[34]);
  v[14] = fmaxf(v[14], v[33]); v[15] = fmaxf(v[15], v[32]); CE(0, 8) CE(1, 9) CE(2, 10) CE(3, 11) CE(4, 12) CE(5, 13) CE(6, 14) CE(7, 15) CE(0, 4) CE(1, 5) CE(2, 6) CE(3, 7)
  CE(8, 12) CE(9, 13) CE(10, 14) CE(11, 15) CE(0, 2) CE(1, 3) CE(4, 6) CE(5, 7) CE(8, 10) CE(9, 11) CE(12, 14) CE(13, 15) CE(0, 1) CE(2, 3) CE(4, 5) CE(6, 7) CE(8, 9) CE(10, 11)
  CE(12, 13) CE(14, 15)
  float pq[16];
#pragma unroll
  for (int i = 0; i < 16; ++i) pq[i] = xor32(v[i], lane);
#pragma unroll
  for (int i = 0; i < 16; ++i) res[i] = fmaxf(v[i], pq[15 - i]);
  { const float a_ = res[0], b_ = res[8]; res[0] = fmaxf(a_, b_); res[8] = fminf(a_, b_); }
  { const float a_ = res[1], b_ = res[9]; res[1] = fmaxf(a_, b_); res[9] = fminf(a_, b_); }
  { const float a_ = res[2], b_ = res[10]; res[2] = fmaxf(a_, b_); res[10] = fminf(a_, b_); }
  { const float a_ = res[3], b_ = res[11]; res[3] = fmaxf(a_, b_); res[11] = fminf(a_, b_); }
  { const float a_ = res[4], b_ = res[12]; res[4] = fmaxf(a_, b_); res[12] = fminf(a_, b_); }
  { const float a_ = res[5], b_ = res[13]; res[5] = fmaxf(a_, b_); res[13] = fminf(a_, b_); }
  { const float a_ = res[6], b_ = res[14]; res[6] = fmaxf(a_, b_); res[14] = fminf(a_, b_); }
  { const float a_ = res[7], b_ = res[15]; res[7] = fmaxf(a_, b_); res[15] = fminf(a_, b_); }
  { const float a_ = res[0], b_ = res[4]; res[0] = fmaxf(a_, b_); res[4] = fminf(a_, b_); }
  { const float a_ = res[1], b_ = res[5]; res[1] = fmaxf(a_, b_); res[5] = fminf(a_, b_); }
  { const float a_ = res[2], b_ = res[6]; res[2] = fmaxf(a_, b_); res[6] = fminf(a_, b_); }
  { const float a_ = res[3], b_ = res[7]; res[3] = fmaxf(a_, b_); res[7] = fminf(a_, b_); }
  { const float a_ = res[8], b_ = res[12]; res[8] = fmaxf(a_, b_); res[12] = fminf(a_, b_); }
  { const float a_ = res[9], b_ = res[13]; res[9] = fmaxf(a_, b_); res[13] = fminf(a_, b_); }
  { const float a_ = res[10], b_ = res[14]; res[10] = fmaxf(a_, b_); res[14] = fminf(a_, b_); }
  { const float a_ = res[11], b_ = res[15]; res[11] = fmaxf(a_, b_); res[15] = fminf(a_, b_); }
  { const float a_ = res[0], b_ = res[2]; res[0] = fmaxf(a_, b_); res[2] = fminf(a_, b_); }
  { const float a_ = res[1], b_ = res[3]; res[1] = fmaxf(a_, b_); res[3] = fminf(a_, b_); }
  { const float a_ = res[4], b_ = res[6]; res[4] = fmaxf(a_, b_); res[6] = fminf(a_, b_); }
  { const float a_ = res[5], b_ = res[7]; res[5] = fmaxf(a_, b_); res[7] = fminf(a_, b_); }
  { const float a_ = res[8], b_ = res[10]; res[8] = fmaxf(a_, b_); res[10] = fminf(a_, b_); }
  { const float a_ = res[9], b_ = res[11]; res[9] = fmaxf(a_, b_); res[11] = fminf(a_, b_); }
  { const float a_ = res[12], b_ = res[14]; res[12] = fmaxf(a_, b_); res[14] = fminf(a_, b_); }
  { const float a_ = res[13], b_ = res[15]; res[13] = fmaxf(a_, b_); res[15] = fminf(a_, b_); }
  { const float a_ = res[0], b_ = res[1]; res[0] = fmaxf(a_, b_); res[1] = fminf(a_, b_); }
  { const float a_ = res[2], b_ = res[3]; res[2] = fmaxf(a_, b_); res[3] = fminf(a_, b_); }
  { const float a_ = res[4], b_ = res[5]; res[4] = fmaxf(a_, b_); res[5] = fminf(a_, b_); }
  { const float a_ = res[6], b_ = res[7]; res[6] = fmaxf(a_, b_); res[7] = fminf(a_, b_); }
  { const float a_ = res[8], b_ = res[9]; res[8] = fmaxf(a_, b_); res[9] = fminf(a_, b_); }
  { const float a_ = res[10], b_ = res[11]; res[10] = fmaxf(a_, b_); res[11] = fminf(a_, b_); }
  { const float a_ = res[12], b_ = res[13]; res[12] = fmaxf(a_, b_); res[13] = fminf(a_, b_); }
  { const float a_ = res[14], b_ = res[15]; res[14] = fmaxf(a_, b_); res[15] = fminf(a_, b_); }
#undef CE
}
struct OneUnit {
  pg8::Unit u;
  __device__ __forceinline__ bool next(int i, pg8::Unit& o) const { if (i) return false; o = u; return true; }
  __device__ __forceinline__ void a_ready(const pg8::Unit&) const {}
  __device__ __forceinline__ void done(const pg8::Unit&) const {}
};
struct EpiPeerQ {
  static constexpr bool PERM = true, AFTER_DRAIN = true;
  const float* ssq; const bf16_t* subk_l; float* topS; unsigned char* smem;
  __device__ __forceinline__ void operator()(const f32x4 (&)[2][2][4][2], const pg8::Unit&, int, int, int, int) const {}
  __device__ __forceinline__ void fused(const f32x4 (&acc)[2][2][4][2], const pg8::Unit& u, int wr, int wc, int fr, int fq, PG8_LAS unsigned char*, int wid, int lane) const {
    bf16_t* Qs = (bf16_t*)smem;
    float rsv[2][4];
#pragma unroll
    for (int ai = 0; ai < 2; ++ai)
#pragma unroll
      for (int m = 0; m < 4; ++m) rsv[ai][m] = rstd_from_ssq(ssq + ((size_t)u.pm * 256 + 128 * ai + 64 * wr + 16 * m + fr) * 16);
#pragma unroll
    for (int ai = 0; ai < 2; ++ai)
#pragma unroll
      for (int m = 0; m < 4; ++m) {
        const int rowl = 128 * ai + 64 * wr + 16 * m + fr;
        const float rs = rsv[ai][m];
#pragma unroll
        for (int bj = 0; bj < 2; ++bj) {
          const f32x4 v0 = acc[ai][bj][m][0] * rs, v1 = acc[ai][bj][m][1] * rs;
          u32x4 w = {pk2(v0[0], v0[1]), pk2(v0[2], v0[3]), pk2(v1[0], v1[1]), pk2(v1[2], v1[3])};
          *(u32x4*)(Qs + rowl * 264 + 128 * bj + 32 * wc + 8 * fq) = w;
        }
      }
    __syncthreads();
    const int r = lane & 31, h = lane >> 5;
#pragma unroll 1
    for (int pp = 0; pp < 2; ++pp) {
      const bf16_t* sk = subk_l + ((size_t)(u.pn * 2 + pp) * 128) * 128 + r * 128 + 8 * h;
      f32x16 sc[4];
#pragma unroll
      for (int n4 = 0; n4 < 4; ++n4)
#pragma unroll
        for (int i = 0; i < 16; ++i) sc[n4][i] = 0.f;
#pragma unroll 2
      for (int ks = 0; ks < 8; ++ks) {
        const bf16x8 bq = *(const bf16x8*)(Qs + (32 * wid + r) * 264 + 128 * pp + 16 * ks + 8 * h);
#pragma unroll
        for (int n4 = 0; n4 < 4; ++n4) { const bf16x8 a = *(const bf16x8*)(sk + (32 * n4) * 128 + 16 * ks); sc[n4] = MFMA32(a, bq, sc[n4]); }
      }
      float v[64], res[16];
#pragma unroll
      for (int n4 = 0; n4 < 4; ++n4)
#pragma unroll
        for (int i = 0; i < 16; ++i) v[16 * n4 + i] = __uint_as_float((__float_as_uint(sc[n4][i]) & ~127u) | (unsigned)(32 * n4 + crow(i, h)));
      topk16_pair(v, res, lane);
      if (h == 0) {
        float* dst = topS + (((size_t)u.pm * 256 + 32 * wid + r) * 16 + u.pn * 2 + pp) * 16;
#pragma unroll
        for (int g = 0; g < 4; ++g) { f32x4 vv = {res[4 * g], res[4 * g + 1], res[4 * g + 2], res[4 * g + 3]}; *(f32x4*)(dst + 4 * g) = vv; }
      }
    }
    __syncthreads();
  }
};
DI void phase_peer_q(const Params& p, int l, unsigned char* smem) {
  const pg8::Gemm g{(const bf16_t*)(p.ws + OFF_XB), (const bf16_t*)(p.ws + OFF_WPQ) + (size_t)l * 2048 * 1024, T, 2048, 1024};
  const EpiPeerQ E{(const float*)(p.ws + OFF_SSP), (const bf16_t*)(p.ws + OFF_SUBK) + (size_t)l * 16 * 128 * 128, (float*)(p.ws + OFF_TOPS), smem};
  TILE_WALK(8, 40)
    const OneUnit S{{mt, nt}};
    pg8::gemm_phase<EpiPeerQ, OneUnit, false>((PG8_LAS unsigned char*)smem, g, S, E, nullptr);
  }
}

DI void fp8x16_dot(const u32x4 u, const float (&xn)[16], float& d) {
#pragma unroll
  for (int dw = 0; dw < 4; ++dw) {
    const f32x2 lo = __builtin_amdgcn_cvt_pk_f32_fp8((int)u[dw], false), hi = __builtin_amdgcn_cvt_pk_f32_fp8((int)u[dw], true);
    d += lo.x * xn[4 * dw] + lo.y * xn[4 * dw + 1]; d += hi.x * xn[4 * dw + 2] + hi.y * xn[4 * dw + 3];
  }
}
DI void fp8x16_axpy(const u32x4 u, float w, float (&out)[16]) {
#pragma unroll
  for (int dw = 0; dw < 4; ++dw) {
    const f32x2 lo = __builtin_amdgcn_cvt_pk_f32_fp8((int)u[dw], false), hi = __builtin_amdgcn_cvt_pk_f32_fp8((int)u[dw], true);
    out[4 * dw] += w * lo.x; out[4 * dw + 1] += w * lo.y; out[4 * dw + 2] += w * hi.x; out[4 * dw + 3] += w * hi.y;
  }
}
DI void phase_peer_experts(const Params& p, int l, bool last) {
  const int t = tid(), lane = t & 63, wid = t >> 6;
  const unsigned char* pu = (const unsigned char*)(p.ws + OFF_PU) + (size_t)l * 16384 * 1024 + 16 * lane;
  const unsigned char* pv = (const unsigned char*)(p.ws + OFF_PV) + (size_t)l * 16384 * 1024 + 16 * lane;
  const float* gf = p.norm_ffn_g + l * 1024 + 16 * lane;
  const int pr = PAIRTAB[lane], ci = pr >> 4, cj = pr & 15;
  for (int tok = VB * 4 + wid; tok < T; tok += NVB * 4) {
    float* xr = p.x + (size_t)tok * DM + 16 * lane;
    float xn[16], out[16];
    {
      f32x4 xa[4];
#pragma unroll
      for (int k = 0; k < 4; ++k) xa[k] = *(const f32x4*)(xr + 4 * k);
      float ss = 0.f;
#pragma unroll
      for (int k = 0; k < 4; ++k) ss += xa[k].x * xa[k].x + xa[k].y * xa[k].y + xa[k].z * xa[k].z + xa[k].w * xa[k].w;
      ss = wave_sum(ss, lane);
      const float rstd = rsqrtf(ss * (1.0f / 1024.0f) + RMS_EPS);
#pragma unroll
      for (int k = 0; k < 4; ++k) { const f32x4 g = *(const f32x4*)(gf + 4 * k);
        xn[4 * k] = xa[k].x * rstd * g.x; xn[4 * k + 1] = xa[k].y * rstd * g.y; xn[4 * k + 2] = xa[k].z * rstd * g.z; xn[4 * k + 3] = xa[k].w * rstd * g.w; }
    }
#pragma unroll
    for (int k = 0; k < 16; ++k) out[k] = 0.f;
    const float* ts = ((float*)(p.ws + OFF_TOPS)) + (size_t)tok * 256;
    for (int hd = 0; hd < 8; ++hd) {
      const float sa = ts[hd * 32 + ci], sb = ts[hd * 32 + 16 + cj];
      const float val = (lane < 50) ? sa + sb : -INFINITY;
      const int idx = (int)((__float_as_uint(sa) & 127u) * 128u + (__float_as_uint(sb) & 127u));
      int rank = 0;
#pragma unroll
      for (int c = 0; c < 50; ++c) { const float vc = rdlane_f(val, c); rank += ((vc > val) || (vc == val && c < lane)) ? 1 : 0; }
      const bool selected = (rank < 16) && (lane < 50);
      unsigned long long sel = __ballot(selected);
      const float vmax = rdlane_f(val, 0);
      const float e = selected ? __expf(val - vmax) : 0.f;
      const float esum = wave_sum(e, lane);
      const float gate = e / esum;
      int ce = 0; float cgt = 0.f;
#pragma unroll
      for (int rd = 0; rd < 16; ++rd) {
        const int s = __ffsll((long long)sel) - 1; sel &= sel - 1;
        const int ex = __builtin_amdgcn_readlane(idx, s); const float gg = rdlane_f(gate, s);
        ce = (lane == rd) ? ex : ce; cgt = (lane == rd) ? gg : cgt;
      }
      float myd = 0.f;
      {
        u32x4 u[16], v[16];
#pragma unroll
        for (int k = 0; k < 16; ++k) { const int ex = __builtin_amdgcn_readlane(ce, k); u[k] = *(const u32x4*)(pu + (size_t)ex * 1024); v[k] = *(const u32x4*)(pv + (size_t)ex * 1024); }
#pragma unroll
        for (int k = 0; k < 16; ++k) {
          float d = 0.f;
          fp8x16_dot(u[k], xn, d);
          d = wave_sum(d, lane);
          myd = (lane == k) ? d : myd;
        }
        myd *= F8_INV;
        const float wgt = cgt * (0.5f * myd * (1.0f + erff(myd * 0.70710678118654752f))) * F8_INV;
#pragma unroll
        for (int k = 0; k < 16; ++k) fp8x16_axpy(v[k], rdlane_f(wgt, k), out);
      }
    }
    f32x4 xo[4];
#pragma unroll
    for (int k = 0; k < 4; ++k) { const f32x4 xa = *(const f32x4*)(xr + 4 * k); xo[k].x = xa.x + out[4 * k]; xo[k].y = xa.y + out[4 * k + 1]; xo[k].z = xa.z + out[4 * k + 2]; xo[k].w = xa.w + out[4 * k + 3]; }
    float s2 = 0.f;
#pragma unroll
    for (int k = 0; k < 4; ++k) s2 += xo[k].x * xo[k].x + xo[k].y * xo[k].y + xo[k].z * xo[k].z + xo[k].w * xo[k].w;
    s2 = wave_sum(s2, lane);
    if (!last && lane < 4) { f32x4 sv = {lane == 0 ? s2 : 0.f, 0.f, 0.f, 0.f}; *(f32x4*)((float*)(p.ws + OFF_SSP) + (size_t)tok * 16 + 4 * lane) = sv; }
    if (last) {
      const float r2 = rsqrtf(s2 * (1.0f / 1024.0f) + RMS_EPS);
      const float* fg = p.final_g + 16 * lane;
#pragma unroll
      for (int k = 0; k < 4; ++k) xo[k] = xo[k] * r2 * *(const f32x4*)(fg + 4 * k);
    }
#pragma unroll
    for (int k = 0; k < 4; ++k) *(f32x4*)(xr + 4 * k) = xo[k];
    if (!last) {
      bf16_t* xb = (bf16_t*)(p.ws + OFF_XB) + (size_t)tok * DM + 16 * lane;
      u32x4 b0 = {pk2(xo[0].x, xo[0].y), pk2(xo[0].z, xo[0].w), pk2(xo[1].x, xo[1].y), pk2(xo[1].z, xo[1].w)};
      u32x4 b1 = {pk2(xo[2].x, xo[2].y), pk2(xo[2].z, xo[2].w), pk2(xo[3].x, xo[3].y), pk2(xo[3].z, xo[3].w)};
      *(u32x4*)xb = b0; *(u32x4*)(xb + 8) = b1;
    }
  }
}

DI void gsync(unsigned* bar, unsigned& epoch) {
  __syncthreads();
  ++epoch;
  if (threadIdx.x == 0) {
    __builtin_amdgcn_fence(__ATOMIC_RELEASE, "agent");
    const unsigned grp = blockIdx.x & 7u, ng = gridDim.x >> 3;
    const unsigned a = __hip_atomic_fetch_add(bar + 64 * grp, 1u, __ATOMIC_RELAXED, __HIP_MEMORY_SCOPE_AGENT);
    if (a + 1u == epoch * ng) {
      __builtin_amdgcn_fence(__ATOMIC_ACQ_REL, "agent"); asm volatile("s_waitcnt vmcnt(0)" ::: "memory");
      const unsigned b = __hip_atomic_fetch_add(bar + 64 * 8, 1u, __ATOMIC_RELAXED, __HIP_MEMORY_SCOPE_AGENT);
      if (b + 1u == epoch * 8u) { __builtin_amdgcn_fence(__ATOMIC_ACQ_REL, "agent"); asm volatile("s_waitcnt vmcnt(0)" ::: "memory"); __hip_atomic_store(bar + 64 * 9, epoch, __ATOMIC_RELAXED, __HIP_MEMORY_SCOPE_AGENT); }
    }
    while (__hip_atomic_load(bar + 64 * 9, __ATOMIC_RELAXED, __HIP_MEMORY_SCOPE_AGENT) < epoch) { }
    __builtin_amdgcn_fence(__ATOMIC_ACQUIRE, "agent");
    asm volatile("s_waitcnt vmcnt(0)" ::: "memory");
  }
  __syncthreads();
}
template <int L>
DI void run_layer(const Params& p, unsigned char* smem, unsigned char* vsm, unsigned* bar, unsigned& epoch) {
  phase_in_gemm(p, L, smem);
  gsync(bar, epoch);
  for (int it = VB; it < 3840; it += NVB) na_item(p, L, it, vsm);
  for (int it = (VB + NVB / 2) % NVB; it < 3840; it += NVB) swa_item(p, L, it, vsm);
  for (int it = VB; it < 10240; it += NVB) conv_item(p, L, it);
  gsync(bar, epoch);
  phase_out_gemm(p, L, smem); gsync(bar, epoch);
  phase_xq_gemm(p, L, smem);
  gsync(bar, epoch);
  for (int it = VB; it < 2560; it += NVB) xattn_item(p, L, it, vsm);
  gsync(bar, epoch);
  phase_xo_gemm(p, L, smem); gsync(bar, epoch);
  phase_peer_q(p, L, smem);
  gsync(bar, epoch);
  phase_peer_experts(p, L, L == 1);
}
__global__ void __launch_bounds__(512, 2) fwd(Params p) {
  __shared__ __attribute__((aligned(16))) unsigned char smem[SMEM_BYTES];
  unsigned char* vsm = smem + VHALF * VSMEM;
  cg::grid_group grid = cg::this_grid();
  unsigned* bar = (unsigned*)(p.ws + OFF_BAR); unsigned epoch = 0;
  if (blockIdx.x == 0 && threadIdx.x < 10) bar[64 * threadIdx.x] = 0u;
  phase_prologue(p, vsm);
  grid.sync();
  run_layer<0>(p, smem, vsm, bar, epoch); gsync(bar, epoch);
  run_layer<1>(p, smem, vsm, bar, epoch);
}

extern "C" void kernel_launch(void* const* d_in, const int* in_sizes, int n_in, void* d_out, int out_size, void* d_ws, size_t ws_size, hipStream_t stream) {
  static int grid_blocks = 0;
  if (!grid_blocks) {
    int dev = 0, cus = 0, per_cu = 1;
    (void)hipGetDevice(&dev);
    (void)hipDeviceGetAttribute(&cus, hipDeviceAttributeMultiprocessorCount, dev);
    (void)hipOccupancyMaxActiveBlocksPerMultiprocessor(&per_cu, fwd, 512, 0);
    if (per_cu < 1) per_cu = 1;
    grid_blocks = cus;
    grid_blocks -= grid_blocks % 8;
  }
  Params p{};
  const float* const* in = (const float* const*)d_in;
  p.x_prompt = in[0]; p.x_sample = in[1]; p.mem_prompt = in[2]; p.mem_sample = in[3];
  p.norm_mix_g = in[4]; p.w_in = in[5]; p.na_rpb = in[6]; p.conv_w = in[7]; p.swa_sink = in[8]; p.t5_bias = in[9];
  p.w_out = in[10]; p.norm_xa_g = in[11]; p.norm_mem_g = in[12]; p.w_xq = in[13]; p.w_xk = in[14]; p.w_xv = in[15]; p.w_xo = in[16];
  p.norm_ffn_g = in[17]; p.peer_wq = in[18]; p.peer_subkeys = in[19]; p.peer_u = in[20]; p.peer_v = in[21]; p.final_g = in[22];
  p.x = (float*)d_out;
  p.ws = (unsigned char*)d_ws;
  if (WS_NEED > ws_size) { fprintf(stderr, "workspace too small: need %zu have %zu\n", (size_t)WS_NEED, ws_size); return; }
  void* args[] = {&p};
  hipError_t e = hipLaunchCooperativeKernel((void*)fwd, dim3(grid_blocks), dim3(512), args, 0, stream);
  if (e != hipSuccess) fprintf(stderr, "cooperative launch failed: %s (grid %d)\n", hipGetErrorString(e), grid_blocks);
}
```
